# Optimizing an MI355X kernel written in HIP

```python
import math
import jax
import jax.numpy as jnp
from jax import lax
import numpy as np

D_MODEL = 1024
BATCH = 8
SEQ = 8192
DEPTH = 1

HEAD_DIM = 64
ATTN_SCALE = HEAD_DIM ** -0.5
Q_BLOCK = 128
NSA_HEADS = 8
NSA_KV_HEADS = 2
NSA_GROUP = NSA_HEADS // NSA_KV_HEADS
CMP_BLOCK = 32
CMP_STRIDE = 16
CMP_HIDDEN = 128
SEL_BLOCK = 64
SEL_TOP_N = 8
SEL_INIT_BLOCKS = 1
SEL_LOCAL_BLOCKS = 2
SEL_FORCE = 1e6
NSA_WINDOW = 512
SWA_HEADS = 8
SWA_KV_HEADS = 2
SWA_GROUP = SWA_HEADS // SWA_KV_HEADS
SWA_WINDOW = 128
REL_BUCKETS = 32
REL_MAX_DIST = 128
N_BIAS_HEADS = NSA_HEADS + SWA_HEADS
N_EXPERTS = 256
TOP_K = 8
EXPERT_HIDDEN = 256
SHARED_HIDDEN = 256
N_EXPERT_GROUPS = 8
TOPK_EXPERT_GROUPS = 4
ROUTED_SCALE = 2.5
MOE_BLOCK = 128
LN_EPS = 1e-5
DN_ALPHA = (2 * DEPTH) ** 0.25
DN_BETA = (8 * DEPTH) ** -0.25

NSA_Q_W = NSA_HEADS * HEAD_DIM
NSA_KV_W = NSA_KV_HEADS * HEAD_DIM
SWA_Q_W = SWA_HEADS * HEAD_DIM
SWA_KV_W = SWA_KV_HEADS * HEAD_DIM
IN_SIZES = (NSA_Q_W, NSA_KV_W, NSA_KV_W, NSA_KV_W, NSA_KV_W, NSA_KV_W, NSA_KV_W, 3 * NSA_HEADS,
            SWA_Q_W, SWA_KV_W, SWA_KV_W, D_MODEL, D_MODEL)
IN_WIDTH = sum(IN_SIZES)

kernel_name = 'nsa_swa_sink_gated_hybrid_moe'


def _layer_norm(x, g, b):
    xf = x.astype(jnp.float32)
    mu = jnp.mean(xf, -1, keepdims=True)
    var = jnp.mean(jnp.square(xf - mu), -1, keepdims=True)
    y = (xf - mu) * lax.rsqrt(var + LN_EPS) * g.astype(jnp.float32) + b.astype(jnp.float32)
    return y.astype(x.dtype)


def _rel_bucket(dist):
    n = jnp.maximum(dist, 0)
    max_exact = REL_BUCKETS // 2
    nf = jnp.maximum(n, 1).astype(jnp.float32)
    log_b = max_exact + (jnp.log(nf / max_exact) / math.log(REL_MAX_DIST / max_exact)
                         * (REL_BUCKETS - max_exact)).astype(jnp.int32)
    log_b = jnp.minimum(log_b, REL_BUCKETS - 1)
    return jnp.where(n < max_exact, n, log_b)


def _masked_softmax(s, mask):
    s = jnp.where(mask, s, -jnp.inf)
    m = jnp.max(s, -1, keepdims=True)
    m = jnp.where(jnp.isfinite(m), m, 0.0)
    e = jnp.exp(s - m)
    return e / jnp.maximum(jnp.sum(e, -1, keepdims=True), 1e-30)


def _sink_softmax(s, mask, sink):
    s = jnp.where(mask, s, -jnp.inf)
    sk = sink.astype(jnp.float32)[None, :, :, None, None]
    m = jnp.maximum(jnp.max(s, -1, keepdims=True), sk)
    e = jnp.exp(s - m)
    return e / (jnp.sum(e, -1, keepdims=True) + jnp.exp(sk - m))


def _window_pad(window):
    return Q_BLOCK * (-(-(window - 1) // Q_BLOCK))


def _window_bias(tab, pad):
    kw_len = pad + Q_BLOCK
    dist = jnp.arange(Q_BLOCK)[:, None] + pad - jnp.arange(kw_len)[None, :]
    bias = jnp.transpose(tab[_rel_bucket(dist)], (2, 3, 0, 1)).astype(jnp.float32)
    return bias, dist


def _window_attend(q, kpad, vpad, t0, pad, window, bias, dist, sink):
    kw_len = pad + Q_BLOCK
    kw = lax.dynamic_slice_in_dim(kpad, t0, kw_len, axis=1)
    vw = lax.dynamic_slice_in_dim(vpad, t0, kw_len, axis=1)
    s = jnp.einsum('bqgrd,bkgd->bgrqk', q, kw).astype(jnp.float32) * ATTN_SCALE + bias
    kpos = t0 - pad + jnp.arange(kw_len)
    mask = (dist >= 0) & (dist < window) & (kpos >= 0)[None, :]
    p = _masked_softmax(s, mask) if sink is None else _sink_softmax(s, mask, sink)
    return jnp.einsum('bgrqk,bkgd->bqgrd', p, vw.astype(jnp.float32))


def _compress(t, pe, w1, b1, w2):
    bsz, seq, g, dh = t.shape
    n_chunks = seq // CMP_STRIDE
    r = CMP_BLOCK // CMP_STRIDE
    n_cmp = n_chunks - r + 1
    ch = t.reshape(bsz, n_chunks, CMP_STRIDE, g, dh)
    blk = jnp.concatenate([ch[:, j:j + n_cmp] for j in range(r)], axis=2) + pe[None, None, :, None, :]
    flat = jnp.moveaxis(blk, 3, 2).reshape(bsz, n_cmp, g, CMP_BLOCK * dh)
    return jax.nn.gelu(flat @ w1 + b1) @ w2


def _unblock(o):
    o = jnp.moveaxis(o, 0, 1)
    return o.reshape(o.shape[0], o.shape[1] * o.shape[2], o.shape[3], o.shape[4], o.shape[5])


def _token_mixer(x, w_in, cmp_pe, cmp_w1, cmp_b1, cmp_w2, sinks, bias_table, proj_a, proj_b, w_out):
    f32 = jnp.float32
    bsz, seq, _ = x.shape
    G, R = NSA_KV_HEADS, NSA_GROUP
    Gb, Rb = SWA_KV_HEADS, SWA_GROUP
    h = x @ w_in
    offs = [int(o) for o in np.cumsum(IN_SIZES)[:-1]]
    (q_a, k_c, v_c, k_s, v_s, k_w, v_w, g_a, q_b, k_b, v_b, gate_a, gate_b) = jnp.split(h, offs, axis=-1)
    q_a = q_a.reshape(bsz, seq, G, R, HEAD_DIM)
    q_b = q_b.reshape(bsz, seq, Gb, Rb, HEAD_DIM)
    kv_a = lambda t: t.reshape(bsz, seq, G, HEAD_DIM)
    kv_b = lambda t: t.reshape(bsz, seq, Gb, HEAD_DIM)

    k_cmp = _compress(kv_a(k_c), cmp_pe[0], cmp_w1[0], cmp_b1[0], cmp_w2[0])
    v_cmp = _compress(kv_a(v_c), cmp_pe[1], cmp_w1[1], cmp_b1[1], cmp_w2[1])
    n_cmp = k_cmp.shape[1]
    cmp_start = jnp.arange(n_cmp) * CMP_STRIDE
    cmp_end = cmp_start + CMP_BLOCK - 1
    n_sel = seq // SEL_BLOCK
    n_top = min(SEL_TOP_N, n_sel)
    n_tok = n_top * SEL_BLOCK
    sel_ids = jnp.arange(n_sel)
    sel_start = sel_ids * SEL_BLOCK
    cmp_to_sel = ((cmp_start[:, None] < sel_start[None, :] + SEL_BLOCK)
                  & (cmp_start[:, None] + CMP_BLOCK > sel_start[None, :])).astype(f32)
    k_sel_blk = jnp.transpose(kv_a(k_s).reshape(bsz, n_sel, SEL_BLOCK, G, HEAD_DIM), (0, 3, 1, 2, 4))
    v_sel_blk = jnp.transpose(kv_a(v_s).reshape(bsz, n_sel, SEL_BLOCK, G, HEAD_DIM), (0, 3, 1, 2, 4))
    bi = jnp.arange(bsz)[:, None, None, None]
    gi = jnp.arange(G)[None, :, None, None]

    tab_a = bias_table[:, :NSA_HEADS].reshape(REL_BUCKETS, G, R)
    tab_b = bias_table[:, NSA_HEADS:].reshape(REL_BUCKETS, Gb, Rb)

    pad_a = _window_pad(NSA_WINDOW)
    pad_b = _window_pad(SWA_WINDOW)
    padf = lambda t, p: jnp.pad(t, ((0, 0), (p, 0), (0, 0), (0, 0)))
    kw_pad, vw_pad = padf(kv_a(k_w), pad_a), padf(kv_a(v_w), pad_a)
    kb_pad, vb_pad = padf(kv_b(k_b), pad_b), padf(kv_b(v_b), pad_b)
    bias_wa, dist_wa = _window_bias(tab_a, pad_a)
    bias_wb, dist_wb = _window_bias(tab_b, pad_b)
    sink_b = sinks.reshape(Gb, Rb)

    def block(bidx):
        t0 = bidx * Q_BLOCK
        t_pos = t0 + jnp.arange(Q_BLOCK)
        qa = lax.dynamic_slice_in_dim(q_a, t0, Q_BLOCK, axis=1)
        qb = lax.dynamic_slice_in_dim(q_b, t0, Q_BLOCK, axis=1)
        s_c = jnp.einsum('bqgrd,bngd->bgrqn', qa, k_cmp).astype(f32) * ATTN_SCALE
        dist_c = t_pos[:, None] - cmp_end[None, :]
        bias_c = jnp.transpose(tab_a[_rel_bucket(dist_c)], (2, 3, 0, 1)).astype(f32)
        p_c = _masked_softmax(s_c + bias_c, dist_c >= 0)
        o_c = jnp.einsum('bgrqn,bngd->bqgrd', p_c, v_cmp.astype(f32))
        imp = jnp.einsum('bgrqn,nj->bgqj', p_c, cmp_to_sel)
        back = (t_pos // SEL_BLOCK)[:, None] - sel_ids[None, :]
        forced = (sel_ids[None, :] < SEL_INIT_BLOCKS) | ((back >= 0) & (back < SEL_LOCAL_BLOCKS))
        score = jnp.where(back >= 0, jnp.where(forced, SEL_FORCE, imp), -1.0)
        top_val, top_idx = lax.top_k(score, n_top)
        k_g = k_sel_blk[bi, gi, top_idx].reshape(bsz, G, Q_BLOCK, n_tok, HEAD_DIM)
        v_g = v_sel_blk[bi, gi, top_idx].reshape(bsz, G, Q_BLOCK, n_tok, HEAD_DIM)
        pos = (top_idx[..., None] * SEL_BLOCK + jnp.arange(SEL_BLOCK)).reshape(bsz, G, Q_BLOCK, n_tok)
        valid = jnp.repeat(top_val >= 0.0, SEL_BLOCK, axis=-1)
        mask_s = (pos <= t_pos[None, None, :, None]) & valid
        bias_s = jnp.transpose(tab_a[_rel_bucket(t_pos[None, None, :, None] - pos), gi], (0, 1, 4, 2, 3)).astype(f32)
        s_s = jnp.einsum('bqgrd,bgqkd->bgrqk', qa, k_g).astype(f32) * ATTN_SCALE + bias_s
        p_s = _masked_softmax(s_s, mask_s[:, :, None])
        o_s = jnp.einsum('bgrqk,bgqkd->bqgrd', p_s, v_g.astype(f32))
        o_w = _window_attend(qa, kw_pad, vw_pad, t0, pad_a, NSA_WINDOW, bias_wa, dist_wa, None)
        o_b = _window_attend(qb, kb_pad, vb_pad, t0, pad_b, SWA_WINDOW, bias_wb, dist_wb, sink_b)
        return o_c, o_s, o_w, o_b

    o_c, o_s, o_w, o_b = lax.map(block, jnp.arange(seq // Q_BLOCK, dtype=jnp.int32))
    o_c, o_s, o_w, o_b = _unblock(o_c), _unblock(o_s), _unblock(o_w), _unblock(o_b)

    ga = jax.nn.sigmoid(g_a.astype(f32)).reshape(bsz, seq, G, R, 3)
    o_a = ga[..., 0:1] * o_c + ga[..., 1:2] * o_s + ga[..., 2:3] * o_w
    o_a = o_a.reshape(bsz, seq, NSA_Q_W).astype(x.dtype)
    o_b = o_b.reshape(bsz, seq, SWA_Q_W).astype(x.dtype)
    merged = jax.nn.sigmoid(gate_a) * (o_a @ proj_a) + jax.nn.sigmoid(gate_b) * (o_b @ proj_b)
    return merged @ w_out


def _moe_ffn(x, w_router, router_bias, e_gate, e_up, e_down, s_gate, s_up, s_down):
    f32 = jnp.float32
    bsz, seq, d = x.shape
    n_tokens = bsz * seq
    xt = x.reshape(n_tokens, d)
    scores = jax.nn.sigmoid((xt @ w_router).astype(f32))
    choice = scores + router_bias.astype(f32)
    per_group = N_EXPERTS // N_EXPERT_GROUPS
    grp_score = jnp.sum(lax.top_k(choice.reshape(n_tokens, N_EXPERT_GROUPS, per_group), 2)[0], -1)
    _, grp_idx = lax.top_k(grp_score, TOPK_EXPERT_GROUPS)
    grp_keep = jnp.any(grp_idx[..., None] == jnp.arange(N_EXPERT_GROUPS), axis=1)
    keep = jnp.repeat(grp_keep, per_group, axis=1)
    _, eidx = lax.top_k(jnp.where(keep, choice, -jnp.inf), TOP_K)
    gate = jnp.take_along_axis(scores, eidx, axis=1)
    gate = gate / jnp.sum(gate, -1, keepdims=True) * ROUTED_SCALE

    n_assign = n_tokens * TOP_K
    n_blocks = (n_assign + N_EXPERTS * (MOE_BLOCK - 1) + MOE_BLOCK - 1) // MOE_BLOCK
    n_rows = n_blocks * MOE_BLOCK
    flat_e = eidx.reshape(n_assign).astype(jnp.int32)
    flat_t = jnp.repeat(jnp.arange(n_tokens, dtype=jnp.int32), TOP_K)
    flat_w = gate.reshape(n_assign)
    order = jnp.argsort(flat_e)
    e_s, t_s, w_s = flat_e[order], flat_t[order], flat_w[order]
    counts = jnp.bincount(flat_e, length=N_EXPERTS).astype(jnp.int32)
    starts = jnp.cumsum(counts) - counts
    padded = (counts + MOE_BLOCK - 1) // MOE_BLOCK * MOE_BLOCK
    pends = jnp.cumsum(padded)
    pstarts = pends - padded
    dest = pstarts[e_s] + jnp.arange(n_assign, dtype=jnp.int32) - starts[e_s]
    row_tok = jnp.full((n_rows,), n_tokens, jnp.int32).at[dest].set(t_s)
    row_w = jnp.zeros((n_rows,), f32).at[dest].set(w_s)
    blk_e = jnp.minimum(jnp.searchsorted(pends, jnp.arange(n_blocks) * MOE_BLOCK, side='right'),
                        N_EXPERTS - 1).astype(jnp.int32)
    xpad = jnp.concatenate([xt, jnp.zeros((1, d), xt.dtype)], axis=0)

    def step(acc, inp):
        tok, wr, e = inp
        xb = xpad[tok]
        hb = jax.nn.silu(xb @ e_gate[e]) * (xb @ e_up[e])
        yb = (hb @ e_down[e]).astype(f32) * wr[:, None]
        return acc.at[tok].add(yb), None

    acc, _ = lax.scan(step, jnp.zeros((n_tokens + 1, d), f32),
                      (row_tok.reshape(n_blocks, MOE_BLOCK), row_w.reshape(n_blocks, MOE_BLOCK), blk_e))
    routed = acc[:n_tokens].astype(x.dtype)
    shared = (jax.nn.silu(xt @ s_gate) * (xt @ s_up)) @ s_down
    return (routed + shared).reshape(bsz, seq, d)


def setup_inputs(seed: int = 0) -> dict:
    key = jax.random.key(seed)
    ks = jax.random.split(key, 24)
    f32 = jnp.float32
    L = DEPTH

    def nrm(k, shape, scale):
        return jax.random.normal(k, shape, f32) * scale

    return {
        'x': nrm(ks[0], (BATCH, SEQ, D_MODEL), 1.0),
        'w_in': nrm(ks[1], (L, D_MODEL, IN_WIDTH), D_MODEL ** -0.5),
        'cmp_pe': nrm(ks[2], (L, 2, CMP_BLOCK, HEAD_DIM), 0.1),
        'cmp_w1': nrm(ks[3], (L, 2, CMP_BLOCK * HEAD_DIM, CMP_HIDDEN), (CMP_BLOCK * HEAD_DIM) ** -0.5),
        'cmp_b1': nrm(ks[4], (L, 2, CMP_HIDDEN), 0.01),
        'cmp_w2': nrm(ks[5], (L, 2, CMP_HIDDEN, HEAD_DIM), CMP_HIDDEN ** -0.5),
        'attn_sinks': nrm(ks[6], (L, SWA_HEADS), 0.5),
        'rel_bias_table': nrm(ks[7], (REL_BUCKETS, N_BIAS_HEADS), 0.5),
        'proj_a': nrm(ks[8], (L, NSA_Q_W, D_MODEL), NSA_Q_W ** -0.5),
        'proj_b': nrm(ks[9], (L, SWA_Q_W, D_MODEL), SWA_Q_W ** -0.5),
        'w_out': nrm(ks[10], (L, D_MODEL, D_MODEL), D_MODEL ** -0.5 * DN_BETA),
        'ln1_g': 1.0 + nrm(ks[11], (L, D_MODEL), 0.02),
        'ln1_b': nrm(ks[12], (L, D_MODEL), 0.02),
        'w_router': nrm(ks[13], (L, D_MODEL, N_EXPERTS), D_MODEL ** -0.5),
        'router_bias': nrm(ks[14], (L, N_EXPERTS), 0.01),
        'expert_w_gate': nrm(ks[15], (L, N_EXPERTS, D_MODEL, EXPERT_HIDDEN), D_MODEL ** -0.5),
        'expert_w_up': nrm(ks[16], (L, N_EXPERTS, D_MODEL, EXPERT_HIDDEN), D_MODEL ** -0.5),
        'expert_w_down': nrm(ks[17], (L, N_EXPERTS, EXPERT_HIDDEN, D_MODEL), EXPERT_HIDDEN ** -0.5 * DN_BETA),
        'shared_w_gate': nrm(ks[18], (L, D_MODEL, SHARED_HIDDEN), D_MODEL ** -0.5),
        'shared_w_up': nrm(ks[19], (L, D_MODEL, SHARED_HIDDEN), D_MODEL ** -0.5),
        'shared_w_down': nrm(ks[20], (L, SHARED_HIDDEN, D_MODEL), SHARED_HIDDEN ** -0.5 * DN_BETA),
        'ln2_g': 1.0 + nrm(ks[21], (L, D_MODEL), 0.02),
        'ln2_b': nrm(ks[22], (L, D_MODEL), 0.02),
    }


def reference(x, w_in, cmp_pe, cmp_w1, cmp_b1, cmp_w2, attn_sinks, rel_bias_table, proj_a, proj_b, w_out,
              ln1_g, ln1_b, w_router, router_bias, expert_w_gate, expert_w_up, expert_w_down,
              shared_w_gate, shared_w_up, shared_w_down, ln2_g, ln2_b):
    h = x
    for l in range(DEPTH):
        mix = _token_mixer(h, w_in[l], cmp_pe[l], cmp_w1[l], cmp_b1[l], cmp_w2[l], attn_sinks[l],
                           rel_bias_table, proj_a[l], proj_b[l], w_out[l])
        h = _layer_norm(DN_ALPHA * h + mix, ln1_g[l], ln1_b[l])
        ffn = _moe_ffn(h, w_router[l], router_bias[l], expert_w_gate[l], expert_w_up[l], expert_w_down[l],
                       shared_w_gate[l], shared_w_up[l], shared_w_down[l])
        h = _layer_norm(DN_ALPHA * h + ffn, ln2_g[l], ln2_b[l])
    return h
```

```cpp
#include <hip/hip_runtime.h>
#include <stdint.h>
#include <math.h>
#include <cstdio>

#define GAS __attribute__((address_space(1)))
#define LAS __attribute__((address_space(3)))
typedef unsigned short bf16_t;
typedef short bf16x8 __attribute__((ext_vector_type(8)));
typedef float f32x4 __attribute__((ext_vector_type(4)));
typedef float f32x2 __attribute__((ext_vector_type(2)));
typedef unsigned u32x4 __attribute__((ext_vector_type(4)));
typedef unsigned u32x2 __attribute__((ext_vector_type(2)));
typedef GAS unsigned gu32;
typedef short v4i16_t __attribute__((ext_vector_type(4)));

constexpr int D = 1024, NB = 8, S = 8192, T = NB * S;
constexpr int INW = 4120;
constexpr int O_QA = 0, O_KC = 512, O_VC = 640, O_KS = 768, O_VS = 896, O_KW = 1024, O_VW = 1152, O_GA = 1280,
              O_QB = 1304, O_KB = 1816, O_VB = 1944, O_GATEA = 2072, O_GATEB = 3096;
constexpr int QW = 4352, QP = 2304, GP = 2048;
constexpr int C_QA = 0, C_KC = 512, C_VC = 640, C_KS = 768, C_VS = 896, C_KW = 1024, C_VW = 1152,
              C_QB = 1280, C_KB = 1792, C_VB = 1920, C_GA = 2048, C_GATEA = 2304, C_GATEB = 3328;
constexpr int NCMP = 511, NSEL = 128;
constexpr int NE = 256, TOPK = 8, EH = 256;
constexpr float DN_ALPHA = 1.189207115002721f;
constexpr float LN_EPS = 1e-5f;
constexpr int MB = 64;
constexpr int NASSIGN = T * TOPK;
constexpr int NTILES_MAX = (NASSIGN + NE * (MB - 1) + MB - 1) / MB;
constexpr int NROWS_MAX = NTILES_MAX * MB;

__device__ const unsigned char BUCKET[128] = {0, 1, 2, 3, 4, 5, 6, 7, 8, 9, 10, 11, 12, 13, 14, 15, 16, 16, 16, 17, 17, 18, 18, 18, 19, 19, 19, 20, 20, 20, 20, 21, 21, 21, 21, 22, 22, 22, 22, 22, 23, 23, 23, 23, 23, 23, 24, 24, 24, 24, 24, 24, 25, 25, 25, 25, 25, 25, 25, 26, 26, 26, 26, 26, 26, 26, 26, 27, 27, 27, 27, 27, 27, 27, 27, 27, 27, 28, 28, 28, 28, 28, 28, 28, 28, 28, 28, 29, 29, 29, 29, 29, 29, 29, 29, 29, 29, 29, 29, 30, 30, 30, 30, 30, 30, 30, 30, 30, 30, 30, 30, 30, 30, 31, 31, 31, 31, 31, 31, 31, 31, 31, 31, 31, 31, 31, 31, 31};
__device__ __forceinline__ int bucket_of(int dist) { return dist >= 128 ? 31 : (int)BUCKET[dist < 0 ? 0 : dist]; }
__device__ __forceinline__ float sigmoidf_(float x) { return 1.0f / (1.0f + expf(-x)); }
__device__ __forceinline__ float bf2f(bf16_t h) { return __builtin_bit_cast(float, (unsigned)h << 16); }
__device__ __forceinline__ unsigned f2bf(float f) { unsigned u = __builtin_bit_cast(unsigned, f); return (u + 0x7fffu + ((u >> 16) & 1u)) >> 16; }
__device__ __forceinline__ unsigned pk2(float lo, float hi) { return f2bf(lo) | (f2bf(hi) << 16); }
typedef __bf16 bf16x2_t __attribute__((ext_vector_type(2)));
__device__ __forceinline__ unsigned cvt_pk_bf16(float lo, float hi) { const f32x2 v = {lo, hi}; const bf16x2_t b = __builtin_convertvector(v, bf16x2_t); return __builtin_bit_cast(unsigned, b); }

constexpr size_t MiB = 1u << 20;
constexpr size_t WS_CTL = 0, CTL_ZERO_BYTES = 1 * MiB;
constexpr size_t WS_WINT = 1 * MiB;
constexpr size_t WS_PROJT = 10 * MiB;
constexpr size_t WS_WOUTT = 12 * MiB;
constexpr size_t WS_WRT = 14 * MiB;
constexpr size_t WS_WGU = 20 * MiB;
constexpr size_t WS_WD = 277 * MiB;
constexpr size_t WS_GATES = 406 * MiB;
constexpr size_t WS_XB = 534 * MiB;
constexpr size_t WS_QKV = 662 * MiB;
constexpr size_t WS_PRE = 662 * MiB;
constexpr size_t WS_HB = 406 * MiB;
constexpr size_t WS_Y = 552 * MiB;
constexpr size_t WS_YS = 892 * MiB;
constexpr size_t WS_LOGITS = 790 * MiB;
constexpr size_t WS_EIDX = 854 * MiB, WS_GATE = 856 * MiB, WS_POS = 858 * MiB;
constexpr size_t WS_LIST = 860 * MiB;
constexpr size_t DO_XB = 0, DO_MERGED = 0, DO_OAB = 128 * MiB, DO_H1B = 128 * MiB;
constexpr size_t WS_KCMP = 1020 * MiB, WS_VCMP = 1021 * MiB;
constexpr size_t WS_NEED = 1030 * MiB;
constexpr int NCH = 2, CHT = T / NCH, CROWS = 9 * CHT;
constexpr int CW_CNT = 32768, CSTR = 16;
constexpr int CW_BAR = 4096;
constexpr int CW_ATTQ = 65536;

#define XB_TMO      128
#define XB_XCNT(j)  (256  + 64 * (j))
#define XB_XSUB(j)  (1280 + 64 * (j))
#define XB_XGEN(j)  (2304 + 64 * (j))
#define XB_TOP      3328
#define XB_TOPGEN   3392
#define XCD_BAR_WORDS 3456
#define XB_SPIN_CAP (1u << 18)
__device__ __forceinline__ unsigned xb_ld(unsigned* p)              { return __hip_atomic_load(p, __ATOMIC_RELAXED, __HIP_MEMORY_SCOPE_AGENT); }
__device__ __forceinline__ unsigned xb_add(unsigned* p, unsigned v) { return __hip_atomic_fetch_add(p, v, __ATOMIC_RELAXED, __HIP_MEMORY_SCOPE_AGENT); }
__device__ __forceinline__ unsigned xb_xcc_id() { return (unsigned)__builtin_amdgcn_s_getreg((3 << 11) | 20) & 0xFu; }
#define XB_SPIN(cond, bar) do { unsigned _sp = 0; while (cond) { __builtin_amdgcn_s_sleep(1); \
    if ((++_sp & 255u) == 0u) { if (xb_ld(&(bar)[XB_TMO])) break; if (_sp > XB_SPIN_CAP) { atomicAdd(&(bar)[XB_TMO], 1u); break; } } } } while (0)
struct XcdBarrier { unsigned* bar; unsigned x; volatile LAS unsigned* st; };
__device__ __forceinline__ XcdBarrier xcd_barrier_post(unsigned* bar, volatile LAS unsigned* st) {
    XcdBarrier b; b.bar = bar; b.x = xb_xcc_id(); b.st = st;
    if (threadIdx.x == 0) (void)xb_add(&bar[XB_XCNT(b.x)], 1u);
    return b;
}
__device__ __forceinline__ void xcd_barrier_complete(unsigned* bar, unsigned x, unsigned& nloc, unsigned& nx) {
    const unsigned G = gridDim.x * gridDim.y * gridDim.z;
    unsigned sum, cnt, mine, sp = 0u;
    for (;;) {
        sum = 0u; cnt = 0u; mine = 0u;
#pragma unroll
        for (unsigned j = 0; j < 16; ++j) { const unsigned c = xb_ld(&bar[XB_XCNT(j)]); sum += c; cnt += (c > 0u) ? 1u : 0u; mine = (j == x) ? c : mine; }
        if (sum == G) break;
        __builtin_amdgcn_s_sleep(1);
        if ((++sp & 255u) == 0u) { if (xb_ld(&bar[XB_TMO])) break; if (sp > XB_SPIN_CAP) { atomicAdd(&bar[XB_TMO], 1u); break; } }
    }
    nloc = mine > 0u ? mine : 1u; nx = cnt > 0u ? cnt : 1u;
}
__device__ __forceinline__ void xcd_barrier(const XcdBarrier& b) {
    asm volatile("s_waitcnt vmcnt(0)" ::: "memory");
    __syncthreads();
    if (threadIdx.x == 0) {
        unsigned* bar = b.bar;
        __builtin_amdgcn_s_waitcnt(0);
        unsigned nloc = b.st[0], nx = b.st[1];
        if (nloc == 0u) { xcd_barrier_complete(bar, b.x, nloc, nx); b.st[0] = nloc; b.st[1] = nx; }
        const unsigned old = xb_add(&bar[XB_XSUB(b.x)], 1u);
        const unsigned gen = old / nloc;
        if (old + 1u == (gen + 1u) * nloc) {
            __builtin_amdgcn_fence(__ATOMIC_RELEASE, "agent");
            asm volatile("s_waitcnt vmcnt(0)" ::: "memory");
            const unsigned og = xb_add(&bar[XB_TOP], 1u);
            const unsigned tg = og / nx;
            if (og + 1u == (tg + 1u) * nx) xb_add(&bar[XB_TOPGEN], 1u);
            else XB_SPIN(xb_ld(&bar[XB_TOPGEN]) == tg, bar);
            __builtin_amdgcn_fence(__ATOMIC_ACQUIRE, "agent");
            xb_add(&bar[XB_XGEN(b.x)], 1u);
            asm volatile("s_waitcnt vmcnt(0)" ::: "memory");
        } else {
            XB_SPIN(xb_ld(&bar[XB_XGEN(b.x)]) == gen, bar);
            __builtin_amdgcn_fence(__ATOMIC_ACQUIRE, "agent");
            asm volatile("s_waitcnt vmcnt(0)" ::: "memory");
        }
    }
    __syncthreads();
}

namespace pg8 {
constexpr int BM = 256, BK = 64, HALF = 128, HTB = HALF * BK * 2, STAGE_BYTES = 8 * HTB;
__host__ __device__ __forceinline__ int lds_byte(int r, int c) { const int st = (r >> 4) * 2 + (c >> 5), rr = r & 15, cc = c & 31, ob = rr * 64 + cc * 2; return st * 1024 + (ob ^ (((ob >> 9) & 1) << 5)); }
__host__ __device__ __forceinline__ void stage_rc(int b, int& R, int& C) { const int st = b / 1024, sb = b % 1024, swz = sb ^ (((sb >> 9) & 1) << 5); R = (st >> 1) * 16 + swz / 64; C = (st & 1) * 32 + (swz % 64) / 2; }
__host__ __device__ __forceinline__ int perm32(int rho) { const int n = rho >> 4, i = rho & 15; return 8 * (i >> 2) + 4 * n + (i & 3); }

struct Unit { const char* A; const char* B; int row0, col0, nrows, aux, e, ti, ord; };

template <class Epi, class Sched, bool ALIGN_EPI, bool GATHER, bool MIDHOOK, int EPI_VM = 0>
__device__ __forceinline__ void gemm_phase(LAS unsigned char* lds, const int K, const Sched& S, const Epi& E) {
    const int tid = threadIdx.x, wid = __builtin_amdgcn_readfirstlane(tid >> 6), lane = tid & 63, wr = wid >> 2, wc = wid & 3, fr = lane & 15, fq = lane >> 4;
    const int nt = K / BK;
    int Rr[2], Cc[2];
    unsigned vcur[2][2], vnxt[2][2], voffB[2];
#pragma unroll
    for (int i = 0; i < 2; ++i) { int R, C; stage_rc(tid * 16 + i * 8192, R, C); Rr[i] = R; Cc[i] = C; const int Rb = (int)Epi::PERM == 2 ? (64 * (R >> 5) + 16 * ((R & 15) >> 2) + 4 * ((R >> 4) & 1) + (R & 3)) : (Epi::PERM ? ((R & ~31) + perm32(R & 31)) : R);
        voffB[i] = (unsigned)(Rb * K + C) * 2u;
#pragma unroll
        for (int h = 0; h < 2; ++h) { vcur[h][i] = (unsigned)((h * HALF + R) * K + C) * 2u; vnxt[h][i] = vcur[h][i]; } }
    const size_t kstep = (size_t)(BK * 2);
    const size_t hstep = (size_t)HALF * K * 2;
    const size_t hstepB = (int)Epi::PERM == 2 ? (size_t)8 * K * 2 : hstep;
    const unsigned ldsw = (unsigned)wid * 1024u;
    const int aoff = lds_byte(wr * 64 + fr, fq * 8), boff = lds_byte(wc * 32 + fr, fq * 8);
#define PG8_SA(b, h) (((b) * 2 + (h)) * HTB)
#define PG8_SB(b, h) ((4 + (b) * 2 + (h)) * HTB)
#define PG8_STAGE(bufoff, gbase, voff) do { _Pragma("unroll") for (int _i = 0; _i < 2; ++_i) \
        __builtin_amdgcn_global_load_lds((const unsigned*)((const char*)(gbase) + (voff)[_i]), (LAS unsigned*)(lds + (bufoff) + ldsw + _i * 8192), 16, 0, 0); } while (0)
#define PG8_LDA(dst, b, h) do { _Pragma("unroll") for (int m = 0; m < 4; ++m) _Pragma("unroll") for (int k = 0; k < 2; ++k) dst[m][k] = *(const LAS bf16x8*)(lds + PG8_SA(b, h) + aoff + m * 2048 + k * 1024); } while (0)
#define PG8_LDB(dst, b, h) do { _Pragma("unroll") for (int n = 0; n < 2; ++n) _Pragma("unroll") for (int k = 0; k < 2; ++k) dst[n][k] = *(const LAS bf16x8*)(lds + PG8_SB(b, h) + boff + n * 2048 + k * 1024); } while (0)
#define PG8_MMA(ai, bj, At, Bt) do { __builtin_amdgcn_s_setprio(1); _Pragma("unroll") for (int m = 0; m < 4; ++m) _Pragma("unroll") for (int n = 0; n < 2; ++n) _Pragma("unroll") for (int k = 0; k < 2; ++k) \
        acc[ai][bj][m][n] = __builtin_amdgcn_mfma_f32_16x16x32_bf16(Bt[n][k], At[m][k], acc[ai][bj][m][n], 0, 0, 0); __builtin_amdgcn_s_setprio(0); } while (0)
#define PG8_WAIT_V(n) asm volatile("s_waitcnt vmcnt(" #n ")" ::: "memory")
#define PG8_WAIT_L(n) asm volatile("s_waitcnt lgkmcnt(" #n ")" ::: "memory")
#define PG8_BAR __builtin_amdgcn_s_barrier()
#define PG8_SCHED __builtin_amdgcn_sched_barrier(0)
    Unit cur, nxt; int ui = 0; int pfn = 1;
    if (!S.next(0, cur)) return;
    if constexpr (GATHER) {
#pragma unroll
        for (int h = 0; h < 2; ++h)
#pragma unroll
            for (int i = 0; i < 2; ++i) vcur[h][i] = S.arow_off(cur, h * HALF + Rr[i]) + (unsigned)Cc[i] * 2u;
    }
    f32x4 acc[2][2][4][2];
#pragma unroll
    for (int a = 0; a < 2; ++a)
#pragma unroll
        for (int b = 0; b < 2; ++b)
#pragma unroll
            for (int m = 0; m < 4; ++m)
#pragma unroll
                for (int n = 0; n < 2; ++n) acc[a][b][m][n] = (f32x4){0.f, 0.f, 0.f, 0.f};
    bf16x8 At[4][2], B0[2][2], B1[2][2];
    const char* cA = cur.A; const char* cB = cur.B;
    PG8_STAGE(PG8_SB(0, 0), cB, voffB); PG8_STAGE(PG8_SB(0, 1), cB + hstepB, voffB); PG8_STAGE(PG8_SA(0, 0), cA, vcur[0]); PG8_STAGE(PG8_SA(0, 1), cA, vcur[1]);
    if (wr == 1) PG8_BAR;
    PG8_WAIT_V(2); PG8_BAR;
    PG8_STAGE(PG8_SB(1, 0), cB + kstep, voffB); PG8_STAGE(PG8_SA(1, 0), cA + kstep, vcur[0]); PG8_STAGE(PG8_SB(1, 1), cB + hstepB + kstep, voffB);
    PG8_WAIT_V(6); PG8_BAR;
    for (;;) {
        const bool has_next = S.next(ui + 1, nxt);
        const char* nA = has_next ? nxt.A : cA; const char* nB = has_next ? nxt.B : cB;
        if constexpr (GATHER) {
#pragma unroll
            for (int h = 0; h < 2; ++h)
#pragma unroll
                for (int i = 0; i < 2; ++i) vnxt[h][i] = has_next ? (S.arow_off(nxt, h * HALF + Rr[i]) + (unsigned)Cc[i] * 2u) : vcur[h][i];
        }
        for (int t = 0; t < nt; t += 2) {
            const bool last = (t == nt - 2);
            if constexpr (MIDHOOK) { if (t == nt / 2) E.mid(acc, cur, wr, wc, fr, fq); }
            const char* a1 = cA + (size_t)(t + 1) * kstep;
            const char* a2 = last ? nA : cA + (size_t)(t + 2) * kstep; const char* b2 = last ? nB : cB + (size_t)(t + 2) * kstep;
            const char* a3 = a2 + kstep; const char* b3 = b2 + kstep;
            unsigned va2[2][2];
#pragma unroll
            for (int h = 0; h < 2; ++h)
#pragma unroll
                for (int i = 0; i < 2; ++i) va2[h][i] = (GATHER && last) ? vnxt[h][i] : vcur[h][i];
            PG8_LDB(B0, 0, 0); PG8_LDB(B1, 0, 1); PG8_SCHED; PG8_LDA(At, 0, 0); PG8_STAGE(PG8_SA(1, 1), a1, vcur[1]);
            static_assert(EPI_VM == 0 || EPI_VM == 8 || EPI_VM == 16, "EPI_VM");
            if (EPI_VM == 8) asm volatile("s_cmp_lg_u32 %0, 0\n\ts_cbranch_scc1 1f\n\ts_waitcnt vmcnt(16)\n\ts_branch 2f\n1:\n\ts_waitcnt vmcnt(8)\n2:" :: "s"(__builtin_amdgcn_readfirstlane(t | pfn)) : "memory", "scc");
            else if (EPI_VM == 16) asm volatile("s_cmp_lg_u32 %0, 0\n\ts_cbranch_scc1 1f\n\ts_waitcnt vmcnt(24)\n\ts_branch 2f\n1:\n\ts_waitcnt vmcnt(8)\n2:" :: "s"(__builtin_amdgcn_readfirstlane(t | pfn)) : "memory", "scc");
            else PG8_WAIT_V(8);
            PG8_WAIT_L(0); PG8_BAR; PG8_MMA(0, 0, At, B0); PG8_MMA(0, 1, At, B1); PG8_BAR; PG8_SCHED;
            PG8_LDA(At, 0, 1); PG8_STAGE(PG8_SB(0, 0), b2, voffB); PG8_STAGE(PG8_SB(0, 1), b2 + hstepB, voffB); PG8_STAGE(PG8_SA(0, 0), a2, va2[0]);
            PG8_WAIT_V(8); PG8_WAIT_L(0); PG8_BAR; PG8_MMA(1, 0, At, B0); PG8_MMA(1, 1, At, B1); PG8_BAR; PG8_SCHED;
            PG8_LDB(B0, 1, 0); PG8_LDB(B1, 1, 1); PG8_SCHED; PG8_LDA(At, 1, 0); PG8_STAGE(PG8_SA(0, 1), a2, va2[1]);
            PG8_WAIT_V(8); PG8_WAIT_L(0); PG8_BAR; PG8_MMA(0, 0, At, B0); PG8_MMA(0, 1, At, B1); PG8_BAR; PG8_SCHED;
            PG8_LDA(At, 1, 1); PG8_STAGE(PG8_SB(1, 0), b3, voffB); PG8_STAGE(PG8_SB(1, 1), b3 + hstepB, voffB); PG8_STAGE(PG8_SA(1, 0), a3, va2[0]);
            PG8_WAIT_V(8); PG8_WAIT_L(0); PG8_BAR; PG8_MMA(1, 0, At, B0); PG8_MMA(1, 1, At, B1); PG8_BAR; PG8_SCHED;
        }
        if constexpr (ALIGN_EPI) { if (wr == 0) PG8_BAR; }
        E(acc, cur, wr, wc, fr, fq);
        if (!has_next) break;
#pragma unroll
        for (int a = 0; a < 2; ++a)
#pragma unroll
            for (int b = 0; b < 2; ++b)
#pragma unroll
                for (int m = 0; m < 4; ++m)
#pragma unroll
                    for (int n = 0; n < 2; ++n) acc[a][b][m][n] = (f32x4){0.f, 0.f, 0.f, 0.f};
        pfn = (cur.nrows == BM) ? 0 : 1;
        cur = nxt; cA = nA; cB = nB; ++ui;
        if constexpr (GATHER) {
#pragma unroll
            for (int h = 0; h < 2; ++h)
#pragma unroll
                for (int i = 0; i < 2; ++i) vcur[h][i] = vnxt[h][i];
        }
        if constexpr (ALIGN_EPI) { if (wr == 1) PG8_BAR; }
    }
    PG8_WAIT_V(0);
    if constexpr (!ALIGN_EPI) { if (wr == 0) PG8_BAR; }
    PG8_BAR;
#undef PG8_SA
#undef PG8_SB
#undef PG8_STAGE
#undef PG8_LDA
#undef PG8_LDB
#undef PG8_MMA
#undef PG8_WAIT_V
#undef PG8_WAIT_L
#undef PG8_BAR
#undef PG8_SCHED
}

struct DenseOrder {
    const char* A; const char* Bt; int K, nM, nN, nwg, G, c;
    __device__ void init(const void* A_, const void* Bt_, int M, int N, int K_, int G_, int c_) { A = (const char*)A_; Bt = (const char*)Bt_; K = K_; nM = M / BM; nN = N / BM; nwg = nM * nN; G = G_; c = c_; }
    __device__ __forceinline__ bool next(int i, Unit& u) const {
        const long L = (long)i * G + c; if (L >= nwg) return false;
        int wgid = (int)L; { const int q = nwg / 8, r = nwg % 8, xcd = wgid % 8, off = wgid / 8; wgid = (xcd < r ? xcd * (q + 1) : r * (q + 1) + (xcd - r) * q) + off; }
        const int nig = 8 * nN, gid = wgid / nig, fm = gid * 8, gsz = (nM - fm) < 8 ? (nM - fm) : 8;
        const int pm = fm + ((wgid % nig) % gsz), pn = (wgid % nig) / gsz;
        u.A = A + (size_t)pm * BM * K * 2; u.B = Bt + (size_t)pn * BM * K * 2; u.row0 = pm * BM; u.col0 = pn * BM; u.nrows = BM; u.aux = pn; u.e = 0; u.ti = 0; u.ord = 0; return true;
    }
    __device__ __forceinline__ unsigned arow_off(const Unit&, int) const { return 0u; }
};
}

struct EpiQKV {
    static constexpr bool PERM = true;
    bf16_t* O; bf16_t* Gt;
    __device__ __forceinline__ void operator()(const f32x4 (&acc)[2][2][4][2], const pg8::Unit& u, int wr, int wc, int fr, int fq) const {
        const bool sig = u.aux >= 9;
        const int row0 = u.row0 + wr * 64 + fr, col0 = u.col0 + wc * 32 + 8 * fq;
        bf16_t* const base = sig ? Gt - QP : O; const int pitch = sig ? GP : QP;
#pragma unroll
        for (int ai = 0; ai < 2; ++ai)
#pragma unroll
            for (int m = 0; m < 4; ++m) { bf16_t* rowp = base + (size_t)(row0 + ai * 128 + m * 16) * pitch + col0;
#pragma unroll
                for (int bj = 0; bj < 2; ++bj) { f32x4 v0 = acc[ai][bj][m][0], v1 = acc[ai][bj][m][1];
                    if (sig) {
#pragma unroll
                        for (int j = 0; j < 4; ++j) { v0[j] = __builtin_amdgcn_rcpf(1.0f + __builtin_amdgcn_exp2f(-1.4426950408889634f * v0[j])); v1[j] = __builtin_amdgcn_rcpf(1.0f + __builtin_amdgcn_exp2f(-1.4426950408889634f * v1[j])); }
                    }
                    if (sig) { int w0 = 0, w1 = 0;
                        w0 = __builtin_amdgcn_cvt_pk_fp8_f32(v0[0] * 256.f, v0[1] * 256.f, w0, false); w0 = __builtin_amdgcn_cvt_pk_fp8_f32(v0[2] * 256.f, v0[3] * 256.f, w0, true);
                        w1 = __builtin_amdgcn_cvt_pk_fp8_f32(v1[0] * 256.f, v1[1] * 256.f, w1, false); w1 = __builtin_amdgcn_cvt_pk_fp8_f32(v1[2] * 256.f, v1[3] * 256.f, w1, true);
                        u32x2 w; w.x = (unsigned)w0; w.y = (unsigned)w1;
                        *(u32x2*)((unsigned char*)Gt + (size_t)(row0 + ai * 128 + m * 16) * GP + (col0 - QP) + bj * 128) = w;
                    } else {
                        u32x4 w; w.x = cvt_pk_bf16(v0[0], v0[1]); w.y = cvt_pk_bf16(v0[2], v0[3]); w.z = cvt_pk_bf16(v1[0], v1[1]); w.w = cvt_pk_bf16(v1[2], v1[3]);
                        *(u32x4*)(rowp + bj * 128) = w; } } }
    }
};

struct EpiMerge {
    static constexpr int PERM = 2;
    const bf16_t* Gt; bf16_t* O;
    __device__ __forceinline__ void mid(f32x4 (&acc)[2][2][4][2], const pg8::Unit& u, int wr, int wc, int fr, int fq) const {
        int row0 = u.row0 + wr * 64 + fr, col0 = u.col0 + wc * 64 + 16 * fq;
        asm volatile("" : "+v"(row0), "+v"(col0));
#pragma unroll
        for (int ai = 0; ai < 2; ++ai)
#pragma unroll
            for (int m = 0; m < 4; ++m) { const unsigned char* gp = (const unsigned char*)Gt + (size_t)(row0 + ai * 128 + m * 16) * GP + col0;
                const u32x4 a = *(const u32x4*)gp, b = *(const u32x4*)(gp + 1024);
#pragma unroll
                for (int d = 0; d < 4; ++d) {
                    const f32x2 al = __builtin_amdgcn_cvt_pk_f32_fp8((int)a[d], false), ah = __builtin_amdgcn_cvt_pk_f32_fp8((int)a[d], true);
                    const f32x2 bl = __builtin_amdgcn_cvt_pk_f32_fp8((int)b[d], false), bh = __builtin_amdgcn_cvt_pk_f32_fp8((int)b[d], true);
                    acc[ai][d >> 1][m][d & 1][0] *= al.x * __builtin_amdgcn_rcpf(fmaxf(bl.x, 1e-30f)); acc[ai][d >> 1][m][d & 1][1] *= al.y * __builtin_amdgcn_rcpf(fmaxf(bl.y, 1e-30f));
                    acc[ai][d >> 1][m][d & 1][2] *= ah.x * __builtin_amdgcn_rcpf(fmaxf(bh.x, 1e-30f)); acc[ai][d >> 1][m][d & 1][3] *= ah.y * __builtin_amdgcn_rcpf(fmaxf(bh.y, 1e-30f)); }
                asm volatile("" ::: "memory"); }
    }
    __device__ __forceinline__ void operator()(const f32x4 (&acc)[2][2][4][2], const pg8::Unit& u, int wr, int wc, int fr, int fq) const {
        int row0 = u.row0 + wr * 64 + fr, col0 = u.col0 + wc * 64 + 16 * fq;
        asm volatile("" : "+v"(row0), "+v"(col0));
#pragma unroll
        for (int ai = 0; ai < 2; ++ai)
#pragma unroll
            for (int m = 0; m < 4; ++m) { const unsigned char* gp = (const unsigned char*)Gt + (size_t)(row0 + ai * 128 + m * 16) * GP + col0; bf16_t* rowp = O + (size_t)(row0 + ai * 128 + m * 16) * D + col0;
                const u32x4 b = *(const u32x4*)(gp + 1024); float v[16];
#pragma unroll
                for (int d = 0; d < 4; ++d) { const f32x2 bl = __builtin_amdgcn_cvt_pk_f32_fp8((int)b[d], false), bh = __builtin_amdgcn_cvt_pk_f32_fp8((int)b[d], true);
                    v[4 * d] = acc[ai][d >> 1][m][d & 1][0] * (fmaxf(bl.x, 1e-30f) * 0.00390625f); v[4 * d + 1] = acc[ai][d >> 1][m][d & 1][1] * (fmaxf(bl.y, 1e-30f) * 0.00390625f);
                    v[4 * d + 2] = acc[ai][d >> 1][m][d & 1][2] * (fmaxf(bh.x, 1e-30f) * 0.00390625f); v[4 * d + 3] = acc[ai][d >> 1][m][d & 1][3] * (fmaxf(bh.y, 1e-30f) * 0.00390625f); }
                u32x4 w0, w1; w0.x = cvt_pk_bf16(v[0], v[1]); w0.y = cvt_pk_bf16(v[2], v[3]); w0.z = cvt_pk_bf16(v[4], v[5]); w0.w = cvt_pk_bf16(v[6], v[7]);
                w1.x = cvt_pk_bf16(v[8], v[9]); w1.y = cvt_pk_bf16(v[10], v[11]); w1.z = cvt_pk_bf16(v[12], v[13]); w1.w = cvt_pk_bf16(v[14], v[15]);
                *(u32x4*)rowp = w0; *(u32x4*)(rowp + 8) = w1;
                asm volatile("" ::: "memory"); }
    }
};
struct EpiWout {
    static constexpr bool PERM = true;
    const bf16_t* X; bf16_t* O;
    __device__ __forceinline__ void operator()(const f32x4 (&acc)[2][2][4][2], const pg8::Unit& u, int wr, int wc, int fr, int fq) const {
        int row0 = u.row0 + wr * 64 + fr, col0 = u.col0 + wc * 32 + 8 * fq;
        asm volatile("" : "+v"(row0), "+v"(col0));
#pragma unroll
        for (int ai = 0; ai < 2; ++ai)
#pragma unroll
            for (int m = 0; m < 4; ++m) { const size_t off = (size_t)(row0 + ai * 128 + m * 16) * D + col0;
#pragma unroll
                for (int bj = 0; bj < 2; ++bj) { const u32x4 xv = *(const u32x4*)(X + off + bj * 128);
                    f32x4 x0, x1; x0[0] = __builtin_bit_cast(float, xv[0] << 16); x0[1] = __builtin_bit_cast(float, xv[0] & 0xffff0000u); x0[2] = __builtin_bit_cast(float, xv[1] << 16); x0[3] = __builtin_bit_cast(float, xv[1] & 0xffff0000u);
                    x1[0] = __builtin_bit_cast(float, xv[2] << 16); x1[1] = __builtin_bit_cast(float, xv[2] & 0xffff0000u); x1[2] = __builtin_bit_cast(float, xv[3] << 16); x1[3] = __builtin_bit_cast(float, xv[3] & 0xffff0000u);
                    const f32x4 v0 = x0 * DN_ALPHA + acc[ai][bj][m][0], v1 = x1 * DN_ALPHA + acc[ai][bj][m][1];
                    u32x4 w; w.x = cvt_pk_bf16(v0[0], v0[1]); w.y = cvt_pk_bf16(v0[2], v0[3]); w.z = cvt_pk_bf16(v1[0], v1[1]); w.w = cvt_pk_bf16(v1[2], v1[3]);
                    *(u32x4*)(O + off + bj * 128) = w; }
                if (m & 1) asm volatile("" ::: "memory"); }
    }
};

__device__ __forceinline__ float wave_sum_x(float v) {
#pragma unroll
    for (int o = 1; o < 64; o <<= 1) v += __shfl_xor(v, o);
    return v;
}
__device__ __forceinline__ void ln_regs_to_bf16(const u32x4 a, const u32x4 c, bf16_t* orow, const f32x4 (&gv)[4], const f32x4 (&bv)[4], int lane) {
    float v[16];
#pragma unroll
    for (int j = 0; j < 4; ++j) { v[2 * j] = __builtin_bit_cast(float, a[j] << 16); v[2 * j + 1] = __builtin_bit_cast(float, a[j] & 0xffff0000u); v[8 + 2 * j] = __builtin_bit_cast(float, c[j] << 16); v[8 + 2 * j + 1] = __builtin_bit_cast(float, c[j] & 0xffff0000u); }
    float sm = 0.f;
#pragma unroll
    for (int j = 0; j < 16; ++j) sm += v[j];
    const float mean = wave_sum_x(sm) * (1.f / D); float s2 = 0.f;
#pragma unroll
    for (int j = 0; j < 16; ++j) { v[j] -= mean; s2 += v[j] * v[j]; }
    const float rstd = 1.f / sqrtf(wave_sum_x(s2) * (1.f / D) + LN_EPS);
    u32x4 o[2];
#pragma unroll
    for (int j = 0; j < 4; ++j) { const f32x4 gg = gv[j], bb = bv[j];
        const float y0 = v[4 * j] * rstd * gg.x + bb.x, y1 = v[4 * j + 1] * rstd * gg.y + bb.y, y2 = v[4 * j + 2] * rstd * gg.z + bb.z, y3 = v[4 * j + 3] * rstd * gg.w + bb.w;
        o[j >> 1][(j & 1) * 2] = pk2(y0, y1); o[j >> 1][(j & 1) * 2 + 1] = pk2(y2, y3); }
    *(u32x4*)(orow + 16 * lane) = o[0]; *(u32x4*)(orow + 16 * lane + 8) = o[1];
}

constexpr int NWAVES = 8;
constexpr int RING_BYTES = 131072, MISC_OFF = RING_BYTES + 320, LDS_BYTES = 147456;
struct EpiLogits {
    static constexpr bool PERM = false;
    float* O;
    __device__ __forceinline__ void operator()(const f32x4 (&acc)[2][2][4][2], const pg8::Unit& u, int wr, int wc, int fr, int fq) const {
        int row0 = u.row0 + wr * 64 + fr, col0 = u.col0 + wc * 32 + 4 * fq;
        asm volatile("" : "+v"(row0), "+v"(col0));
#pragma unroll
        for (int ai = 0; ai < 2; ++ai)
#pragma unroll
            for (int m = 0; m < 4; ++m) { const size_t off = (size_t)(row0 + ai * 128 + m * 16) * NE + col0;
#pragma unroll
                for (int bj = 0; bj < 2; ++bj)
#pragma unroll
                    for (int n = 0; n < 2; ++n) *(f32x4*)(O + off + bj * 128 + n * 16) = acc[ai][bj][m][n]; }
    }
};
struct MoeTables { LAS int* tn; LAS int* es; LAS int* us; };
struct MoeUnits { LAS int* rec; LAS int* cnt; LAS unsigned short* tok; };
template <int NPN> struct MoeOrder {
    MoeTables tb; MoeUnits mu; const char* Abase; const char* Bbase; size_t strideE, stridePN; size_t apitch;
    int chunk; int colw;
    __device__ __forceinline__ bool next(int i, pg8::Unit& u) const {
        if (i >= __builtin_amdgcn_readfirstlane(mu.cnt[0])) return false;
        const int e = __builtin_amdgcn_readfirstlane(mu.rec[4 * i]), ti = __builtin_amdgcn_readfirstlane(mu.rec[4 * i + 1]), pn = __builtin_amdgcn_readfirstlane(mu.rec[4 * i + 2]);
        const int ne = __builtin_amdgcn_readfirstlane(tb.tn[e]), e0 = __builtin_amdgcn_readfirstlane(tb.es[e]);
        u.e = e; u.ti = ti; u.aux = pn; u.ord = i; u.row0 = e0 + ti * 256; u.nrows = (ne - ti * 256) < 256 ? (ne - ti * 256) : 256; u.col0 = pn * colw;
        u.A = Abase + (size_t)u.row0 * apitch; u.B = Bbase + (size_t)e * strideE + (size_t)pn * stridePN;
        return true;
    }
    __device__ __forceinline__ unsigned arow_off(const pg8::Unit& u, int r) const { return (unsigned)(chunk * CHT + (int)mu.tok[u.ord * 256 + r]) * (unsigned)(D * 2); }
};
template <int NPN, bool GATHER> __device__ __forceinline__ void moe_units(const MoeTables& tb, const MoeUnits& mu, int G, int c, int tid, const unsigned short* list, int chunk) {
    __syncthreads();
    const int NU = tb.us[257] * NPN;
    if (tid < 24) {
        const long L = (long)tid * G + c;
        if (L < NU) {
            int wgid = (int)L; { const int q = NU / 8, r = NU % 8, xcd = wgid % 8, off = wgid / 8; wgid = (xcd < r ? xcd * (q + 1) : r * (q + 1) + (xcd - r) * q) + off; }
            const int rt = wgid / NPN, pn = wgid % NPN;
            int lo = 0, hi = 257;
            while (hi - lo > 1) { const int mid = (lo + hi) >> 1; if (tb.us[mid] <= rt) lo = mid; else hi = mid; }
            mu.rec[4 * tid] = lo; mu.rec[4 * tid + 1] = rt - tb.us[lo]; mu.rec[4 * tid + 2] = pn;
        }
    }
    const int n = c < NU ? (NU - 1 - c) / G + 1 : 0;
    if (tid == 0) mu.cnt[0] = n < 24 ? n : 24;
    __syncthreads();
    if (GATHER) {
        const int nn = n < 16 ? n : 16;
        for (int x = tid; x < nn * 256; x += NWAVES * 64) { const int ui = x >> 8, r = x & 255, e = mu.rec[4 * ui], ti = mu.rec[4 * ui + 1];
            const int nr = tb.tn[e] - ti * 256, rr = r < nr ? r : nr - 1; int tl = ti * 256 + rr;
            if (e < 256) tl = (int)list[((size_t)chunk * 256 + e) * CHT + tl];
            mu.tok[x] = (unsigned short)tl; }
        __syncthreads();
    }
}
struct EpiGLU {
    static constexpr bool PERM = true;
    bf16_t* HB;
    __device__ __forceinline__ void operator()(const f32x4 (&acc)[2][2][4][2], const pg8::Unit& u, int wr, int wc, int fr, int fq) const {
        int rt0 = wr * 64 + fr, col0 = u.col0 + wc * 32 + 8 * fq;
        asm volatile("" : "+v"(rt0), "+v"(col0));
#pragma unroll
        for (int ai = 0; ai < 2; ++ai)
#pragma unroll
            for (int m = 0; m < 4; ++m) { int rt = rt0 + ai * 128 + m * 16;
                asm volatile("" : "+v"(rt));
                float v[8];
#pragma unroll
                for (int j = 0; j < 8; ++j) { const float g = acc[ai][0][m][j >> 2][j & 3], up = acc[ai][1][m][j >> 2][j & 3];
                    v[j] = g * __builtin_amdgcn_rcpf(1.0f + __builtin_amdgcn_exp2f(-1.4426950408889634f * g)) * up; }
                u32x4 w; w.x = cvt_pk_bf16(v[0], v[1]); w.y = cvt_pk_bf16(v[2], v[3]); w.z = cvt_pk_bf16(v[4], v[5]); w.w = cvt_pk_bf16(v[6], v[7]);
                if (rt < u.nrows) *(u32x4*)(HB + (size_t)(u.row0 + rt) * EH + col0) = w; }
    }
};
struct EpiDown {
    static constexpr int PERM = 2;
    unsigned char* Y8; bf16_t* YS; const bf16_t* H1; int chunk;
    __device__ __forceinline__ void operator()(const f32x4 (&acc)[2][2][4][2], const pg8::Unit& u, int wr, int wc, int fr, int fq) const {
        int rt0 = wr * 64 + fr, col0 = u.col0 + wc * 64 + 16 * fq;
        asm volatile("" : "+v"(rt0), "+v"(col0));
        const bool shared = u.e == 256;
#pragma unroll
        for (int ai = 0; ai < 2; ++ai)
#pragma unroll
            for (int m = 0; m < 4; ++m) { int rt = rt0 + ai * 128 + m * 16;
                asm volatile("" : "+v"(rt));
                if (rt < u.nrows) {
                    float v[16];
#pragma unroll
                    for (int j = 0; j < 16; ++j) v[j] = acc[ai][j >> 3][m][(j >> 2) & 1][j & 3];
                    if (shared) { const bf16_t* hp = H1 + (size_t)(chunk * CHT + u.ti * 256 + rt) * D + col0; const u32x4 h0 = *(const u32x4*)hp, h1 = *(const u32x4*)(hp + 8);
#pragma unroll
                        for (int j = 0; j < 4; ++j) { v[2 * j] += DN_ALPHA * __builtin_bit_cast(float, h0[j] << 16); v[2 * j + 1] += DN_ALPHA * __builtin_bit_cast(float, h0[j] & 0xffff0000u);
                            v[8 + 2 * j] += DN_ALPHA * __builtin_bit_cast(float, h1[j] << 16); v[8 + 2 * j + 1] += DN_ALPHA * __builtin_bit_cast(float, h1[j] & 0xffff0000u); }
                        u32x4 w0, w1; w0.x = cvt_pk_bf16(v[0], v[1]); w0.y = cvt_pk_bf16(v[2], v[3]); w0.z = cvt_pk_bf16(v[4], v[5]); w0.w = cvt_pk_bf16(v[6], v[7]);
                        w1.x = cvt_pk_bf16(v[8], v[9]); w1.y = cvt_pk_bf16(v[10], v[11]); w1.z = cvt_pk_bf16(v[12], v[13]); w1.w = cvt_pk_bf16(v[14], v[15]);
                        bf16_t* yp = YS + (size_t)(u.ti * 256 + rt) * D + col0; *(u32x4*)yp = w0; *(u32x4*)(yp + 8) = w1;
                    } else { int w[4] = {0, 0, 0, 0};
#pragma unroll
                        for (int d = 0; d < 4; ++d) { w[d] = __builtin_amdgcn_cvt_pk_fp8_f32(v[4 * d] * 16.f, v[4 * d + 1] * 16.f, w[d], false); w[d] = __builtin_amdgcn_cvt_pk_fp8_f32(v[4 * d + 2] * 16.f, v[4 * d + 3] * 16.f, w[d], true); }
                        u32x4 ww; ww.x = (unsigned)w[0]; ww.y = (unsigned)w[1]; ww.z = (unsigned)w[2]; ww.w = (unsigned)w[3];
                        *(u32x4*)(Y8 + (size_t)(u.row0 + rt) * D + col0) = ww; } }
                asm volatile("" ::: "memory"); }
    }
};

constexpr size_t WS_W1T = 15 * MiB;
constexpr size_t WS_W2T = 16 * MiB;
constexpr size_t WS_C1 = 16 * MiB + 65536;
namespace att {
constexpr float LOG2E = 1.4426950408889634f;
constexpr float C2 = 0.125f * LOG2E;
constexpr float THR = 8.0f;
constexpr int NB = 2;
constexpr int L_KV = 0, L_IMP = 65536, L_SELM = 98304, L_UW = 99584, L_JL = 99616, L_BIAS = 99840, L_HID = 108288, L_END = 112640;
constexpr int MODE_C1 = 0, MODE_C2 = 1, MODE_SEL = 2, MODE_WIN = 3, MODE_SWA = 4;
struct Ctx {
    LAS unsigned char* lds; int tid, lane, wave;
    const bf16_t* qkv_b;
    const bf16_t* kc; const bf16_t* vc;
    int cur, g;
};
__device__ __forceinline__ float ex2(float x) { return __builtin_amdgcn_exp2f(x); }
__device__ __forceinline__ float colmax4(float x) { x = fmaxf(x, __shfl_xor(x, 16)); return fmaxf(x, __shfl_xor(x, 32)); }
__device__ __forceinline__ float col_sum4(float x) { x += __shfl_xor(x, 16); return x + __shfl_xor(x, 32); }
__device__ __forceinline__ float quad_sum(float x) {
    x += __builtin_bit_cast(float, __builtin_amdgcn_update_dpp(0u, __builtin_bit_cast(unsigned, x), 0xB1, 0xF, 0xF, true));
    x += __builtin_bit_cast(float, __builtin_amdgcn_update_dpp(0u, __builtin_bit_cast(unsigned, x), 0x4E, 0xF, 0xF, true));
    return x;
}
__device__ __forceinline__ void glds16(const void* gsrc, unsigned lds_dst) { unsigned keep;
    asm volatile("s_mov_b32 %0, m0\n\ts_mov_b32 m0, %2\n\ts_nop 0\n\tglobal_load_lds_dwordx4 %1, off\n\ts_mov_b32 m0, %0" : "=&s"(keep) : "v"(gsrc), "s"(lds_dst) : "memory"); }
template <int MODE> __device__ __forceinline__ void blk_dma(const Ctx& c, int j, int slot) {
    const int key = c.tid >> 3, chs = c.tid & 7;
    const int kch = chs ^ (key & 7), vch = chs ^ (((key >> 1) & 3) << 1);
    const unsigned dst = (unsigned)__builtin_amdgcn_readfirstlane((int)(unsigned)(uintptr_t)(c.lds + L_KV + slot * 16384 + c.wave * 1024));
    if (MODE <= MODE_C2) { const size_t o = (size_t)(64 * j + key) * 128;
        glds16(c.kc + o + kch * 8, dst);
        if (MODE == MODE_C2) glds16(c.vc + o + vch * 8, dst + 8192u);
    } else { constexpr int KC = MODE == MODE_SEL ? C_KS : (MODE == MODE_WIN ? C_KW : C_KB), VC = MODE == MODE_SEL ? C_VS : (MODE == MODE_WIN ? C_VW : C_VB);
        const bf16_t* rp = c.qkv_b + (size_t)(64 * j + key) * QP + c.g * 64;
        glds16(rp + KC + kch * 8, dst);
        glds16(rp + VC + vch * 8, dst + 8192u); }
}
struct NoDma { __device__ __forceinline__ void operator()(int) const {} };
template <int MODE, bool PRE = false, class NextDma = NoDma> __device__ __forceinline__ void branch(const Ctx& c, const bf16x8 (&Qf)[2][2], f32x4 (&O)[2][4], float (&m)[2], float (&l)[2], const float (&invl)[2], int nblk, int j0, int hh, int par = 0, NextDma nextdma = NoDma()) {
    const int lane = c.lane, q = lane >> 4, cc = lane & 15;
    const LAS unsigned char* jl = c.lds + L_JL;
    const LAS float* biasL = (const LAS float*)(c.lds + L_BIAS) + hh * 132;
    LAS float* impL = (LAS float*)(c.lds + L_IMP);
    const LAS unsigned* selm = (const LAS unsigned*)(c.lds + L_SELM);
    const float c31 = biasL[128];
    const int nstage = (nblk + NB - 1) / NB;
    if (!PRE) {
#pragma unroll
        for (int bi = 0; bi < NB; ++bi) if (bi < nblk) blk_dma<MODE>(c, (MODE == MODE_SEL) ? (int)jl[bi] : j0 + bi, par * NB + bi);
    }
    asm volatile("s_waitcnt vmcnt(0)" ::: "memory");
    __syncthreads();
    const int kaddr0 = cc * 128 + (((0 + q) ^ (lane & 7)) << 4), kaddr1 = cc * 128 + (((4 + q) ^ (lane & 7)) << 4);
    const int vsw = ((2 * q + (cc >> 3)) & 3) << 1, vkey = (4 * q + (cc >> 2)) * 128, vb = (cc & 3) >> 1, vwi = (cc & 1) * 8;
    for (int st = 0; st < nstage; ++st) {
        if (st + 1 < nstage) {
#pragma unroll
            for (int bi = 0; bi < NB; ++bi) { const int i2 = (st + 1) * NB + bi; if (i2 < nblk) blk_dma<MODE>(c, (MODE == MODE_SEL) ? (int)jl[i2] : j0 + i2, ((st + 1 + par) & 1) * NB + bi); }
        } else nextdma((st + 1 + par) & 1);
#pragma unroll
        for (int bi = 0; bi < NB; ++bi) {
            const int i = st * NB + bi;
            if (i >= nblk) break;
            const int j = (MODE == MODE_SEL) ? (int)jl[i] : j0 + i;
            const LAS unsigned char* Kb = c.lds + L_KV + (((st + par) & 1) * NB + bi) * 16384;
            const LAS unsigned char* Vb = Kb + 8192;
            const int back = c.cur - j;
            bool far;
            if (MODE <= MODE_C2) far = !(64 * (j + 1) > 4 * c.cur - 10);
            else far = back >= 3 && !(MODE == MODE_WIN && back == 8);
            bool act[2] = {true, true}, own[2] = {true, true};
            if (MODE == MODE_SEL) {
#pragma unroll
                for (int a = 0; a < 2; ++a) { const unsigned uw = selm[256 + (2 * c.wave + a) * 4 + (j >> 5)];
                    act[a] = __builtin_amdgcn_readfirstlane((uw >> (j & 31)) & 1u) != 0;
                    own[a] = (selm[(8 * c.wave + 4 * a + (cc >> 2)) * 4 + (j >> 5)] >> (j & 31)) & 1u; }
                if (!act[0] && !act[1]) continue;
            }
            bf16x8 Kf[4][2];
#pragma unroll
            for (int kt = 0; kt < 4; ++kt) { Kf[kt][0] = *(const LAS bf16x8*)(Kb + kt * 2048 + kaddr0); Kf[kt][1] = *(const LAS bf16x8*)(Kb + kt * 2048 + kaddr1); }
            f32x4 s[2][4];
#pragma unroll
            for (int a = 0; a < 2; ++a) {
                if (!act[a]) continue;
#pragma unroll
                for (int kt = 0; kt < 4; ++kt) {
                    s[a][kt] = __builtin_amdgcn_mfma_f32_16x16x32_bf16(Kf[kt][0], Qf[a][0], (f32x4){0.f, 0.f, 0.f, 0.f}, 0, 0, 0);
                    s[a][kt] = __builtin_amdgcn_mfma_f32_16x16x32_bf16(Kf[kt][1], Qf[a][1], s[a][kt], 0, 0, 0);
                }
            }
            bf16x8 Vf[4][2];
            if (MODE != MODE_C1) {
#pragma unroll
                for (int mt = 0; mt < 4; ++mt) { const int va = vkey + ((((2 * mt) ^ vsw) + vb) << 4) + vwi;
#pragma unroll
                    for (int k2 = 0; k2 < 2; ++k2) {
                        const v4i16_t lo = __builtin_amdgcn_ds_read_tr16_b64_v4i16((LAS v4i16_t*)(Vb + (2 * k2) * 2048 + va));
                        const v4i16_t hi = __builtin_amdgcn_ds_read_tr16_b64_v4i16((LAS v4i16_t*)(Vb + (2 * k2 + 1) * 2048 + va));
                        Vf[mt][k2] = (bf16x8){lo[0], lo[1], lo[2], lo[3], hi[0], hi[1], hi[2], hi[3]}; } }
            }
#pragma unroll
            for (int a = 0; a < 2; ++a) {
                if (!act[a]) continue;
                const int tl = 8 * c.wave + 4 * a + (cc >> 2);
                if (far) {
                    const float cb = own[a] ? c31 : -INFINITY;
#pragma unroll
                    for (int kt = 0; kt < 4; ++kt)
#pragma unroll
                        for (int r = 0; r < 4; ++r) s[a][kt][r] = fmaf(s[a][kt][r], C2, cb);
                } else if (MODE <= MODE_C2) {
                    const int dd0 = 64 * c.cur + tl - 1024 * j - 31;
#pragma unroll
                    for (int kt = 0; kt < 4; ++kt)
#pragma unroll
                        for (int r = 0; r < 4; ++r) { const int d = dd0 - 16 * (16 * kt + 4 * q + r);
                            s[a][kt][r] = fmaf(s[a][kt][r], C2, biasL[d < 0 ? 0 : (d > 128 ? 128 : d)]) + (d >= 0 ? 0.f : -INFINITY); }
                } else {
                    const int dd0 = 64 * back + tl;
                    const int hi_lim = (MODE == MODE_WIN) ? 512 : (MODE == MODE_SWA ? 128 : (1 << 30));
#pragma unroll
                    for (int kt = 0; kt < 4; ++kt)
#pragma unroll
                        for (int r = 0; r < 4; ++r) { const int d = dd0 - (16 * kt + 4 * q + r);
                            s[a][kt][r] = fmaf(s[a][kt][r], C2, biasL[d < 0 ? 0 : (d > 128 ? 128 : d)]) + (((unsigned)d < (unsigned)hi_lim && own[a]) ? 0.f : -INFINITY); }
                }
                if (MODE != MODE_C2) {
                    float bm = fmaxf(fmaxf(fmaxf(s[a][0][0], s[a][0][1]), fmaxf(s[a][0][2], s[a][0][3])), fmaxf(fmaxf(s[a][1][0], s[a][1][1]), fmaxf(s[a][1][2], s[a][1][3])));
                    bm = fmaxf(bm, fmaxf(fmaxf(fmaxf(s[a][2][0], s[a][2][1]), fmaxf(s[a][2][2], s[a][2][3])), fmaxf(fmaxf(s[a][3][0], s[a][3][1]), fmaxf(s[a][3][2], s[a][3][3]))));
                    if (__any(bm > m[a] + THR)) {
                        bm = colmax4(bm);
                        const float mn = fmaxf(m[a], bm);
                        const float alpha = (mn == m[a]) ? 1.0f : ex2(m[a] - mn);
                        m[a] = mn; l[a] *= alpha;
                        if (MODE != MODE_C1) {
#pragma unroll
                            for (int mt = 0; mt < 4; ++mt) O[a][mt] = O[a][mt] * alpha;
                        }
                    }
                }
                const float mu = (m[a] == -INFINITY) ? 0.f : m[a];
                float ps = 0.f;
#pragma unroll
                for (int kt = 0; kt < 4; ++kt)
#pragma unroll
                    for (int r = 0; r < 4; ++r) { float p = ex2(s[a][kt][r] - mu); if (MODE == MODE_C2) p *= invl[a]; s[a][kt][r] = p; ps += p; }
                l[a] += ps;
                if (MODE == MODE_C2) {
#pragma unroll
                    for (int kt = 0; kt < 4; ++kt) {
                        const float s4 = quad_sum((s[a][kt][0] + s[a][kt][1]) + (s[a][kt][2] + s[a][kt][3])), lastv = quad_sum(s[a][kt][3]);
                        const int jp = 16 * j + 4 * kt + q;
                        if ((cc & 3) == 0) { __hip_atomic_fetch_add(impL + tl * 128 + jp, s4, __ATOMIC_RELAXED, __HIP_MEMORY_SCOPE_WORKGROUP);
                            if (jp < 127) __hip_atomic_fetch_add(impL + tl * 128 + jp + 1, lastv, __ATOMIC_RELAXED, __HIP_MEMORY_SCOPE_WORKGROUP); }
                    }
                }
            }
            if (MODE == MODE_C1) continue;
#pragma unroll
            for (int a = 0; a < 2; ++a) {
                if (!act[a]) continue;
                bf16x8 Pf[2];
#pragma unroll
                for (int k2 = 0; k2 < 2; ++k2) { u32x4 w; w.x = cvt_pk_bf16(s[a][2 * k2][0], s[a][2 * k2][1]); w.y = cvt_pk_bf16(s[a][2 * k2][2], s[a][2 * k2][3]); w.z = cvt_pk_bf16(s[a][2 * k2 + 1][0], s[a][2 * k2 + 1][1]); w.w = cvt_pk_bf16(s[a][2 * k2 + 1][2], s[a][2 * k2 + 1][3]);
                    Pf[k2] = __builtin_bit_cast(bf16x8, w); }
#pragma unroll
                for (int mt = 0; mt < 4; ++mt)
#pragma unroll
                    for (int k2 = 0; k2 < 2; ++k2) O[a][mt] = __builtin_amdgcn_mfma_f32_16x16x32_bf16(Vf[mt][k2], Pf[k2], O[a][mt], 0, 0, 0);
            }
        }
        asm volatile("s_waitcnt vmcnt(0)" ::: "memory");
        __syncthreads();
    }
}
__device__ __forceinline__ void clearO(f32x4 (&O)[2][4], float (&m)[2], float (&l)[2], float m0) {
#pragma unroll
    for (int a = 0; a < 2; ++a) { m[a] = m0; l[a] = 0.f;
#pragma unroll
        for (int mt = 0; mt < 4; ++mt) O[a][mt] = (f32x4){0.f, 0.f, 0.f, 0.f}; }
}

__device__ __forceinline__ void store_orow(bf16_t* obase, int q, const u32x2 (&w)[4]) {
#pragma unroll
    for (int p = 0; p < 2; ++p) { u32x2 a = w[2 * p], b = w[2 * p + 1];
        const auto r0 = __builtin_amdgcn_permlane16_swap(a.x, b.x, false, false); a.x = r0[0]; b.x = r0[1];
        const auto r1 = __builtin_amdgcn_permlane16_swap(a.y, b.y, false, false); a.y = r1[0]; b.y = r1[1];
        u32x4 v; v.x = a.x; v.y = a.y; v.z = b.x; v.w = b.y;
        *(u32x4*)(obase + 16 * (2 * p + (q & 1)) + 8 * (q >> 1)) = v; }
}
__device__ __forceinline__ void unit(LAS unsigned char* lds, int tid, int lane, int wave, const bf16_t* qkvg, const bf16_t* kcmp, const bf16_t* vcmp, const float* sinks, bf16_t* oab, int b, int g, int cur) {
    Ctx c; c.lds = lds; c.tid = tid; c.lane = lane; c.wave = wave; c.qkv_b = qkvg + (size_t)b * S * QP; c.kc = kcmp + (size_t)b * 512 * 128 + g * 64; c.vc = vcmp + (size_t)b * 512 * 128 + g * 64; c.cur = cur; c.g = g;
    const int q = lane >> 4, cc = lane & 15, hr = cc & 3, hA = g * 4 + hr;
    const int t0 = 64 * cur;
    LAS unsigned* selm = (LAS unsigned*)(lds + L_SELM); LAS unsigned* uwp = (LAS unsigned*)(lds + L_UW); LAS unsigned char* jl = lds + L_JL;
    LAS float* impL = (LAS float*)(lds + L_IMP);
    bf16x8 Qf[2][2];
    f32x4 O[2][4]; float m[2], l[2], invl[2] = {1.f, 1.f};
    LAS u32x2* stash = (LAS u32x2*)(lds + L_IMP) + wave * 512 + lane;
#pragma unroll
    for (int a = 0; a < 2; ++a) { const bf16_t* qrow = c.qkv_b + (size_t)(t0 + 8 * wave + 4 * a + (cc >> 2)) * QP;
        Qf[a][0] = *(const bf16x8*)(qrow + C_QA + hA * 64 + 8 * q); Qf[a][1] = *(const bf16x8*)(qrow + C_QA + hA * 64 + 32 + 8 * q); }
    { const u32x4 z = {0u, 0u, 0u, 0u};
#pragma unroll
      for (int i = 0; i < 4; ++i) *(LAS u32x4*)(lds + L_IMP + (i * 512 + tid) * 16) = z; }
    const int nbc = (4 * cur + 3 + 63) >> 6;
    clearO(O, m, l, -INFINITY);
    const int nstc = (nbc + NB - 1) / NB;
    branch<MODE_C1>(c, Qf, O, m, l, invl, nbc, 0, hA, 0, [&](int p) {
#pragma unroll
        for (int bi = 0; bi < NB; ++bi) if (bi < nbc) blk_dma<MODE_C2>(c, bi, p * NB + bi); });
#pragma unroll
    for (int a = 0; a < 2; ++a) invl[a] = 1.0f / fmaxf(col_sum4(l[a]), 1e-30f);
    branch<MODE_C2, true>(c, Qf, O, m, l, invl, nbc, 0, hA, nstc & 1);
    {
        unsigned long long un_lo[2] = {0ull, 0ull}, un_hi[2] = {0ull, 0ull};
        for (int i = 0; i < 8; ++i) {
            const int tok = 8 * wave + i;
            unsigned long long mlo, mhi = 0ull;
            if (cur <= 7) mlo = (2ull << cur) - 1ull;
            else {
                mlo = 1ull;
                if (cur - 1 < 64) mlo |= 1ull << (cur - 1); else mhi |= 1ull << (cur - 65);
                if (cur < 64) mlo |= 1ull << cur; else mhi |= 1ull << (cur - 64);
                const bool ok0 = lane >= 1 && lane <= cur - 2, ok1 = lane + 64 <= cur - 2;
                const unsigned k0 = ok0 ? __builtin_bit_cast(unsigned, impL[tok * 128 + lane]) + 1u : 0u;
                const unsigned k1 = ok1 ? __builtin_bit_cast(unsigned, impL[tok * 128 + 64 + lane]) + 1u : 0u;
                unsigned T = 0u;
                for (int bit = 31; bit >= 0; --bit) { const unsigned cand = T | (1u << bit);
                    const int cnt = __popcll(__ballot(k0 >= cand)) + __popcll(__ballot(k1 >= cand));
                    if (cnt >= 5) T = cand; }
                const unsigned long long G0 = __ballot(k0 > T), G1 = __ballot(k1 > T);
                unsigned long long E0 = __ballot(k0 == T), E1 = __ballot(k1 == T), S0 = 0ull, S1 = 0ull;
                int need = 5 - (__popcll(G0) + __popcll(G1));
                while (need > 0 && E0) { const unsigned long long b_ = E0 & (0ull - E0); S0 |= b_; E0 ^= b_; --need; }
                while (need > 0 && E1) { const unsigned long long b_ = E1 & (0ull - E1); S1 |= b_; E1 ^= b_; --need; }
                mlo |= G0 | S0; mhi |= G1 | S1;
            }
            if (lane == 0) { selm[tok * 4 + 0] = (unsigned)mlo; selm[tok * 4 + 1] = (unsigned)(mlo >> 32); selm[tok * 4 + 2] = (unsigned)mhi; selm[tok * 4 + 3] = (unsigned)(mhi >> 32); }
            un_lo[i >> 2] |= mlo; un_hi[i >> 2] |= mhi;
        }
        if (lane == 0) {
#pragma unroll
            for (int a = 0; a < 2; ++a) { LAS unsigned* up = selm + 256 + (2 * wave + a) * 4; up[0] = (unsigned)un_lo[a]; up[1] = (unsigned)(un_lo[a] >> 32); up[2] = (unsigned)un_hi[a]; up[3] = (unsigned)(un_hi[a] >> 32); }
        }
    }
    __syncthreads();
    if (wave == 0) {
        unsigned long long ulo = 0ull, uhi = 0ull;
#pragma unroll
        for (int k = 0; k < 16; ++k) { ulo |= (unsigned long long)selm[256 + 4 * k] | ((unsigned long long)selm[256 + 4 * k + 1] << 32); uhi |= (unsigned long long)selm[256 + 4 * k + 2] | ((unsigned long long)selm[256 + 4 * k + 3] << 32); }
        const unsigned long long below = (1ull << lane) - 1ull;
        const int nlo = __popcll(ulo);
        if ((ulo >> lane) & 1ull) jl[__popcll(ulo & below)] = (unsigned char)lane;
        if ((uhi >> lane) & 1ull) jl[nlo + __popcll(uhi & below)] = (unsigned char)(64 + lane);
        if (lane == 0) uwp[4] = (unsigned)(nlo + __popcll(uhi));
    }
    __syncthreads();
    const int nsel = __builtin_amdgcn_readfirstlane((int)uwp[4]);
#pragma unroll
    for (int a = 0; a < 2; ++a) { const float sc = 1.0f / (1.0f + ex2(-LOG2E * bf2f(c.qkv_b[(size_t)(t0 + 8 * wave + 4 * a + (cc >> 2)) * QP + C_GA + hA * 3 + 0])));
#pragma unroll
        for (int mt = 0; mt < 4; ++mt) { const f32x4 o = O[a][mt] * sc; u32x2 w; w.x = cvt_pk_bf16(o[0], o[1]); w.y = cvt_pk_bf16(o[2], o[3]); stash[(a * 4 + mt) * 64] = w; } }
    clearO(O, m, l, -INFINITY);
    const int jw0 = cur >= 8 ? cur - 8 : 0, nwin = cur - jw0 + 1, jb0 = cur >= 2 ? cur - 2 : 0, nswa = cur - jb0 + 1;
    const int pwin = ((nsel + NB - 1) / NB) & 1, pswa = (pwin + (nwin + NB - 1) / NB) & 1;
    branch<MODE_SEL>(c, Qf, O, m, l, invl, nsel, 0, hA, 0, [&](int p) {
#pragma unroll
        for (int bi = 0; bi < NB; ++bi) if (bi < nwin) blk_dma<MODE_WIN>(c, jw0 + bi, p * NB + bi); });
#pragma unroll
    for (int a = 0; a < 2; ++a) { const float sc = (1.0f / (1.0f + ex2(-LOG2E * bf2f(c.qkv_b[(size_t)(t0 + 8 * wave + 4 * a + (cc >> 2)) * QP + C_GA + hA * 3 + 1])))) / fmaxf(col_sum4(l[a]), 1e-30f);
#pragma unroll
        for (int mt = 0; mt < 4; ++mt) { const u32x2 pv = stash[(a * 4 + mt) * 64]; f32x4 o = O[a][mt] * sc;
            o[0] += __builtin_bit_cast(float, pv.x << 16); o[1] += __builtin_bit_cast(float, pv.x & 0xffff0000u); o[2] += __builtin_bit_cast(float, pv.y << 16); o[3] += __builtin_bit_cast(float, pv.y & 0xffff0000u);
            u32x2 w; w.x = cvt_pk_bf16(o[0], o[1]); w.y = cvt_pk_bf16(o[2], o[3]); stash[(a * 4 + mt) * 64] = w; } }
    clearO(O, m, l, -INFINITY);
    branch<MODE_WIN, true>(c, Qf, O, m, l, invl, nwin, jw0, hA, pwin, [&](int p) {
#pragma unroll
        for (int bi = 0; bi < NB; ++bi) if (bi < nswa) blk_dma<MODE_SWA>(c, jb0 + bi, p * NB + bi); });
#pragma unroll
    for (int a = 0; a < 2; ++a) { const float sc = (1.0f / (1.0f + ex2(-LOG2E * bf2f(c.qkv_b[(size_t)(t0 + 8 * wave + 4 * a + (cc >> 2)) * QP + C_GA + hA * 3 + 2])))) / fmaxf(col_sum4(l[a]), 1e-30f);
        bf16_t* orow = oab + (size_t)(b * S + t0 + 8 * wave + 4 * a + (cc >> 2)) * D + hA * 64;
        u32x2 w[4];
#pragma unroll
        for (int mt = 0; mt < 4; ++mt) { const u32x2 pv = stash[(a * 4 + mt) * 64]; f32x4 o = O[a][mt] * sc;
            o[0] += __builtin_bit_cast(float, pv.x << 16); o[1] += __builtin_bit_cast(float, pv.x & 0xffff0000u); o[2] += __builtin_bit_cast(float, pv.y << 16); o[3] += __builtin_bit_cast(float, pv.y & 0xffff0000u);
            w[mt].x = cvt_pk_bf16(o[0], o[1]); w[mt].y = cvt_pk_bf16(o[2], o[3]); }
        store_orow(orow, q, w); }
    const float sk2 = sinks[hA] * LOG2E;
#pragma unroll
    for (int a = 0; a < 2; ++a) { const bf16_t* qrow = c.qkv_b + (size_t)(t0 + 8 * wave + 4 * a + (cc >> 2)) * QP;
        Qf[a][0] = *(const bf16x8*)(qrow + C_QB + hA * 64 + 8 * q); Qf[a][1] = *(const bf16x8*)(qrow + C_QB + hA * 64 + 32 + 8 * q); }
    clearO(O, m, l, sk2);
    branch<MODE_SWA, true>(c, Qf, O, m, l, invl, nswa, jb0, 8 + hA, pswa);
#pragma unroll
    for (int a = 0; a < 2; ++a) { const float sc = 1.0f / (col_sum4(l[a]) + ex2(sk2 - m[a]));
        bf16_t* orow = oab + (size_t)(b * S + t0 + 8 * wave + 4 * a + (cc >> 2)) * D + 512 + hA * 64;
        u32x2 w[4];
#pragma unroll
        for (int mt = 0; mt < 4; ++mt) { const f32x4 o = O[a][mt] * sc; w[mt].x = cvt_pk_bf16(o[0], o[1]); w[mt].y = cvt_pk_bf16(o[2], o[3]); }
        store_orow(orow, q, w); }
}

constexpr int CMP_PITCH = 144, CMP_NCH = 272 * 8;
__device__ __forceinline__ void compress_load(const bf16_t* qkvg, int u, int tid, u32x4 (&r)[5]) {
    const int nt = u & 31, g = (u >> 5) & 1, b = (u >> 6) & 7, which = u >> 9;
    const bf16_t* base = qkvg + (size_t)(b * S) * QP + (which ? C_VC : C_KC) + g * 64;
#pragma unroll
    for (int i = 0; i < 5; ++i) { int c = tid + 512 * i; c = c < CMP_NCH ? c : CMP_NCH - 1; int tok = 256 * nt + (c >> 3); tok = tok < S ? tok : S - 1;
        r[i] = *(const u32x4*)(base + (size_t)tok * QP + (c & 7) * 8); }
}
__device__ __forceinline__ void compress_stage(LAS unsigned char* lds, int tid, const u32x4 (&r)[5]) {
#pragma unroll
    for (int i = 0; i < 5; ++i) { const int c = tid + 512 * i; const int tr = c >> 3;
        if (c < CMP_NCH) *(LAS u32x4*)(lds + L_KV + ((tr & 15) * 17 + (tr >> 4)) * CMP_PITCH + (c & 7) * 16) = r[i]; }
}
__device__ __forceinline__ void compress_unit(LAS unsigned char* lds, int lane, int wave, const bf16_t* W1T, const bf16_t* W2T, const float* c1, bf16_t* kcmp, bf16_t* vcmp, int u) {
    const int nt = u & 31, g = (u >> 5) & 1, b = (u >> 6) & 7, which = u >> 9, n0 = 16 * nt;
    const int mrow = lane & 15, q = lane >> 4;
    const int n = n0 + mrow, mcl = n > 510 ? mrow - 1 : mrow;
    const LAS unsigned char* arow = lds + L_KV + mcl * CMP_PITCH + 16 * q;
    const bf16_t* brow = W1T + ((size_t)which * 128 + 16 * wave + mrow) * 2048 + 8 * q;
    f32x4 acc = {0.f, 0.f, 0.f, 0.f};
#pragma unroll 16
    for (int ks = 0; ks < 64; ++ks) {
        const bf16x8 a = *(const LAS bf16x8*)(arow + (((ks >> 1) & 15) * 17 + (ks >> 5)) * CMP_PITCH + 64 * (ks & 1));
        const bf16x8 w = *(const bf16x8*)(brow + 32 * ks);
        acc = __builtin_amdgcn_mfma_f32_16x16x32_bf16(w, a, acc, 0, 0, 0);
    }
    LAS bf16_t* hid = (LAS bf16_t*)(lds + L_HID);
    { const f32x4 cb = *(const f32x4*)(c1 + which * 128 + 16 * wave + 4 * q); float hv[4];
#pragma unroll
      for (int r = 0; r < 4; ++r) { const float xx = acc[r] + cb[r]; const float y = 0.7978845608028654f * (xx + 0.044715f * xx * xx * xx);
          const float th = 1.0f - 2.0f / (1.0f + ex2(2.0f * LOG2E * y)); hv[r] = 0.5f * xx * (1.0f + th); }
      u32x2 w; w.x = cvt_pk_bf16(hv[0], hv[1]); w.y = cvt_pk_bf16(hv[2], hv[3]);
      *(LAS u32x2*)(hid + mrow * 136 + 16 * wave + 4 * q) = w; }
    __syncthreads();
    if (wave < 4) {
        f32x4 acc2 = {0.f, 0.f, 0.f, 0.f};
        const bf16_t* w2row = W2T + ((size_t)which * 64 + 16 * wave + mrow) * 128 + 8 * q;
#pragma unroll
        for (int ks = 0; ks < 4; ++ks) {
            const bf16x8 hfr = *(const LAS bf16x8*)(hid + mrow * 136 + 32 * ks + 8 * q);
            const bf16x8 w = *(const bf16x8*)(w2row + 32 * ks);
            acc2 = __builtin_amdgcn_mfma_f32_16x16x32_bf16(w, hfr, acc2, 0, 0, 0);
        }
        u32x2 w; w.x = cvt_pk_bf16(acc2[0], acc2[1]); w.y = cvt_pk_bf16(acc2[2], acc2[3]);
        if (n > 510) { w.x = 0u; w.y = 0u; }
        *(u32x2*)((which ? vcmp : kcmp) + ((size_t)(b * 512 + n) * 2 + g) * 64 + 16 * wave + 4 * q) = w;
    }
    __syncthreads();
}
constexpr int CMP_R1 = 40960, L_HID2 = L_END;
__device__ __forceinline__ void compress_stage1(LAS unsigned char* lds, int tid, const u32x4 (&r)[5]) {
#pragma unroll
    for (int i = 0; i < 5; ++i) { const int c = tid + 512 * i; const int tr = c >> 3;
        if (c < CMP_NCH) *(LAS u32x4*)(lds + L_KV + CMP_R1 + ((tr & 15) * 17 + (tr >> 4)) * CMP_PITCH + (c & 7) * 16) = r[i]; }
}
__device__ __forceinline__ void compress_unit2(LAS unsigned char* lds, int lane, int wave, const bf16_t* W1T, const bf16_t* W2T, const float* c1, bf16_t* kcmp, bf16_t* vcmp, int u) {
    const int nt = u & 31, g = (u >> 5) & 1, b = (u >> 6) & 7, which = u >> 9, n0 = 16 * nt;
    const int mrow = lane & 15, q = lane >> 4;
    const int n = n0 + mrow, mcl = n > 510 ? mrow - 1 : mrow;
    const LAS unsigned char* arow = lds + L_KV + mcl * CMP_PITCH + 16 * q;
    const bf16_t* brow = W1T + ((size_t)which * 128 + 16 * wave + mrow) * 2048 + 8 * q;
    f32x4 acc0 = {0.f, 0.f, 0.f, 0.f}, acc1 = {0.f, 0.f, 0.f, 0.f};
#pragma unroll 16
    for (int ks = 0; ks < 64; ++ks) {
        const int ao = (((ks >> 1) & 15) * 17 + (ks >> 5)) * CMP_PITCH + 64 * (ks & 1);
        const bf16x8 a0 = *(const LAS bf16x8*)(arow + ao), a1 = *(const LAS bf16x8*)(arow + CMP_R1 + ao);
        const bf16x8 w = *(const bf16x8*)(brow + 32 * ks);
        acc0 = __builtin_amdgcn_mfma_f32_16x16x32_bf16(w, a0, acc0, 0, 0, 0);
        acc1 = __builtin_amdgcn_mfma_f32_16x16x32_bf16(w, a1, acc1, 0, 0, 0);
    }
    { const f32x4 cb = *(const f32x4*)(c1 + which * 128 + 16 * wave + 4 * q);
#pragma unroll
      for (int h = 0; h < 2; ++h) { float hv[4];
#pragma unroll
          for (int r = 0; r < 4; ++r) { const float xx = (h ? acc1[r] : acc0[r]) + cb[r]; const float y = 0.7978845608028654f * (xx + 0.044715f * xx * xx * xx);
              const float th = 1.0f - 2.0f / (1.0f + ex2(2.0f * LOG2E * y)); hv[r] = 0.5f * xx * (1.0f + th); }
          u32x2 w; w.x = cvt_pk_bf16(hv[0], hv[1]); w.y = cvt_pk_bf16(hv[2], hv[3]);
          *(LAS u32x2*)((LAS bf16_t*)(lds + (h ? L_HID2 : L_HID)) + mrow * 136 + 16 * wave + 4 * q) = w; } }
    __syncthreads();
    {   const int h = wave >> 2, w4 = wave & 3;
        const LAS bf16_t* hid = (const LAS bf16_t*)(lds + (h ? L_HID2 : L_HID));
        f32x4 acc2 = {0.f, 0.f, 0.f, 0.f};
        const bf16_t* w2row = W2T + ((size_t)which * 64 + 16 * w4 + mrow) * 128 + 8 * q;
#pragma unroll
        for (int ks = 0; ks < 4; ++ks) {
            const bf16x8 hfr = *(const LAS bf16x8*)(hid + mrow * 136 + 32 * ks + 8 * q);
            const bf16x8 w = *(const bf16x8*)(w2row + 32 * ks);
            acc2 = __builtin_amdgcn_mfma_f32_16x16x32_bf16(w, hfr, acc2, 0, 0, 0);
        }
        u32x2 w; w.x = cvt_pk_bf16(acc2[0], acc2[1]); w.y = cvt_pk_bf16(acc2[2], acc2[3]);
        if (n > 510) { w.x = 0u; w.y = 0u; }
        *(u32x2*)((which ? vcmp : kcmp) + ((size_t)((b + 4 * h) * 512 + n) * 2 + g) * 64 + 16 * w4 + 4 * q) = w;
    }
    __syncthreads();
}
}

struct __attribute__((packed, aligned(4))) Rec3 { unsigned x, y, z; };
struct MoeCtx { LAS unsigned char* lds; unsigned char* ws; float* out; const float* ln2g; const float* ln2b; int G, gw, NGW, tid, lane; };
__device__ __forceinline__ MoeTables moe_tb(LAS unsigned char* lds) { MoeTables tb; tb.tn = (LAS int*)(lds + RING_BYTES + 1024); tb.es = tb.tn + 260; tb.us = tb.es + 260; return tb; }
__device__ __forceinline__ void moe_prefix(const unsigned* cnt, LAS int* tn, LAS int* es, LAS int* us, int tid) {
    __syncthreads();
    if (tid < 64) { const int lane = tid; int n[4], tt[4], sa = 0, sb = 0;
#pragma unroll
        for (int j = 0; j < 4; ++j) { n[j] = (int)cnt[(4 * lane + j) * CSTR]; tt[j] = (n[j] + 255) >> 8; sa += n[j]; sb += tt[j]; }
        int ia = sa, ib = sb;
#pragma unroll
        for (int o = 1; o < 64; o <<= 1) { const int xa = __shfl_up(ia, o), xb = __shfl_up(ib, o); if (lane >= o) { ia += xa; ib += xb; } }
        int ea = ia - sa, eb = ib - sb;
#pragma unroll
        for (int j = 0; j < 4; ++j) { es[4 * lane + j] = ea; if (us) us[4 * lane + j] = eb; if (tn) tn[4 * lane + j] = n[j]; ea += n[j]; eb += tt[j]; }
        if (lane == 63) { es[256] = ea; es[257] = ea + CHT; if (us) { us[256] = eb; us[257] = eb + CHT / 256; } if (tn) tn[256] = CHT; } }
    __syncthreads();
}
__device__ __forceinline__ LAS int* moe_esc(LAS unsigned char* lds) { return (LAS int*)(lds + RING_BYTES + 13056); }
template <int C> __device__ __forceinline__ void moe_combine(const MoeCtx& mc) {
    LAS int* es = moe_esc(mc.lds);
    const unsigned* eidx = (const unsigned*)(mc.ws + WS_EIDX); const float* gatev = (const float*)(mc.ws + WS_GATE); const unsigned* posv = (const unsigned*)(mc.ws + WS_POS);
    const unsigned char* y8 = mc.ws + WS_Y; const bf16_t* ys = (const bf16_t*)(mc.ws + WS_YS);
    const int lane = mc.lane;
    f32x4 g2v[4], b2v[4];
#pragma unroll
    for (int j = 0; j < 4; ++j) { g2v[j] = *(const f32x4*)(mc.ln2g + 16 * lane + 4 * j); b2v[j] = *(const f32x4*)(mc.ln2b + 16 * lane + 4 * j); }
    for (int tl = mc.gw; tl < CHT; tl += 2 * mc.NGW) {
        const int tl2 = tl + mc.NGW; const bool two = tl2 < CHT;
        const int tA = C * CHT + tl, tB = C * CHT + (two ? tl2 : tl);
        u32x4 ra[10], rb[10]; float ga[8], gb[8];
        { const size_t ie = (size_t)((lane & 8) ? tB : tA) * TOPK + (lane & 7);
          const Rec3 rec = *(const Rec3*)(eidx + 3 * ie);
          const unsigned rowv = (unsigned)es[rec.x] + rec.y; const float gvv = __builtin_bit_cast(float, rec.z) * 0.0625f;
#pragma unroll
          for (int k = 0; k < 8; ++k) {
              const unsigned rowA = (unsigned)__builtin_amdgcn_readlane((int)rowv, k), rowB = (unsigned)__builtin_amdgcn_readlane((int)rowv, 8 + k);
              ga[k] = __builtin_bit_cast(float, __builtin_amdgcn_readlane(__builtin_bit_cast(int, gvv), k)); gb[k] = __builtin_bit_cast(float, __builtin_amdgcn_readlane(__builtin_bit_cast(int, gvv), 8 + k));
              ra[k] = *(const u32x4*)(y8 + (size_t)rowA * D + 16 * lane); rb[k] = *(const u32x4*)(y8 + (size_t)rowB * D + 16 * lane); } }
        { const bf16_t* pa = ys + (size_t)tl * D + 16 * lane; const bf16_t* pb = ys + (size_t)(two ? tl2 : tl) * D + 16 * lane;
          ra[8] = *(const u32x4*)pa; ra[9] = *(const u32x4*)(pa + 8); rb[8] = *(const u32x4*)pb; rb[9] = *(const u32x4*)(pb + 8); }
#pragma unroll
        for (int h = 0; h < 2; ++h) {
            if (h == 1 && !two) break;
            float v[16];
            { const u32x4 a = h ? rb[8] : ra[8], b = h ? rb[9] : ra[9];
#pragma unroll
              for (int j = 0; j < 4; ++j) { v[2 * j] = __builtin_bit_cast(float, a[j] << 16); v[2 * j + 1] = __builtin_bit_cast(float, a[j] & 0xffff0000u);
                  v[8 + 2 * j] = __builtin_bit_cast(float, b[j] << 16); v[8 + 2 * j + 1] = __builtin_bit_cast(float, b[j] & 0xffff0000u); } }
#pragma unroll
            for (int k = 0; k < 8; ++k) { const float gk = h ? gb[k] : ga[k]; const u32x4 a = h ? rb[k] : ra[k];
#pragma unroll
                for (int j = 0; j < 4; ++j) { const f32x2 lo = __builtin_amdgcn_cvt_pk_f32_fp8((int)a[j], false), hi = __builtin_amdgcn_cvt_pk_f32_fp8((int)a[j], true);
                    v[4 * j] += gk * lo.x; v[4 * j + 1] += gk * lo.y; v[4 * j + 2] += gk * hi.x; v[4 * j + 3] += gk * hi.y; } }
            float sm = 0.f;
#pragma unroll
            for (int j = 0; j < 16; ++j) sm += v[j];
            const float mean = wave_sum_x(sm) * (1.f / D); float s2 = 0.f;
#pragma unroll
            for (int j = 0; j < 16; ++j) { v[j] -= mean; s2 += v[j] * v[j]; }
            const float rstd = 1.f / sqrtf(wave_sum_x(s2) * (1.f / D) + LN_EPS);
            float* op = mc.out + (size_t)(h ? tB : tA) * D + 16 * lane;
#pragma unroll
            for (int j = 0; j < 4; ++j) { const f32x4 gg = g2v[j], bb = b2v[j];
                f32x4 o; o.x = v[4 * j] * rstd * gg.x + bb.x; o.y = v[4 * j + 1] * rstd * gg.y + bb.y; o.z = v[4 * j + 2] * rstd * gg.z + bb.z; o.w = v[4 * j + 3] * rstd * gg.w + bb.w;
                *(f32x4*)(op + 4 * j) = o; }
        }
    }
}
template <int C> __device__ __forceinline__ void moe_gu(const MoeCtx& mc) {
    const MoeTables tb = moe_tb(mc.lds);
    const unsigned* cntw = (const unsigned*)(mc.ws + WS_CTL) + CW_CNT;
    bf16_t* h1b = (bf16_t*)((unsigned char*)mc.out + DO_H1B); bf16_t* Wgu = (bf16_t*)(mc.ws + WS_WGU); bf16_t* hb = (bf16_t*)(mc.ws + WS_HB);
    const unsigned short* elist = (const unsigned short*)(mc.ws + WS_LIST);
    moe_prefix(cntw + C * 256 * CSTR, tb.tn, tb.es, tb.us, mc.tid);
    MoeUnits mu; mu.rec = (LAS int*)(mc.lds + RING_BYTES + 4352); mu.cnt = mu.rec + 96; mu.tok = (LAS unsigned short*)(mc.lds + RING_BYTES + 4864);
    moe_units<2, true>(tb, mu, mc.G, (int)blockIdx.x, mc.tid, elist, C);
    { MoeOrder<2> S; S.tb = tb; S.mu = mu; S.Abase = (const char*)h1b; S.apitch = 0; S.Bbase = (const char*)Wgu; S.strideE = (size_t)512 * D * 2; S.stridePN = (size_t)256 * D * 2;
      S.chunk = C; S.colw = 128;
      EpiGLU E{hb};
      pg8::gemm_phase<EpiGLU, MoeOrder<2>, true, true, false, 8>(mc.lds, D, S, E); }
}
template <int C> __device__ __forceinline__ void moe_d(const MoeCtx& mc) {
    const MoeTables tb = moe_tb(mc.lds);
    bf16_t* h1b = (bf16_t*)((unsigned char*)mc.out + DO_H1B); bf16_t* Wd = (bf16_t*)(mc.ws + WS_WD); bf16_t* hb = (bf16_t*)(mc.ws + WS_HB);
    const unsigned short* elist = (const unsigned short*)(mc.ws + WS_LIST);
    MoeUnits mu; mu.rec = (LAS int*)(mc.lds + RING_BYTES + 4352); mu.cnt = mu.rec + 96; mu.tok = (LAS unsigned short*)(mc.lds + RING_BYTES + 4864);
    moe_units<4, false>(tb, mu, mc.G, (int)blockIdx.x, mc.tid, elist, C);
    { MoeOrder<4> S; S.tb = tb; S.mu = mu; S.Abase = (const char*)hb; S.apitch = (size_t)EH * 2; S.Bbase = (const char*)Wd; S.strideE = (size_t)D * EH * 2; S.stridePN = (size_t)256 * EH * 2;
      S.chunk = C; S.colw = 256;
      EpiDown E{mc.ws + WS_Y, (bf16_t*)(mc.ws + WS_YS), h1b, C};
      int kk = EH; asm volatile("" : "+s"(kk));
      pg8::gemm_phase<EpiDown, MoeOrder<4>, true, false, false, 8>(mc.lds, kk, S, E); }
}
template <int C> __device__ __forceinline__ void moe_cgu(const MoeCtx& mc) {
    const unsigned* cntw = (const unsigned*)(mc.ws + WS_CTL) + CW_CNT;
    moe_prefix(cntw + C * 256 * CSTR, nullptr, moe_esc(mc.lds), nullptr, mc.tid);
    const bool first = (((int)blockIdx.x >> 3) & 1) == 0;
    if (first) moe_combine<C>(mc);
    moe_gu<C + 1>(mc);
    if (!first) moe_combine<C>(mc);
}

struct MegaArgs { const float* in[23]; float* out; unsigned char* ws; unsigned phases; unsigned li; };

__device__ __forceinline__ int colmap_win(int c) {
    if (c < 1280) return c;
    if (c < 1792) return O_QB + (c - 1280);
    if (c < 2048) return O_KB + (c - 1792);
    if (c < 2072) return O_GA + (c - 2048);
    if (c < 2304) return -1;
    if (c < 3328) return O_GATEA + (c - 2304);
    return O_GATEB + (c - 3328);
}
template <class CMap> __device__ __forceinline__ void transpose_item(const float* W, int K, int Nsrc, bf16_t* WT, int nblk, LAS unsigned char* scr, int item, int lane, CMap cmap, int ldo = 0, int koff = 0) {
    if (ldo == 0) ldo = K;
    const int kb = item / nblk, nb = item % nblk, k0 = 64 * kb, n0 = 64 * nb;
    const int sc = cmap(n0 + 4 * (lane & 15));
    const float* src = W + (size_t)(k0 + (lane >> 4)) * Nsrc + (sc >= 0 ? sc : 0);
#pragma unroll 8
    for (int i = 0; i < 16; ++i) { f32x4 v = {0.f, 0.f, 0.f, 0.f}; if (sc >= 0) v = __builtin_nontemporal_load((const f32x4*)(src + (size_t)(4 * i) * Nsrc));
        u32x2 w; w.x = pk2(v.x, v.y); w.y = pk2(v.z, v.w);
        *(LAS u32x2*)(scr + (4 * i + (lane >> 4)) * 144 + (lane & 15) * 8) = w; }
    asm volatile("s_waitcnt lgkmcnt(0)" ::: "memory");
    const int q = lane >> 4, cc = lane & 15;
#pragma unroll
    for (int it = 0; it < 8; ++it) { const int ng = it >> 1, kc = 4 * (it & 1) + q;
        const LAS unsigned char* p = scr + (8 * kc + (cc >> 2)) * 144 + (16 * ng + 4 * (cc & 3)) * 2;
        const v4i16_t lo = __builtin_amdgcn_ds_read_tr16_b64_v4i16((LAS v4i16_t*)p);
        const v4i16_t hi = __builtin_amdgcn_ds_read_tr16_b64_v4i16((LAS v4i16_t*)(p + 4 * 144));
        const bf16x8 o = {lo[0], lo[1], lo[2], lo[3], hi[0], hi[1], hi[2], hi[3]};
        *(bf16x8*)(WT + (size_t)(n0 + 16 * ng + cc) * ldo + koff + k0 + 8 * kc) = o; }
    asm volatile("s_waitcnt lgkmcnt(0)" ::: "memory");
}

__device__ __forceinline__ void route_select(const float (&lg)[4], const float (&rb)[4], int lane, unsigned long long (&Sm)[4], float (&sc)[4], float& gsum) {
            float ch[4];
#pragma unroll
            for (int i = 0; i < 4; ++i) { sc[i] = 1.0f / (1.0f + expf(-lg[i])); ch[i] = sc[i] + rb[i]; }
            float gs[8];
#pragma unroll
            for (int i = 0; i < 4; ++i) {
                float m1 = ch[i]; int a1 = lane;
#pragma unroll
                for (int o = 16; o > 0; o >>= 1) { const float om = __shfl_xor(m1, o); const int oa_ = __shfl_xor(a1, o); if (om > m1 || (om == m1 && oa_ < a1)) { m1 = om; a1 = oa_; } }
                float m2 = (lane == a1) ? -INFINITY : ch[i];
#pragma unroll
                for (int o = 16; o > 0; o >>= 1) m2 = fmaxf(m2, __shfl_xor(m2, o));
                const float s2 = m1 + m2;
                gs[2 * i] = __shfl(s2, 0); gs[2 * i + 1] = __shfl(s2, 32);
            }
            float cm[4];
#pragma unroll
            for (int i = 0; i < 4; ++i) { int r0 = 0, r1 = 0;
#pragma unroll
                for (int b = 0; b < 8; ++b) { r0 += (gs[b] > gs[2 * i] || (gs[b] == gs[2 * i] && b < 2 * i)) ? 1 : 0; r1 += (gs[b] > gs[2 * i + 1] || (gs[b] == gs[2 * i + 1] && b < 2 * i + 1)) ? 1 : 0; }
                const bool k = (lane < 32) ? (r0 < 4) : (r1 < 4); cm[i] = k ? ch[i] : -INFINITY; }
            unsigned key[4];
#pragma unroll
            for (int i = 0; i < 4; ++i) { const unsigned b_ = __builtin_bit_cast(unsigned, cm[i]); key[i] = (cm[i] == -INFINITY) ? 0u : (b_ ^ ((b_ >> 31) ? 0xFFFFFFFFu : 0x80000000u)); }
            unsigned Tk = 0u;
            for (int bit = 31; bit >= 0; --bit) { const unsigned cand = Tk | (1u << bit);
                const int cnt = __popcll(__ballot(key[0] >= cand)) + __popcll(__ballot(key[1] >= cand)) + __popcll(__ballot(key[2] >= cand)) + __popcll(__ballot(key[3] >= cand));
                if (cnt >= TOPK) Tk = cand; }
            int need = TOPK;
#pragma unroll
            for (int i = 0; i < 4; ++i) { Sm[i] = __ballot(key[i] > Tk); need -= __popcll(Sm[i]); }
#pragma unroll
            for (int i = 0; i < 4; ++i) { unsigned long long E_ = __ballot(key[i] == Tk);
                while (need > 0 && E_) { const unsigned long long b_ = E_ & (0ull - E_); Sm[i] |= b_; E_ ^= b_; --need; } }
            float gpart = 0.f;
#pragma unroll
            for (int i = 0; i < 4; ++i) gpart += ((Sm[i] >> lane) & 1ull) ? sc[i] : 0.f;
            gsum = wave_sum_x(gpart);
}
__device__ __forceinline__ void route_commit(int t, int lane, const unsigned long long (&Sm)[4], const float (&gv)[4], const unsigned (&p)[4], unsigned* eidx, float* gatev, unsigned* posv, unsigned short* elist) {
            const unsigned long long below = (1ull << lane) - 1ull;
            const int c = t / CHT;
            int base_ = 0;
#pragma unroll
            for (int i = 0; i < 4; ++i) {
                if ((Sm[i] >> lane) & 1ull) {
                    const int slot = base_ + __popcll(Sm[i] & below), e = lane + 64 * i;
                    { Rec3 rec; rec.x = (unsigned)e; rec.y = p[i]; rec.z = __builtin_bit_cast(unsigned, gv[i]);
                      *(Rec3*)(eidx + 3 * ((size_t)t * TOPK + slot)) = rec; }
                    elist[((size_t)c * 256 + e) * CHT + p[i]] = (unsigned short)(t - c * CHT);
                }
                base_ += __popcll(Sm[i]);
            }
}
struct PanelOrder { const char* A; const char* Bt; int K, row0;
    __device__ __forceinline__ bool next(int i, pg8::Unit& u) const { if (i >= 4) return false;
        u.A = A + (size_t)row0 * K * 2; u.B = Bt + (size_t)i * pg8::BM * K * 2; u.row0 = row0; u.col0 = i * pg8::BM; u.nrows = pg8::BM; u.aux = i; u.e = 0; u.ti = 0; u.ord = 0; return true; }
    __device__ __forceinline__ unsigned arow_off(const pg8::Unit&, int) const { return 0u; } };
constexpr int I_GU = (D / 64) * (512 / 64), I_D = (EH / 64) * (D / 64), I_E = I_GU + I_D, I_EXP = 257 * I_E;
__device__ __forceinline__ void expert_load(const float* const* in, int it, int lane, f32x4 (&v)[16]) {
    it = it < I_EXP ? it : I_EXP - 1;
    const int e = it / I_E; int r = it % I_E;
    const float* src; int Nsrc, kb, sc;
    if (r < I_GU) { const int nb = r % 8, bj = (nb >> 1) & 1, pnn = nb >> 2; kb = r / 8;
        src = (e < 256) ? ((bj ? in[16] : in[15]) + (size_t)e * D * EH) : (bj ? in[19] : in[18]); Nsrc = EH; sc = pnn * 128 + 64 * (nb & 1);
    } else { r -= I_GU; src = (e < 256) ? (in[17] + (size_t)e * EH * D) : in[20]; Nsrc = D; kb = r / (D / 64); sc = 64 * (r % (D / 64)); }
    const char* base = (const char*)(src + (size_t)(64 * kb) * Nsrc + sc);
    const unsigned loff = (unsigned)((lane >> 4) * Nsrc + 4 * (lane & 15)) * 4u;
#pragma unroll
    for (int i = 0; i < 16; ++i) v[i] = __builtin_nontemporal_load((const f32x4*)(base + (size_t)(4 * i) * Nsrc * 4 + loff));
}
__device__ __forceinline__ void expert_finish(bf16_t* Wgu, bf16_t* Wd, LAS unsigned char* scr, int it, int lane, const f32x4 (&v)[16]) {
    if (it >= I_EXP) return;
    const int e = it / I_E; int r = it % I_E;
    bf16_t* WT; int ldo, kb, nb;
    if (r < I_GU) { WT = Wgu + (size_t)e * 512 * D; ldo = D; kb = r / 8; nb = r % 8; }
    else { r -= I_GU; WT = Wd + (size_t)e * D * EH; ldo = EH; kb = r / (D / 64); nb = r % (D / 64); }
#pragma unroll
    for (int i = 0; i < 16; ++i) { u32x2 w; w.x = pk2(v[i].x, v[i].y); w.y = pk2(v[i].z, v[i].w);
        *(LAS u32x2*)(scr + (4 * i + (lane >> 4)) * 144 + (lane & 15) * 8) = w; }
    asm volatile("s_waitcnt lgkmcnt(0)" ::: "memory");
    const int q = lane >> 4, cc = lane & 15;
    char* obase = (char*)(WT + (size_t)(64 * nb) * ldo + 64 * kb);
    const unsigned ooff = (unsigned)(cc * ldo + 8 * q) * 2u;
    const LAS unsigned char* p0 = scr + (8 * q + (cc >> 2)) * 144 + (4 * (cc & 3)) * 2;
#pragma unroll
    for (int x = 0; x < 8; ++x) { const int ng = x >> 1, kh = x & 1;
        const LAS unsigned char* p = p0 + (32 * kh) * 144 + (16 * ng) * 2;
        const v4i16_t lo = __builtin_amdgcn_ds_read_tr16_b64_v4i16((LAS v4i16_t*)p);
        const v4i16_t hi = __builtin_amdgcn_ds_read_tr16_b64_v4i16((LAS v4i16_t*)(p + 4 * 144));
        const bf16x8 o = {lo[0], lo[1], lo[2], lo[3], hi[0], hi[1], hi[2], hi[3]};
        *(bf16x8*)(obase + ((size_t)(16 * ng) * ldo + 32 * kh) * 2 + ooff) = o; }
    asm volatile("s_waitcnt lgkmcnt(0)" ::: "memory");
}
struct OneUnit { pg8::Unit u; __device__ __forceinline__ bool next(int i, pg8::Unit& o) const { if (i) return false; o = u; return true; } __device__ __forceinline__ unsigned arow_off(const pg8::Unit&, int) const { return 0u; } };

__global__ void __launch_bounds__(NWAVES * 64, 2) mega(MegaArgs args) {
    extern __shared__ __attribute__((aligned(16))) unsigned char lds_raw[];
    LAS unsigned char* lds = (LAS unsigned char*)lds_raw;
    volatile LAS unsigned* MISC = (volatile LAS unsigned*)(lds + MISC_OFF);
    const int tid = threadIdx.x, lane = tid & 63, wave = __builtin_amdgcn_readfirstlane(tid >> 6);
    const int G = gridDim.x;
    const int vcu = (G % 8 == 0) ? ((int)blockIdx.x % 8) * (G / 8) + (int)blockIdx.x / 8 : (int)blockIdx.x;
    unsigned char* ws = args.ws;
    gu32* ctl = (gu32*)(ws + WS_CTL);
    for (int u = tid; u < (LDS_BYTES - RING_BYTES) / 4; u += NWAVES * 64) ((LAS unsigned*)(lds + RING_BYTES))[u] = 0u;
    __syncthreads();
    XcdBarrier bar = xcd_barrier_post((unsigned*)(ctl + CW_BAR) + (args.li & 255u) * XCD_BAR_WORDS, MISC + 8);
    const unsigned ph = args.phases;
    const float* x = args.in[0]; const float* w_in = args.in[1];
    bf16_t* xb = (bf16_t*)(ws + WS_XB);
    bf16_t* merged = (bf16_t*)((unsigned char*)args.out + DO_MERGED);
    bf16_t* oab = (bf16_t*)((unsigned char*)args.out + DO_OAB);
    bf16_t* WinT = (bf16_t*)(ws + WS_WINT); bf16_t* projT = (bf16_t*)(ws + WS_PROJT); bf16_t* woutT = (bf16_t*)(ws + WS_WOUTT); bf16_t* WrT = (bf16_t*)(ws + WS_WRT);
    bf16_t* qkvg = (bf16_t*)(ws + WS_QKV); bf16_t* gates = (bf16_t*)(ws + WS_GATES);
    bf16_t* pre = (bf16_t*)(ws + WS_PRE);
    bf16_t* h1b = (bf16_t*)((unsigned char*)args.out + DO_H1B);
    bf16_t* Wgu = (bf16_t*)(ws + WS_WGU); bf16_t* Wd = (bf16_t*)(ws + WS_WD);
    bf16_t* hb = (bf16_t*)(ws + WS_HB); bf16_t* ybuf = (bf16_t*)(ws + WS_Y);
    float* logits = (float*)(ws + WS_LOGITS);
    unsigned* eidx = (unsigned*)(ws + WS_EIDX); float* gatev = (float*)(ws + WS_GATE); unsigned* posv = (unsigned*)(ws + WS_POS);
    unsigned short* elist = (unsigned short*)(ws + WS_LIST);
    unsigned* cntw = (unsigned*)(ctl + CW_CNT);
    const int gw = vcu * NWAVES + wave, NGW = G * NWAVES;

    if (ph & 1u) {
        LAS unsigned char* scr = lds + wave * 16384;
        constexpr int NBLK = QW / 64, I_WIN = (D / 64) * NBLK, I_PA = (512 / 64) * (D / 64), I_WO = (D / 64) * (D / 64), I_WR = (D / 64) * (NE / 64);
        constexpr int NITEMS = I_WIN + 2 * I_PA + I_WO + I_WR;
        auto ident = [](int c) { return c; };
        for (int it = gw; it < NITEMS; it += NGW) {
            int r = it;
            if (r < I_WIN) { transpose_item(w_in, D, INW, WinT, NBLK, scr, r, lane, [](int c) { return colmap_win(c); }); continue; } r -= I_WIN;
            if (r < I_PA) { transpose_item(args.in[8], 512, D, projT, D / 64, scr, r, lane, ident, D, 0); continue; } r -= I_PA;
            if (r < I_PA) { transpose_item(args.in[9], 512, D, projT, D / 64, scr, r, lane, ident, D, 512); continue; } r -= I_PA;
            if (r < I_WO) { transpose_item(args.in[10], D, D, woutT, D / 64, scr, r, lane, ident); continue; } r -= I_WO;
            transpose_item(args.in[13], D, NE, WrT, NE / 64, scr, r, lane, ident);
        }
        { bf16_t* W1T = (bf16_t*)(ws + WS_W1T); bf16_t* W2T = (bf16_t*)(ws + WS_W2T); float* c1 = (float*)(ws + WS_C1);
          constexpr int I_1 = (2048 / 64) * (128 / 64), I_2 = (128 / 64) * (64 / 64);
          for (int it = gw; it < 2 * (I_1 + I_2); it += NGW) { const int which = it / (I_1 + I_2); int r = it % (I_1 + I_2);
              if (r < I_1) transpose_item(args.in[3] + (size_t)which * 2048 * 128, 2048, 128, W1T + (size_t)which * 128 * 2048, 2, scr, r, lane, ident);
              else transpose_item(args.in[5] + (size_t)which * 128 * 64, 128, 64, W2T + (size_t)which * 64 * 128, 1, scr, r - I_1, lane, ident); }
          for (int o = gw; o < 256; o += NGW) { const int which = o >> 7, nn = o & 127; const float* pe = args.in[2] + which * 2048; const float* w1 = args.in[3] + (size_t)which * 2048 * 128 + nn;
              float a = 0.f; for (int k = lane; k < 2048; k += 64) a = fmaf(pe[k], w1[(size_t)k * 128], a);
              a = wave_sum_x(a); if (lane == 0) c1[o] = a + args.in[4][o]; } }
        const size_t nchunk = (size_t)T * D / 8, gstep = (size_t)G * NWAVES * 64;
        for (size_t i = (size_t)blockIdx.x * (NWAVES * 64) + tid; i < nchunk; i += 4 * gstep) {
            f32x4 a[4], b[4];
#pragma unroll
            for (int j = 0; j < 4; ++j) { const size_t ii = (i + j * gstep < nchunk) ? i + j * gstep : i; a[j] = __builtin_nontemporal_load((const f32x4*)(x + ii * 8)); b[j] = __builtin_nontemporal_load((const f32x4*)(x + ii * 8 + 4)); }
#pragma unroll
            for (int j = 0; j < 4; ++j) { const size_t ii = (i + j * gstep < nchunk) ? i + j * gstep : i;
                u32x4 o; o.x = pk2(a[j][0], a[j][1]); o.y = pk2(a[j][2], a[j][3]); o.z = pk2(b[j][0], b[j][1]); o.w = pk2(b[j][2], b[j][3]);
                *(u32x4*)(xb + ii * 8) = o; }
        }
        xcd_barrier(bar);
    }
    if (ph & 2u) {
        pg8::DenseOrder S; S.init(xb, WinT, T, QW, D, G, (int)blockIdx.x);
        EpiQKV E{qkvg, gates};
        pg8::gemm_phase<EpiQKV, pg8::DenseOrder, true, false, false, 16>(lds, D, S, E);
        xcd_barrier(bar);
    }
    if (ph & 4u) {
        const bf16_t* W1T = (const bf16_t*)(ws + WS_W1T); const bf16_t* W2T = (const bf16_t*)(ws + WS_W2T); const float* c1 = (const float*)(ws + WS_C1);
        if (G == 256) {
            u32x4 cr0[5], cr1[5]; att::compress_load(qkvg, (int)blockIdx.x, tid, cr0); att::compress_load(qkvg, (int)blockIdx.x + 256, tid, cr1);
            for (int u = (int)blockIdx.x; u < 1024; u += 512) {
                att::compress_stage(lds, tid, cr0); att::compress_stage1(lds, tid, cr1);
                __syncthreads();
                { const int un = u + 512 < 1024 ? u + 512 : u; att::compress_load(qkvg, un, tid, cr0); att::compress_load(qkvg, un + 256, tid, cr1); }
                att::compress_unit2(lds, lane, wave, W1T, W2T, c1, (bf16_t*)(ws + WS_KCMP), (bf16_t*)(ws + WS_VCMP), u);
            }
        } else {
            u32x4 cr[5]; att::compress_load(qkvg, (int)blockIdx.x < 1024 ? (int)blockIdx.x : 0, tid, cr);
            for (int u = (int)blockIdx.x; u < 1024; u += G) {
                att::compress_stage(lds, tid, cr);
                __syncthreads();
                att::compress_load(qkvg, u + G < 1024 ? u + G : u, tid, cr);
                att::compress_unit(lds, lane, wave, W1T, W2T, c1, (bf16_t*)(ws + WS_KCMP), (bf16_t*)(ws + WS_VCMP), u);
            }
        }
        xcd_barrier(bar);
    }
    if (ph & 8u) {
        { LAS float* biasL = (LAS float*)(lds + att::L_BIAS); const float* tab = args.in[7];
          for (int i = tid; i < 16 * 132; i += NWAVES * 64) { const int hh = i / 132, d = i % 132; biasL[i] = tab[(d >= 128 ? 31 : (int)BUCKET[d]) * 16 + hh] * att::LOG2E; } }
        __syncthreads();
        const int nstat = (2048 - 256 - (int)blockIdx.x + G - 1) / G, cgrp = ((int)blockIdx.x >> 3) & 7, cslot = nstat <= 0 ? 0 : (cgrp < nstat ? cgrp : nstat - 1);
        int u = 256 + (int)blockIdx.x;
        for (int itn = 0;; ++itn) {
            int tile = -1, bg = 0;
            if (u < 2048) { const int w = u & 255, k = u >> 8, sub = w >> 4; bg = w & 15; tile = 16 * k + ((k & 1) ? 15 - sub : sub); u += G; }
            else {
                __syncthreads();
                if (tid == 0) *(volatile LAS unsigned*)(lds + att::L_END) = __hip_atomic_fetch_add((unsigned*)(ctl + CW_ATTQ), 1u, __ATOMIC_RELAXED, __HIP_MEMORY_SCOPE_AGENT);
                __syncthreads();
                const int qd = __builtin_amdgcn_readfirstlane((int)*(volatile LAS unsigned*)(lds + att::L_END));
                if (qd < 256) { bg = qd & 15; tile = 15 - (qd >> 4); }
            }
            if (itn == cslot) {
                static_assert(2047 + 23 * 2048 < I_EXP && I_EXP <= 25 * 2048, "conversion share");
                for (int r = 0; r < 8; ++r) {
                    int lane2 = tid; asm volatile("" : "+v"(lane2)); lane2 &= 63;
                    LAS unsigned char* scr = lds + wave * 9216;
                    const int i0 = __builtin_amdgcn_readfirstlane(gw + 3 * r * NGW), i1 = i0 + NGW, i2 = i1 + NGW;
                    f32x4 va[16], vb[16];
                    expert_load(args.in, i0, lane2, va); expert_load(args.in, i1, lane2, vb);
                    expert_finish(Wgu, Wd, scr, i0, lane2, va); expert_load(args.in, i2, lane2, va);
                    expert_finish(Wgu, Wd, scr, i1, lane2, vb);
                    expert_finish(Wgu, Wd, scr, i2, lane2, va);
                }
            }
            if (tile < 0) break;
            __syncthreads();
            { int tidu = tid; asm volatile("" : "+v"(tidu));
              att::unit(lds, tidu, tidu & 63, wave, qkvg, (const bf16_t*)(ws + WS_KCMP), (const bf16_t*)(ws + WS_VCMP), args.in[6], oab, bg >> 1, bg & 1, tile); }
            __syncthreads();
        }
        {
            const int it = gw + 24 * NGW;
            if (it < I_EXP) { int lane2 = tid; asm volatile("" : "+v"(lane2)); lane2 &= 63; f32x4 vc[16]; expert_load(args.in, it, lane2, vc); expert_finish(Wgu, Wd, lds + wave * 9216, it, lane2, vc); }
        }
        xcd_barrier(bar);
    }
    if (ph & 64u) {
        pg8::DenseOrder S; S.init(h1b, WrT, T, NE, D, G, (int)blockIdx.x);
        {
            OneUnit S1; if (!S.next(0, S1.u)) S1.u = pg8::Unit{(const char*)h1b, (const char*)WrT, 0, 0, 256, 0, 0, 0, 0};
            { PanelOrder SP{(const char*)oab, (const char*)projT, D, S1.u.row0}; EpiMerge E{gates, merged}; pg8::gemm_phase<EpiMerge, PanelOrder, true, false, true>(lds, D, SP, E); }
            xcd_barrier(bar);
            { PanelOrder SP{(const char*)merged, (const char*)woutT, D, S1.u.row0}; EpiWout E{xb, pre}; pg8::gemm_phase<EpiWout, PanelOrder, true, false, false>(lds, D, SP, E); }
            asm volatile("s_waitcnt vmcnt(0)" ::: "memory");
            __syncthreads();
            __builtin_amdgcn_fence(__ATOMIC_ACQUIRE, "agent");
            const int r0 = S1.u.row0 + wave * 32;
            f32x4 g1v[4], b1v[4];
#pragma unroll
            for (int j = 0; j < 4; ++j) { g1v[j] = *(const f32x4*)(args.in[11] + 16 * lane + 4 * j); b1v[j] = *(const f32x4*)(args.in[12] + 16 * lane + 4 * j); }
            for (int m = 0; m < 32; m += 4) {
                u32x4 ra[4], rc[4];
#pragma unroll
                for (int j = 0; j < 4; ++j) { const bf16_t* xr = pre + (size_t)(r0 + m + j) * D + 16 * lane; ra[j] = *(const u32x4*)xr; rc[j] = *(const u32x4*)(xr + 8); }
#pragma unroll
                for (int j = 0; j < 4; ++j) ln_regs_to_bf16(ra[j], rc[j], h1b + (size_t)(r0 + m + j) * D, g1v, b1v, lane);
            }
            asm volatile("s_waitcnt vmcnt(0)" ::: "memory");
            __syncthreads();
            { EpiLogits E{logits}; pg8::gemm_phase<EpiLogits, OneUnit, false, false, false>(lds, D, S1, E); }
            asm volatile("s_waitcnt vmcnt(0)" ::: "memory");
            __syncthreads();
            {
                LAS float* lgs = (LAS float*)(lds + wave * 8192);
                float rb[4];
#pragma unroll
                for (int i = 0; i < 4; ++i) rb[i] = args.in[14][lane + 64 * i];
                f32x4 rr[8];
#pragma unroll
                for (int k = 0; k < 8; ++k) rr[k] = *(const f32x4*)(logits + (size_t)(r0 + k) * NE + 4 * lane);
                unsigned long long pSm[4] = {0ull, 0ull, 0ull, 0ull}; float pg[4] = {0.f, 0.f, 0.f, 0.f}; unsigned pp[4] = {0u, 0u, 0u, 0u};
                for (int mb = 0; mb < 32; mb += 8) {
#pragma unroll
                    for (int k = 0; k < 8; ++k) *(LAS f32x4*)(lgs + k * 256 + 4 * lane) = rr[k];
                    { const int nb_ = mb + 8 < 32 ? mb + 8 : mb;
#pragma unroll
                      for (int k = 0; k < 8; ++k) rr[k] = *(const f32x4*)(logits + (size_t)(r0 + nb_ + k) * NE + 4 * lane); }
                    for (int m = mb; m < mb + 8; ++m) {
                        const int t = r0 + m;
                        float lg[4];
#pragma unroll
                        for (int i = 0; i < 4; ++i) lg[i] = lgs[(m - mb) * 256 + lane + 64 * i];
                        unsigned long long Sm[4]; float sc[4], gsum;
                        route_select(lg, rb, lane, Sm, sc, gsum);
                        unsigned p[4];
#pragma unroll
                        for (int i = 0; i < 4; ++i) { p[i] = 0u; if ((Sm[i] >> lane) & 1ull) p[i] = atomicAdd(&cntw[((t / CHT) * 256 + lane + 64 * i) * CSTR], 1u); }
                        if (m > 0) route_commit(t - 1, lane, pSm, pg, pp, eidx, gatev, posv, elist);
#pragma unroll
                        for (int i = 0; i < 4; ++i) { pSm[i] = Sm[i]; pg[i] = sc[i] / gsum * 2.5f; pp[i] = p[i]; }
                    }
                }
                route_commit(r0 + 31, lane, pSm, pg, pp, eidx, gatev, posv, elist);
            }
        }
        xcd_barrier(bar);
    }
    if (ph & 512u) {
        MoeCtx mc; mc.lds = lds; mc.ws = ws; mc.out = args.out; mc.ln2g = args.in[21]; mc.ln2b = args.in[22]; mc.G = G; mc.gw = gw; mc.NGW = NGW; mc.tid = tid; mc.lane = lane;
        static_assert(NCH == 2, "MoE chunk program");
        moe_gu<0>(mc); xcd_barrier(bar); moe_d<0>(mc); xcd_barrier(bar);
        moe_cgu<0>(mc); xcd_barrier(bar); moe_d<1>(mc); xcd_barrier(bar);
        moe_prefix((const unsigned*)(ws + WS_CTL) + CW_CNT + 1 * 256 * CSTR, nullptr, moe_esc(lds), nullptr, tid);
        moe_combine<1>(mc);
    }
}

extern "C" void kernel_launch(void* const* d_in, const int* in_sizes, int n_in, void* d_out, int out_size, void* d_ws, size_t ws_size, hipStream_t stream) {
    static int grid = 0;
    if (grid == 0) {
        if (n_in != 23 || in_sizes[0] != T * D || out_size != T * D || ws_size < WS_NEED) { fprintf(stderr, "kernel_launch: unexpected inputs / workspace (%d inputs, %zu bytes)\n", n_in, ws_size); grid = -1; return; }
        int dev = 0, cus = 0;
        if (hipGetDevice(&dev) != hipSuccess || hipDeviceGetAttribute(&cus, hipDeviceAttributeMultiprocessorCount, dev) != hipSuccess) { grid = -1; return; }
        if (hipFuncSetAttribute((const void*)mega, hipFuncAttributeMaxDynamicSharedMemorySize, LDS_BYTES) != hipSuccess) { fprintf(stderr, "kernel_launch: hipFuncSetAttribute failed\n"); grid = -1; return; }
        int per_cu = 0;
        if (hipOccupancyMaxActiveBlocksPerMultiprocessor(&per_cu, (const void*)mega, NWAVES * 64, LDS_BYTES) != hipSuccess || per_cu < 1) fprintf(stderr, "kernel_launch: occupancy query says %d\n", per_cu);
        (void)hipGetLastError();
        if (cus != 256) fprintf(stderr, "kernel_launch: built for the 256 CUs of MI355X (one row panel per workgroup), found %d\n", cus);
        grid = cus;
    }
    if (grid < 0) return;
    (void)hipMemsetAsync((char*)d_ws + WS_CTL, 0, CTL_ZERO_BYTES, stream);
    MegaArgs a{};
    for (int i = 0; i < 23; ++i) a.in[i] = (const float*)d_in[i];
    a.out = (float*)d_out; a.ws = (unsigned char*)d_ws; a.phases = 0x3ffu; a.li = 0u;
    hipLaunchKernelGGL(mega, dim3(grid), dim3(NWAVES * 64), LDS_BYTES, stream, a);
}
```

```cpp
#include <hip/hip_runtime.h>
#include <stdint.h>
#include <math.h>
#include <cstdio>

#define GAS __attribute__((address_space(1)))
#define LAS __attribute__((address_space(3)))
typedef unsigned short bf16_t;
typedef short bf16x8 __attribute__((ext_vector_type(8)));
typedef float f32x4 __attribute__((ext_vector_type(4)));
typedef float f32x2 __attribute__((ext_vector_type(2)));
typedef unsigned u32x4 __attribute__((ext_vector_type(4)));
typedef unsigned u32x2 __attribute__((ext_vector_type(2)));
typedef GAS unsigned gu32;
typedef short v4i16_t __attribute__((ext_vector_type(4)));

constexpr int D = 1024, NB = 8, S = 8192, T = NB * S;
constexpr int INW = 4120;
constexpr int O_QA = 0, O_KC = 512, O_VC = 640, O_KS = 768, O_VS = 896, O_KW = 1024, O_VW = 1152, O_GA = 1280,
              O_QB = 1304, O_KB = 1816, O_VB = 1944, O_GATEA = 2072, O_GATEB = 3096;
constexpr int QW = 4352, QP = 2304, GP = 2048;
constexpr int C_QA = 0, C_KC = 512, C_VC = 640, C_KS = 768, C_VS = 896, C_KW = 1024, C_VW = 1152,
              C_QB = 1280, C_KB = 1792, C_VB = 1920, C_GA = 2048, C_GATEA = 2304, C_GATEB = 3328;
constexpr int NCMP = 511, NSEL = 128;
constexpr int NE = 256, TOPK = 8, EH = 256;
constexpr float DN_ALPHA = 1.189207115002721f;
constexpr float LN_EPS = 1e-5f;
constexpr int MB = 64;
constexpr int NASSIGN = T * TOPK;
constexpr int NTILES_MAX = (NASSIGN + NE * (MB - 1) + MB - 1) / MB;
constexpr int NROWS_MAX = NTILES_MAX * MB;

__device__ const unsigned char BUCKET[128] = {0, 1, 2, 3, 4, 5, 6, 7, 8, 9, 10, 11, 12, 13, 14, 15, 16, 16, 16, 17, 17, 18, 18, 18, 19, 19, 19, 20, 20, 20, 20, 21, 21, 21, 21, 22, 22, 22, 22, 22, 23, 23, 23, 23, 23, 23, 24, 24, 24, 24, 24, 24, 25, 25, 25, 25, 25, 25, 25, 26, 26, 26, 26, 26, 26, 26, 26, 27, 27, 27, 27, 27, 27, 27, 27, 27, 27, 28, 28, 28, 28, 28, 28, 28, 28, 28, 28, 29, 29, 29, 29, 29, 29, 29, 29, 29, 29, 29, 29, 30, 30, 30, 30, 30, 30, 30, 30, 30, 30, 30, 30, 30, 30, 31, 31, 31, 31, 31, 31, 31, 31, 31, 31, 31, 31, 31, 31, 31};
__device__ __forceinline__ int bucket_of(int dist) { return dist >= 128 ? 31 : (int)BUCKET[dist < 0 ? 0 : dist]; }
__device__ __forceinline__ float sigmoidf_(float x) { return 1.0f / (1.0f + expf(-x)); }
__device__ __forceinline__ float bf2f(bf16_t h) { return __builtin_bit_cast(float, (unsigned)h << 16); }
__device__ __forceinline__ unsigned f2bf(float f) { unsigned u = __builtin_bit_cast(unsigned, f); return (u + 0x7fffu + ((u >> 16) & 1u)) >> 16; }
__device__ __forceinline__ unsigned pk2(float lo, float hi) { return f2bf(lo) | (f2bf(hi) << 16); }
typedef __bf16 bf16x2_t __attribute__((ext_vector_type(2)));
__device__ __forceinline__ unsigned cvt_pk_bf16(float lo, float hi) { const f32x2 v = {lo, hi}; const bf16x2_t b = __builtin_convertvector(v, bf16x2_t); return __builtin_bit_cast(unsigned, b); }

constexpr size_t MiB = 1u << 20;
constexpr size_t WS_CTL = 0, CTL_ZERO_BYTES = 1 * MiB;
constexpr size_t WS_WINT = 1 * MiB;
constexpr size_t WS_PROJT = 10 * MiB;
constexpr size_t WS_WOUTT = 12 * MiB;
constexpr size_t WS_WRT = 14 * MiB;
constexpr size_t WS_WGU = 20 * MiB;
constexpr size_t WS_WD = 277 * MiB;
constexpr size_t WS_GATES = 406 * MiB;
constexpr size_t WS_XB = 534 * MiB;
constexpr size_t WS_QKV = 662 * MiB;
constexpr size_t WS_PRE = 662 * MiB;
constexpr size_t WS_HB = 406 * MiB;
constexpr size_t WS_Y = 552 * MiB;
constexpr size_t WS_YS = 892 * MiB;
constexpr size_t WS_LOGITS = 790 * MiB;
constexpr size_t WS_EIDX = 854 * MiB, WS_GATE = 856 * MiB, WS_POS = 858 * MiB;
constexpr size_t WS_LIST = 860 * MiB;
constexpr size_t DO_XB = 0, DO_MERGED = 0, DO_OAB = 128 * MiB, DO_H1B = 128 * MiB;
constexpr size_t WS_KCMP = 1020 * MiB, WS_VCMP = 1021 * MiB;
constexpr size_t WS_NEED = 1030 * MiB;
constexpr int NCH = 2, CHT = T / NCH, CROWS = 9 * CHT;
constexpr int CW_CNT = 32768;
constexpr int CW_BAR = 4096;
constexpr int CW_ATTQ = 65536;

#define XB_TMO      128
#define XB_XCNT(j)  (256  + 64 * (j))
#define XB_XSUB(j)  (1280 + 64 * (j))
#define XB_XGEN(j)  (2304 + 64 * (j))
#define XB_TOP      3328
#define XB_TOPGEN   3392
#define XCD_BAR_WORDS 3456
#define XB_SPIN_CAP (1u << 18)
__device__ __forceinline__ unsigned xb_ld(unsigned* p)              { return __hip_atomic_load(p, __ATOMIC_RELAXED, __HIP_MEMORY_SCOPE_AGENT); }
__device__ __forceinline__ unsigned xb_add(unsigned* p, unsigned v) { return __hip_atomic_fetch_add(p, v, __ATOMIC_RELAXED, __HIP_MEMORY_SCOPE_AGENT); }
__device__ __forceinline__ unsigned xb_xcc_id() { return (unsigned)__builtin_amdgcn_s_getreg((3 << 11) | 20) & 0xFu; }
#define XB_SPIN(cond, bar) do { unsigned _sp = 0; while (cond) { __builtin_amdgcn_s_sleep(1); \
    if ((++_sp & 255u) == 0u) { if (xb_ld(&(bar)[XB_TMO])) break; if (_sp > XB_SPIN_CAP) { atomicAdd(&(bar)[XB_TMO], 1u); break; } } } } while (0)
struct XcdBarrier { unsigned* bar; unsigned x; volatile LAS unsigned* st; };
__device__ __forceinline__ XcdBarrier xcd_barrier_post(unsigned* bar, volatile LAS unsigned* st) {
    XcdBarrier b; b.bar = bar; b.x = xb_xcc_id(); b.st = st;
    if (threadIdx.x == 0) (void)xb_add(&bar[XB_XCNT(b.x)], 1u);
    return b;
}
__device__ __forceinline__ void xcd_barrier_complete(unsigned* bar, unsigned x, unsigned& nloc, unsigned& nx) {
    const unsigned G = gridDim.x * gridDim.y * gridDim.z;
    unsigned sum, cnt, mine, sp = 0u;
    for (;;) {
        sum = 0u; cnt = 0u; mine = 0u;
#pragma unroll
        for (unsigned j = 0; j < 16; ++j) { const unsigned c = xb_ld(&bar[XB_XCNT(j)]); sum += c; cnt += (c > 0u) ? 1u : 0u; mine = (j == x) ? c : mine; }
        if (sum == G) break;
        __builtin_amdgcn_s_sleep(1);
        if ((++sp & 255u) == 0u) { if (xb_ld(&bar[XB_TMO])) break; if (sp > XB_SPIN_CAP) { atomicAdd(&bar[XB_TMO], 1u); break; } }
    }
    nloc = mine > 0u ? mine : 1u; nx = cnt > 0u ? cnt : 1u;
}
__device__ __forceinline__ void xcd_barrier(const XcdBarrier& b) {
    asm volatile("s_waitcnt vmcnt(0)" ::: "memory");
    __syncthreads();
    if (threadIdx.x == 0) {
        unsigned* bar = b.bar;
        __builtin_amdgcn_s_waitcnt(0);
        unsigned nloc = b.st[0], nx = b.st[1];
        if (nloc == 0u) { xcd_barrier_complete(bar, b.x, nloc, nx); b.st[0] = nloc; b.st[1] = nx; }
        const unsigned old = xb_add(&bar[XB_XSUB(b.x)], 1u);
        const unsigned gen = old / nloc;
        if (old + 1u == (gen + 1u) * nloc) {
            __builtin_amdgcn_fence(__ATOMIC_RELEASE, "agent");
            asm volatile("s_waitcnt vmcnt(0)" ::: "memory");
            const unsigned og = xb_add(&bar[XB_TOP], 1u);
            const unsigned tg = og / nx;
            if (og + 1u == (tg + 1u) * nx) xb_add(&bar[XB_TOPGEN], 1u);
            else XB_SPIN(xb_ld(&bar[XB_TOPGEN]) == tg, bar);
            __builtin_amdgcn_fence(__ATOMIC_ACQUIRE, "agent");
            xb_add(&bar[XB_XGEN(b.x)], 1u);
            asm volatile("s_waitcnt vmcnt(0)" ::: "memory");
        } else {
            XB_SPIN(xb_ld(&bar[XB_XGEN(b.x)]) == gen, bar);
            __builtin_amdgcn_fence(__ATOMIC_ACQUIRE, "agent");
            asm volatile("s_waitcnt vmcnt(0)" ::: "memory");
        }
    }
    __syncthreads();
}

namespace pg8 {
constexpr int BM = 256, BK = 64, HALF = 128, HTB = HALF * BK * 2, STAGE_BYTES = 8 * HTB;
__host__ __device__ __forceinline__ int lds_byte(int r, int c) { const int st = (r >> 4) * 2 + (c >> 5), rr = r & 15, cc = c & 31, ob = rr * 64 + cc * 2; return st * 1024 + (ob ^ (((ob >> 9) & 1) << 5)); }
__host__ __device__ __forceinline__ void stage_rc(int b, int& R, int& C) { const int st = b / 1024, sb = b % 1024, swz = sb ^ (((sb >> 9) & 1) << 5); R = (st >> 1) * 16 + swz / 64; C = (st & 1) * 32 + (swz % 64) / 2; }
__host__ __device__ __forceinline__ int perm32(int rho) { const int n = rho >> 4, i = rho & 15; return 8 * (i >> 2) + 4 * n + (i & 3); }

struct Unit { const char* A; const char* B; int row0, col0, nrows, aux, e, ti, ord; };

template <class Epi, class Sched, bool ALIGN_EPI, bool GATHER, bool MIDHOOK, int EPI_VM = 0>
__device__ __forceinline__ void gemm_phase(LAS unsigned char* lds, const int K, const Sched& S, const Epi& E) {
    const int tid = threadIdx.x, wid = __builtin_amdgcn_readfirstlane(tid >> 6), lane = tid & 63, wr = wid >> 2, wc = wid & 3, fr = lane & 15, fq = lane >> 4;
    const int nt = K / BK;
    int Rr[2], Cc[2];
    unsigned vcur[2][2], vnxt[2][2], voffB[2];
#pragma unroll
    for (int i = 0; i < 2; ++i) { int R, C; stage_rc(tid * 16 + i * 8192, R, C); Rr[i] = R; Cc[i] = C; const int Rb = (int)Epi::PERM == 2 ? (64 * (R >> 5) + 16 * ((R & 15) >> 2) + 4 * ((R >> 4) & 1) + (R & 3)) : (Epi::PERM ? ((R & ~31) + perm32(R & 31)) : R);
        voffB[i] = (unsigned)(Rb * K + C) * 2u;
#pragma unroll
        for (int h = 0; h < 2; ++h) { vcur[h][i] = (unsigned)((h * HALF + R) * K + C) * 2u; vnxt[h][i] = vcur[h][i]; } }
    const size_t kstep = (size_t)(BK * 2);
    const size_t hstep = (size_t)HALF * K * 2;
    const size_t hstepB = (int)Epi::PERM == 2 ? (size_t)8 * K * 2 : hstep;
    const unsigned ldsw = (unsigned)wid * 1024u;
    const int aoff = lds_byte(wr * 64 + fr, fq * 8), boff = lds_byte(wc * 32 + fr, fq * 8);
#define PG8_SA(b, h) (((b) * 2 + (h)) * HTB)
#define PG8_SB(b, h) ((4 + (b) * 2 + (h)) * HTB)
#define PG8_STAGE(bufoff, gbase, voff) do { _Pragma("unroll") for (int _i = 0; _i < 2; ++_i) \
        __builtin_amdgcn_global_load_lds((const unsigned*)((const char*)(gbase) + (voff)[_i]), (LAS unsigned*)(lds + (bufoff) + ldsw + _i * 8192), 16, 0, 0); } while (0)
#define PG8_LDA(dst, b, h) do { _Pragma("unroll") for (int m = 0; m < 4; ++m) _Pragma("unroll") for (int k = 0; k < 2; ++k) dst[m][k] = *(const LAS bf16x8*)(lds + PG8_SA(b, h) + aoff + m * 2048 + k * 1024); } while (0)
#define PG8_LDB(dst, b, h) do { _Pragma("unroll") for (int n = 0; n < 2; ++n) _Pragma("unroll") for (int k = 0; k < 2; ++k) dst[n][k] = *(const LAS bf16x8*)(lds + PG8_SB(b, h) + boff + n * 2048 + k * 1024); } while (0)
#define PG8_MMA(ai, bj, At, Bt) do { __builtin_amdgcn_s_setprio(1); _Pragma("unroll") for (int m = 0; m < 4; ++m) _Pragma("unroll") for (int n = 0; n < 2; ++n) _Pragma("unroll") for (int k = 0; k < 2; ++k) \
        acc[ai][bj][m][n] = __builtin_amdgcn_mfma_f32_16x16x32_bf16(Bt[n][k], At[m][k], acc[ai][bj][m][n], 0, 0, 0); __builtin_amdgcn_s_setprio(0); } while (0)
#define PG8_WAIT_V(n) asm volatile("s_waitcnt vmcnt(" #n ")" ::: "memory")
#define PG8_WAIT_L(n) asm volatile("s_waitcnt lgkmcnt(" #n ")" ::: "memory")
#define PG8_BAR __builtin_amdgcn_s_barrier()
#define PG8_SCHED __builtin_amdgcn_sched_barrier(0)
    Unit cur, nxt; int ui = 0; int pfn = 1;
    if (!S.next(0, cur)) return;
    if constexpr (GATHER) {
#pragma unroll
        for (int h = 0; h < 2; ++h)
#pragma unroll
            for (int i = 0; i < 2; ++i) vcur[h][i] = S.arow_off(cur, h * HALF + Rr[i]) + (unsigned)Cc[i] * 2u;
    }
    f32x4 acc[2][2][4][2];
#pragma unroll
    for (int a = 0; a < 2; ++a)
#pragma unroll
        for (int b = 0; b < 2; ++b)
#pragma unroll
            for (int m = 0; m < 4; ++m)
#pragma unroll
                for (int n = 0; n < 2; ++n) acc[a][b][m][n] = (f32x4){0.f, 0.f, 0.f, 0.f};
    bf16x8 At[4][2], B0[2][2], B1[2][2];
    const char* cA = cur.A; const char* cB = cur.B;
    PG8_STAGE(PG8_SB(0, 0), cB, voffB); PG8_STAGE(PG8_SB(0, 1), cB + hstepB, voffB); PG8_STAGE(PG8_SA(0, 0), cA, vcur[0]); PG8_STAGE(PG8_SA(0, 1), cA, vcur[1]);
    if (wr == 1) PG8_BAR;
    PG8_WAIT_V(2); PG8_BAR;
    PG8_STAGE(PG8_SB(1, 0), cB + kstep, voffB); PG8_STAGE(PG8_SA(1, 0), cA + kstep, vcur[0]); PG8_STAGE(PG8_SB(1, 1), cB + hstepB + kstep, voffB);
    PG8_WAIT_V(6); PG8_BAR;
    for (;;) {
        const bool has_next = S.next(ui + 1, nxt);
        const char* nA = has_next ? nxt.A : cA; const char* nB = has_next ? nxt.B : cB;
        if constexpr (GATHER) {
#pragma unroll
            for (int h = 0; h < 2; ++h)
#pragma unroll
                for (int i = 0; i < 2; ++i) vnxt[h][i] = has_next ? (S.arow_off(nxt, h * HALF + Rr[i]) + (unsigned)Cc[i] * 2u) : vcur[h][i];
        }
        for (int t = 0; t < nt; t += 2) {
            const bool last = (t == nt - 2);
            if constexpr (MIDHOOK) { if (t == nt / 2) E.mid(acc, cur, wr, wc, fr, fq); }
            const char* a1 = cA + (size_t)(t + 1) * kstep;
            const char* a2 = last ? nA : cA + (size_t)(t + 2) * kstep; const char* b2 = last ? nB : cB + (size_t)(t + 2) * kstep;
            const char* a3 = a2 + kstep; const char* b3 = b2 + kstep;
            unsigned va2[2][2];
#pragma unroll
            for (int h = 0; h < 2; ++h)
#pragma unroll
                for (int i = 0; i < 2; ++i) va2[h][i] = (GATHER && last) ? vnxt[h][i] : vcur[h][i];
            PG8_LDB(B0, 0, 0); PG8_LDB(B1, 0, 1); PG8_SCHED; PG8_LDA(At, 0, 0); PG8_STAGE(PG8_SA(1, 1), a1, vcur[1]);
            static_assert(EPI_VM == 0 || EPI_VM == 8 || EPI_VM == 16, "EPI_VM");
            if (EPI_VM == 8) asm volatile("s_cmp_lg_u32 %0, 0\n\ts_cbranch_scc1 1f\n\ts_waitcnt vmcnt(16)\n\ts_branch 2f\n1:\n\ts_waitcnt vmcnt(8)\n2:" :: "s"(__builtin_amdgcn_readfirstlane(t | pfn)) : "memory", "scc");
            else if (EPI_VM == 16) asm volatile("s_cmp_lg_u32 %0, 0\n\ts_cbranch_scc1 1f\n\ts_waitcnt vmcnt(24)\n\ts_branch 2f\n1:\n\ts_waitcnt vmcnt(8)\n2:" :: "s"(__builtin_amdgcn_readfirstlane(t | pfn)) : "memory", "scc");
            else PG8_WAIT_V(8);
            PG8_WAIT_L(0); PG8_BAR; PG8_MMA(0, 0, At, B0); PG8_MMA(0, 1, At, B1); PG8_BAR; PG8_SCHED;
            PG8_LDA(At, 0, 1); PG8_STAGE(PG8_SB(0, 0), b2, voffB); PG8_STAGE(PG8_SB(0, 1), b2 + hstepB, voffB); PG8_STAGE(PG8_SA(0, 0), a2, va2[0]);
            PG8_WAIT_V(8); PG8_WAIT_L(0); PG8_BAR; PG8_MMA(1, 0, At, B0); PG8_MMA(1, 1, At, B1); PG8_BAR; PG8_SCHED;
            PG8_LDB(B0, 1, 0); PG8_LDB(B1, 1, 1); PG8_SCHED; PG8_LDA(At, 1, 0); PG8_STAGE(PG8_SA(0, 1), a2, va2[1]);
            PG8_WAIT_V(8); PG8_WAIT_L(0); PG8_BAR; PG8_MMA(0, 0, At, B0); PG8_MMA(0, 1, At, B1); PG8_BAR; PG8_SCHED;
            PG8_LDA(At, 1, 1); PG8_STAGE(PG8_SB(1, 0), b3, voffB); PG8_STAGE(PG8_SB(1, 1), b3 + hstepB, voffB); PG8_STAGE(PG8_SA(1, 0), a3, va2[0]);
            PG8_WAIT_V(8); PG8_WAIT_L(0); PG8_BAR; PG8_MMA(1, 0, At, B0); PG8_MMA(1, 1, At, B1); PG8_BAR; PG8_SCHED;
        }
        if constexpr (ALIGN_EPI) { if (wr == 0) PG8_BAR; }
        E(acc, cur, wr, wc, fr, fq);
        if (!has_next) break;
#pragma unroll
        for (int a = 0; a < 2; ++a)
#pragma unroll
            for (int b = 0; b < 2; ++b)
#pragma unroll
                for (int m = 0; m < 4; ++m)
#pragma unroll
                    for (int n = 0; n < 2; ++n) acc[a][b][m][n] = (f32x4){0.f, 0.f, 0.f, 0.f};
        pfn = (cur.nrows == BM) ? 0 : 1;
        cur = nxt; cA = nA; cB = nB; ++ui;
        if constexpr (GATHER) {
#pragma unroll
            for (int h = 0; h < 2; ++h)
#pragma unroll
                for (int i = 0; i < 2; ++i) vcur[h][i] = vnxt[h][i];
        }
        if constexpr (ALIGN_EPI) { if (wr == 1) PG8_BAR; }
    }
    PG8_WAIT_V(0);
    if constexpr (!ALIGN_EPI) { if (wr == 0) PG8_BAR; }
    PG8_BAR;
#undef PG8_SA
#undef PG8_SB
#undef PG8_STAGE
#undef PG8_LDA
#undef PG8_LDB
#undef PG8_MMA
#undef PG8_WAIT_V
#undef PG8_WAIT_L
#undef PG8_BAR
#undef PG8_SCHED
}

struct DenseOrder {
    const char* A; const char* Bt; int K, nM, nN, nwg, G, c;
    __device__ void init(const void* A_, const void* Bt_, int M, int N, int K_, int G_, int c_) { A = (const char*)A_; Bt = (const char*)Bt_; K = K_; nM = M / BM; nN = N / BM; nwg = nM * nN; G = G_; c = c_; }
    __device__ __forceinline__ bool next(int i, Unit& u) const {
        const long L = (long)i * G + c; if (L >= nwg) return false;
        int wgid = (int)L; { const int q = nwg / 8, r = nwg % 8, xcd = wgid % 8, off = wgid / 8; wgid = (xcd < r ? xcd * (q + 1) : r * (q + 1) + (xcd - r) * q) + off; }
        const int nig = 8 * nN, gid = wgid / nig, fm = gid * 8, gsz = (nM - fm) < 8 ? (nM - fm) : 8;
        const int pm = fm + ((wgid % nig) % gsz), pn = (wgid % nig) / gsz;
        u.A = A + (size_t)pm * BM * K * 2; u.B = Bt + (size_t)pn * BM * K * 2; u.row0 = pm * BM; u.col0 = pn * BM; u.nrows = BM; u.aux = pn; u.e = 0; u.ti = 0; u.ord = 0; return true;
    }
    __device__ __forceinline__ unsigned arow_off(const Unit&, int) const { return 0u; }
};
}

struct EpiQKV {
    static constexpr bool PERM = true;
    bf16_t* O; bf16_t* Gt;
    __device__ __forceinline__ void operator()(const f32x4 (&acc)[2][2][4][2], const pg8::Unit& u, int wr, int wc, int fr, int fq) const {
        const bool sig = u.aux >= 9;
        const int row0 = u.row0 + wr * 64 + fr, col0 = u.col0 + wc * 32 + 8 * fq;
        bf16_t* const base = sig ? Gt - QP : O; const int pitch = sig ? GP : QP;
#pragma unroll
        for (int ai = 0; ai < 2; ++ai)
#pragma unroll
            for (int m = 0; m < 4; ++m) { bf16_t* rowp = base + (size_t)(row0 + ai * 128 + m * 16) * pitch + col0;
#pragma unroll
                for (int bj = 0; bj < 2; ++bj) { f32x4 v0 = acc[ai][bj][m][0], v1 = acc[ai][bj][m][1];
                    if (sig) {
#pragma unroll
                        for (int j = 0; j < 4; ++j) { v0[j] = __builtin_amdgcn_rcpf(1.0f + __builtin_amdgcn_exp2f(-1.4426950408889634f * v0[j])); v1[j] = __builtin_amdgcn_rcpf(1.0f + __builtin_amdgcn_exp2f(-1.4426950408889634f * v1[j])); }
                    }
                    if (sig) { int w0 = 0, w1 = 0;
                        w0 = __builtin_amdgcn_cvt_pk_fp8_f32(v0[0] * 256.f, v0[1] * 256.f, w0, false); w0 = __builtin_amdgcn_cvt_pk_fp8_f32(v0[2] * 256.f, v0[3] * 256.f, w0, true);
                        w1 = __builtin_amdgcn_cvt_pk_fp8_f32(v1[0] * 256.f, v1[1] * 256.f, w1, false); w1 = __builtin_amdgcn_cvt_pk_fp8_f32(v1[2] * 256.f, v1[3] * 256.f, w1, true);
                        u32x2 w; w.x = (unsigned)w0; w.y = (unsigned)w1;
                        *(u32x2*)((unsigned char*)Gt + (size_t)(row0 + ai * 128 + m * 16) * GP + (col0 - QP) + bj * 128) = w;
                    } else {
                        u32x4 w; w.x = cvt_pk_bf16(v0[0], v0[1]); w.y = cvt_pk_bf16(v0[2], v0[3]); w.z = cvt_pk_bf16(v1[0], v1[1]); w.w = cvt_pk_bf16(v1[2], v1[3]);
                        *(u32x4*)(rowp + bj * 128) = w; } } }
    }
};

struct EpiMerge {
    static constexpr int PERM = 2;
    const bf16_t* Gt; bf16_t* O;
    __device__ __forceinline__ void mid(f32x4 (&acc)[2][2][4][2], const pg8::Unit& u, int wr, int wc, int fr, int fq) const {
        int row0 = u.row0 + wr * 64 + fr, col0 = u.col0 + wc * 64 + 16 * fq;
        asm volatile("" : "+v"(row0), "+v"(col0));
#pragma unroll
        for (int ai = 0; ai < 2; ++ai)
#pragma unroll
            for (int m = 0; m < 4; ++m) { const unsigned char* gp = (const unsigned char*)Gt + (size_t)(row0 + ai * 128 + m * 16) * GP + col0;
                const u32x4 a = *(const u32x4*)gp, b = *(const u32x4*)(gp + 1024);
#pragma unroll
                for (int d = 0; d < 4; ++d) {
                    const f32x2 al = __builtin_amdgcn_cvt_pk_f32_fp8((int)a[d], false), ah = __builtin_amdgcn_cvt_pk_f32_fp8((int)a[d], true);
                    const f32x2 bl = __builtin_amdgcn_cvt_pk_f32_fp8((int)b[d], false), bh = __builtin_amdgcn_cvt_pk_f32_fp8((int)b[d], true);
                    acc[ai][d >> 1][m][d & 1][0] *= al.x * __builtin_amdgcn_rcpf(fmaxf(bl.x, 1e-30f)); acc[ai][d >> 1][m][d & 1][1] *= al.y * __builtin_amdgcn_rcpf(fmaxf(bl.y, 1e-30f));
                    acc[ai][d >> 1][m][d & 1][2] *= ah.x * __builtin_amdgcn_rcpf(fmaxf(bh.x, 1e-30f)); acc[ai][d >> 1][m][d & 1][3] *= ah.y * __builtin_amdgcn_rcpf(fmaxf(bh.y, 1e-30f)); }
                asm volatile("" ::: "memory"); }
    }
    __device__ __forceinline__ void operator()(const f32x4 (&acc)[2][2][4][2], const pg8::Unit& u, int wr, int wc, int fr, int fq) const {
        int row0 = u.row0 + wr * 64 + fr, col0 = u.col0 + wc * 64 + 16 * fq;
        asm volatile("" : "+v"(row0), "+v"(col0));
#pragma unroll
        for (int ai = 0; ai < 2; ++ai)
#pragma unroll
            for (int m = 0; m < 4; ++m) { const unsigned char* gp = (const unsigned char*)Gt + (size_t)(row0 + ai * 128 + m * 16) * GP + col0; bf16_t* rowp = O + (size_t)(row0 + ai * 128 + m * 16) * D + col0;
                const u32x4 b = *(const u32x4*)(gp + 1024); float v[16];
#pragma unroll
                for (int d = 0; d < 4; ++d) { const f32x2 bl = __builtin_amdgcn_cvt_pk_f32_fp8((int)b[d], false), bh = __builtin_amdgcn_cvt_pk_f32_fp8((int)b[d], true);
                    v[4 * d] = acc[ai][d >> 1][m][d & 1][0] * (fmaxf(bl.x, 1e-30f) * 0.00390625f); v[4 * d + 1] = acc[ai][d >> 1][m][d & 1][1] * (fmaxf(bl.y, 1e-30f) * 0.00390625f);
                    v[4 * d + 2] = acc[ai][d >> 1][m][d & 1][2] * (fmaxf(bh.x, 1e-30f) * 0.00390625f); v[4 * d + 3] = acc[ai][d >> 1][m][d & 1][3] * (fmaxf(bh.y, 1e-30f) * 0.00390625f); }
                u32x4 w0, w1; w0.x = cvt_pk_bf16(v[0], v[1]); w0.y = cvt_pk_bf16(v[2], v[3]); w0.z = cvt_pk_bf16(v[4], v[5]); w0.w = cvt_pk_bf16(v[6], v[7]);
                w1.x = cvt_pk_bf16(v[8], v[9]); w1.y = cvt_pk_bf16(v[10], v[11]); w1.z = cvt_pk_bf16(v[12], v[13]); w1.w = cvt_pk_bf16(v[14], v[15]);
                *(u32x4*)rowp = w0; *(u32x4*)(rowp + 8) = w1;
                asm volatile("" ::: "memory"); }
    }
};
struct EpiWout {
    static constexpr bool PERM = true;
    const bf16_t* X; bf16_t* O;
    __device__ __forceinline__ void operator()(const f32x4 (&acc)[2][2][4][2], const pg8::Unit& u, int wr, int wc, int fr, int fq) const {
        int row0 = u.row0 + wr * 64 + fr, col0 = u.col0 + wc * 32 + 8 * fq;
        asm volatile("" : "+v"(row0), "+v"(col0));
#pragma unroll
        for (int ai = 0; ai < 2; ++ai)
#pragma unroll
            for (int m = 0; m < 4; ++m) { const size_t off = (size_t)(row0 + ai * 128 + m * 16) * D + col0;
#pragma unroll
                for (int bj = 0; bj < 2; ++bj) { const u32x4 xv = *(const u32x4*)(X + off + bj * 128);
                    f32x4 x0, x1; x0[0] = __builtin_bit_cast(float, xv[0] << 16); x0[1] = __builtin_bit_cast(float, xv[0] & 0xffff0000u); x0[2] = __builtin_bit_cast(float, xv[1] << 16); x0[3] = __builtin_bit_cast(float, xv[1] & 0xffff0000u);
                    x1[0] = __builtin_bit_cast(float, xv[2] << 16); x1[1] = __builtin_bit_cast(float, xv[2] & 0xffff0000u); x1[2] = __builtin_bit_cast(float, xv[3] << 16); x1[3] = __builtin_bit_cast(float, xv[3] & 0xffff0000u);
                    const f32x4 v0 = x0 * DN_ALPHA + acc[ai][bj][m][0], v1 = x1 * DN_ALPHA + acc[ai][bj][m][1];
                    u32x4 w; w.x = cvt_pk_bf16(v0[0], v0[1]); w.y = cvt_pk_bf16(v0[2], v0[3]); w.z = cvt_pk_bf16(v1[0], v1[1]); w.w = cvt_pk_bf16(v1[2], v1[3]);
                    *(u32x4*)(O + off + bj * 128) = w; }
                if (m & 1) asm volatile("" ::: "memory"); }
    }
};

__device__ __forceinline__ float wave_sum_x(float v) {
#pragma unroll
    for (int o = 1; o < 64; o <<= 1) v += __shfl_xor(v, o);
    return v;
}
__device__ __forceinline__ void ln_regs_to_bf16(const u32x4 a, const u32x4 c, bf16_t* orow, const f32x4 (&gv)[4], const f32x4 (&bv)[4], int lane) {
    float v[16];
#pragma unroll
    for (int j = 0; j < 4; ++j) { v[2 * j] = __builtin_bit_cast(float, a[j] << 16); v[2 * j + 1] = __builtin_bit_cast(float, a[j] & 0xffff0000u); v[8 + 2 * j] = __builtin_bit_cast(float, c[j] << 16); v[8 + 2 * j + 1] = __builtin_bit_cast(float, c[j] & 0xffff0000u); }
    float sm = 0.f;
#pragma unroll
    for (int j = 0; j < 16; ++j) sm += v[j];
    const float mean = wave_sum_x(sm) * (1.f / D); float s2 = 0.f;
#pragma unroll
    for (int j = 0; j < 16; ++j) { v[j] -= mean; s2 += v[j] * v[j]; }
    const float rstd = 1.f / sqrtf(wave_sum_x(s2) * (1.f / D) + LN_EPS);
    u32x4 o[2];
#pragma unroll
    for (int j = 0; j < 4; ++j) { const f32x4 gg = gv[j], bb = bv[j];
        const float y0 = v[4 * j] * rstd * gg.x + bb.x, y1 = v[4 * j + 1] * rstd * gg.y + bb.y, y2 = v[4 * j + 2] * rstd * gg.z + bb.z, y3 = v[4 * j + 3] * rstd * gg.w + bb.w;
        o[j >> 1][(j & 1) * 2] = pk2(y0, y1); o[j >> 1][(j & 1) * 2 + 1] = pk2(y2, y3); }
    *(u32x4*)(orow + 16 * lane) = o[0]; *(u32x4*)(orow + 16 * lane + 8) = o[1];
}

constexpr int NWAVES = 8;
constexpr int RING_BYTES = 131072, MISC_OFF = RING_BYTES + 320, LDS_BYTES = 147456;
struct EpiLogits {
    static constexpr bool PERM = false;
    float* O;
    __device__ __forceinline__ void operator()(const f32x4 (&acc)[2][2][4][2], const pg8::Unit& u, int wr, int wc, int fr, int fq) const {
        int row0 = u.row0 + wr * 64 + fr, col0 = u.col0 + wc * 32 + 4 * fq;
        asm volatile("" : "+v"(row0), "+v"(col0));
#pragma unroll
        for (int ai = 0; ai < 2; ++ai)
#pragma unroll
            for (int m = 0; m < 4; ++m) { const size_t off = (size_t)(row0 + ai * 128 + m * 16) * NE + col0;
#pragma unroll
                for (int bj = 0; bj < 2; ++bj)
#pragma unroll
                    for (int n = 0; n < 2; ++n) *(f32x4*)(O + off + bj * 128 + n * 16) = acc[ai][bj][m][n]; }
    }
};
struct MoeTables { LAS int* tn; LAS int* es; LAS int* us; };
struct MoeUnits { LAS int* rec; LAS int* cnt; LAS unsigned short* tok; };
template <int NPN> struct MoeOrder {
    MoeTables tb; MoeUnits mu; const char* Abase; const char* Bbase; size_t strideE, stridePN; size_t apitch;
    int chunk; int colw;
    __device__ __forceinline__ bool next(int i, pg8::Unit& u) const {
        if (i >= __builtin_amdgcn_readfirstlane(mu.cnt[0])) return false;
        const int e = __builtin_amdgcn_readfirstlane(mu.rec[4 * i]), ti = __builtin_amdgcn_readfirstlane(mu.rec[4 * i + 1]), pn = __builtin_amdgcn_readfirstlane(mu.rec[4 * i + 2]);
        const int ne = __builtin_amdgcn_readfirstlane(tb.tn[e]), e0 = __builtin_amdgcn_readfirstlane(tb.es[e]);
        u.e = e; u.ti = ti; u.aux = pn; u.ord = i; u.row0 = e0 + ti * 256; u.nrows = (ne - ti * 256) < 256 ? (ne - ti * 256) : 256; u.col0 = pn * colw;
        u.A = Abase + (size_t)u.row0 * apitch; u.B = Bbase + (size_t)e * strideE + (size_t)pn * stridePN;
        return true;
    }
    __device__ __forceinline__ unsigned arow_off(const pg8::Unit& u, int r) const { return (unsigned)(chunk * CHT + (int)mu.tok[u.ord * 256 + r]) * (unsigned)(D * 2); }
};
template <int NPN, bool GATHER> __device__ __forceinline__ void moe_units(const MoeTables& tb, const MoeUnits& mu, int G, int c, int tid, const unsigned short* list, int chunk) {
    __syncthreads();
    const int NU = tb.us[257] * NPN;
    if (tid < 24) {
        const long L = (long)tid * G + c;
        if (L < NU) {
            int wgid = (int)L; { const int q = NU / 8, r = NU % 8, xcd = wgid % 8, off = wgid / 8; wgid = (xcd < r ? xcd * (q + 1) : r * (q + 1) + (xcd - r) * q) + off; }
            const int rt = wgid / NPN, pn = wgid % NPN;
            int lo = 0, hi = 257;
            while (hi - lo > 1) { const int mid = (lo + hi) >> 1; if (tb.us[mid] <= rt) lo = mid; else hi = mid; }
            mu.rec[4 * tid] = lo; mu.rec[4 * tid + 1] = rt - tb.us[lo]; mu.rec[4 * tid + 2] = pn;
        }
    }
    const int n = c < NU ? (NU - 1 - c) / G + 1 : 0;
    if (tid == 0) mu.cnt[0] = n < 24 ? n : 24;
    __syncthreads();
    if (GATHER) {
        const int nn = n < 16 ? n : 16;
        for (int x = tid; x < nn * 256; x += NWAVES * 64) { const int ui = x >> 8, r = x & 255, e = mu.rec[4 * ui], ti = mu.rec[4 * ui + 1];
            const int nr = tb.tn[e] - ti * 256, rr = r < nr ? r : nr - 1; int tl = ti * 256 + rr;
            if (e < 256) tl = (int)list[((size_t)chunk * 256 + e) * CHT + tl];
            mu.tok[x] = (unsigned short)tl; }
        __syncthreads();
    }
}
struct EpiGLU {
    static constexpr bool PERM = true;
    bf16_t* HB;
    __device__ __forceinline__ void operator()(const f32x4 (&acc)[2][2][4][2], const pg8::Unit& u, int wr, int wc, int fr, int fq) const {
        int rt0 = wr * 64 + fr, col0 = u.col0 + wc * 32 + 8 * fq;
        asm volatile("" : "+v"(rt0), "+v"(col0));
#pragma unroll
        for (int ai = 0; ai < 2; ++ai)
#pragma unroll
            for (int m = 0; m < 4; ++m) { int rt = rt0 + ai * 128 + m * 16;
                asm volatile("" : "+v"(rt));
                float v[8];
#pragma unroll
                for (int j = 0; j < 8; ++j) { const float g = acc[ai][0][m][j >> 2][j & 3], up = acc[ai][1][m][j >> 2][j & 3];
                    v[j] = g * __builtin_amdgcn_rcpf(1.0f + __builtin_amdgcn_exp2f(-1.4426950408889634f * g)) * up; }
                u32x4 w; w.x = cvt_pk_bf16(v[0], v[1]); w.y = cvt_pk_bf16(v[2], v[3]); w.z = cvt_pk_bf16(v[4], v[5]); w.w = cvt_pk_bf16(v[6], v[7]);
                if (rt < u.nrows) *(u32x4*)(HB + (size_t)(u.row0 + rt) * EH + col0) = w; }
    }
};
struct EpiDown {
    static constexpr int PERM = 2;
    unsigned char* Y8; bf16_t* YS; const bf16_t* H1; int chunk;
    __device__ __forceinline__ void operator()(const f32x4 (&acc)[2][2][4][2], const pg8::Unit& u, int wr, int wc, int fr, int fq) const {
        int rt0 = wr * 64 + fr, col0 = u.col0 + wc * 64 + 16 * fq;
        asm volatile("" : "+v"(rt0), "+v"(col0));
        const bool shared = u.e == 256;
#pragma unroll
        for (int ai = 0; ai < 2; ++ai)
#pragma unroll
            for (int m = 0; m < 4; ++m) { int rt = rt0 + ai * 128 + m * 16;
                asm volatile("" : "+v"(rt));
                if (rt < u.nrows) {
                    float v[16];
#pragma unroll
                    for (int j = 0; j < 16; ++j) v[j] = acc[ai][j >> 3][m][(j >> 2) & 1][j & 3];
                    if (shared) { const bf16_t* hp = H1 + (size_t)(chunk * CHT + u.ti * 256 + rt) * D + col0; const u32x4 h0 = *(const u32x4*)hp, h1 = *(const u32x4*)(hp + 8);
#pragma unroll
                        for (int j = 0; j < 4; ++j) { v[2 * j] += DN_ALPHA * __builtin_bit_cast(float, h0[j] << 16); v[2 * j + 1] += DN_ALPHA * __builtin_bit_cast(float, h0[j] & 0xffff0000u);
                            v[8 + 2 * j] += DN_ALPHA * __builtin_bit_cast(float, h1[j] << 16); v[8 + 2 * j + 1] += DN_ALPHA * __builtin_bit_cast(float, h1[j] & 0xffff0000u); }
                        u32x4 w0, w1; w0.x = cvt_pk_bf16(v[0], v[1]); w0.y = cvt_pk_bf16(v[2], v[3]); w0.z = cvt_pk_bf16(v[4], v[5]); w0.w = cvt_pk_bf16(v[6], v[7]);
                        w1.x = cvt_pk_bf16(v[8], v[9]); w1.y = cvt_pk_bf16(v[10], v[11]); w1.z = cvt_pk_bf16(v[12], v[13]); w1.w = cvt_pk_bf16(v[14], v[15]);
                        bf16_t* yp = YS + (size_t)(u.ti * 256 + rt) * D + col0; *(u32x4*)yp = w0; *(u32x4*)(yp + 8) = w1;
                    } else { int w[4] = {0, 0, 0, 0};
#pragma unroll
                        for (int d = 0; d < 4; ++d) { w[d] = __builtin_amdgcn_cvt_pk_fp8_f32(v[4 * d] * 16.f, v[4 * d + 1] * 16.f, w[d], false); w[d] = __builtin_amdgcn_cvt_pk_fp8_f32(v[4 * d + 2] * 16.f, v[4 * d + 3] * 16.f, w[d], true); }
                        u32x4 ww; ww.x = (unsigned)w[0]; ww.y = (unsigned)w[1]; ww.z = (unsigned)w[2]; ww.w = (unsigned)w[3];
                        *(u32x4*)(Y8 + (size_t)(u.row0 + rt) * D + col0) = ww; } }
                asm volatile("" ::: "memory"); }
    }
};

constexpr size_t WS_W1T = 15 * MiB;
constexpr size_t WS_W2T = 16 * MiB;
constexpr size_t WS_C1 = 16 * MiB + 65536;
namespace att {
constexpr float LOG2E = 1.4426950408889634f;
constexpr float C2 = 0.125f * LOG2E;
constexpr float THR = 8.0f;
constexpr int NB = 2;
constexpr int L_KV = 0, L_IMP = 65536, L_SELM = 98304, L_UW = 99584, L_JL = 99616, L_BIAS = 99840, L_HID = 108288, L_END = 112640;
constexpr int MODE_C1 = 0, MODE_C2 = 1, MODE_SEL = 2, MODE_WIN = 3, MODE_SWA = 4;
struct Ctx {
    LAS unsigned char* lds; int tid, lane, wave;
    const bf16_t* qkv_b;
    const bf16_t* kc; const bf16_t* vc;
    int cur, g;
};
__device__ __forceinline__ float ex2(float x) { return __builtin_amdgcn_exp2f(x); }
__device__ __forceinline__ float colmax4(float x) { x = fmaxf(x, __shfl_xor(x, 16)); return fmaxf(x, __shfl_xor(x, 32)); }
__device__ __forceinline__ float col_sum4(float x) { x += __shfl_xor(x, 16); return x + __shfl_xor(x, 32); }
__device__ __forceinline__ float quad_sum(float x) {
    x += __builtin_bit_cast(float, __builtin_amdgcn_update_dpp(0u, __builtin_bit_cast(unsigned, x), 0xB1, 0xF, 0xF, true));
    x += __builtin_bit_cast(float, __builtin_amdgcn_update_dpp(0u, __builtin_bit_cast(unsigned, x), 0x4E, 0xF, 0xF, true));
    return x;
}
__device__ __forceinline__ void glds16(const void* gsrc, unsigned lds_dst) { unsigned keep;
    asm volatile("s_mov_b32 %0, m0\n\ts_mov_b32 m0, %2\n\ts_nop 0\n\tglobal_load_lds_dwordx4 %1, off\n\ts_mov_b32 m0, %0" : "=&s"(keep) : "v"(gsrc), "s"(lds_dst) : "memory"); }
template <int MODE> __device__ __forceinline__ void blk_dma(const Ctx& c, int j, int slot) {
    const int key = c.tid >> 3, chs = c.tid & 7;
    const int kch = chs ^ (key & 7), vch = chs ^ (((key >> 1) & 3) << 1);
    const unsigned dst = (unsigned)__builtin_amdgcn_readfirstlane((int)(unsigned)(uintptr_t)(c.lds + L_KV + slot * 16384 + c.wave * 1024));
    if (MODE <= MODE_C2) { const size_t o = (size_t)(64 * j + key) * 128;
        glds16(c.kc + o + kch * 8, dst);
        if (MODE == MODE_C2) glds16(c.vc + o + vch * 8, dst + 8192u);
    } else { constexpr int KC = MODE == MODE_SEL ? C_KS : (MODE == MODE_WIN ? C_KW : C_KB), VC = MODE == MODE_SEL ? C_VS : (MODE == MODE_WIN ? C_VW : C_VB);
        const bf16_t* rp = c.qkv_b + (size_t)(64 * j + key) * QP + c.g * 64;
        glds16(rp + KC + kch * 8, dst);
        glds16(rp + VC + vch * 8, dst + 8192u); }
}
struct NoDma { __device__ __forceinline__ void operator()(int) const {} };
template <int MODE, bool PRE = false, class NextDma = NoDma> __device__ __forceinline__ void branch(const Ctx& c, const bf16x8 (&Qf)[2][2], f32x4 (&O)[2][4], float (&m)[2], float (&l)[2], const float (&invl)[2], int nblk, int j0, int hh, int par = 0, NextDma nextdma = NoDma()) {
    const int lane = c.lane, q = lane >> 4, cc = lane & 15;
    const LAS unsigned char* jl = c.lds + L_JL;
    const LAS float* biasL = (const LAS float*)(c.lds + L_BIAS) + hh * 132;
    LAS float* impL = (LAS float*)(c.lds + L_IMP);
    const LAS unsigned* selm = (const LAS unsigned*)(c.lds + L_SELM);
    const float c31 = biasL[128];
    const int nstage = (nblk + NB - 1) / NB;
    if (!PRE) {
#pragma unroll
        for (int bi = 0; bi < NB; ++bi) if (bi < nblk) blk_dma<MODE>(c, (MODE == MODE_SEL) ? (int)jl[bi] : j0 + bi, par * NB + bi);
    }
    asm volatile("s_waitcnt vmcnt(0)" ::: "memory");
    __syncthreads();
    const int kaddr0 = cc * 128 + (((0 + q) ^ (lane & 7)) << 4), kaddr1 = cc * 128 + (((4 + q) ^ (lane & 7)) << 4);
    const int vsw = ((2 * q + (cc >> 3)) & 3) << 1, vkey = (4 * q + (cc >> 2)) * 128, vb = (cc & 3) >> 1, vwi = (cc & 1) * 8;
    for (int st = 0; st < nstage; ++st) {
        if (st + 1 < nstage) {
#pragma unroll
            for (int bi = 0; bi < NB; ++bi) { const int i2 = (st + 1) * NB + bi; if (i2 < nblk) blk_dma<MODE>(c, (MODE == MODE_SEL) ? (int)jl[i2] : j0 + i2, ((st + 1 + par) & 1) * NB + bi); }
        } else nextdma((st + 1 + par) & 1);
#pragma unroll
        for (int bi = 0; bi < NB; ++bi) {
            const int i = st * NB + bi;
            if (i >= nblk) break;
            const int j = (MODE == MODE_SEL) ? (int)jl[i] : j0 + i;
            const LAS unsigned char* Kb = c.lds + L_KV + (((st + par) & 1) * NB + bi) * 16384;
            const LAS unsigned char* Vb = Kb + 8192;
            const int back = c.cur - j;
            bool far;
            if (MODE <= MODE_C2) far = !(64 * (j + 1) > 4 * c.cur - 10);
            else far = back >= 3 && !(MODE == MODE_WIN && back == 8);
            bool act[2] = {true, true}, own[2] = {true, true};
            if (MODE == MODE_SEL) {
#pragma unroll
                for (int a = 0; a < 2; ++a) { const unsigned uw = selm[256 + (2 * c.wave + a) * 4 + (j >> 5)];
                    act[a] = __builtin_amdgcn_readfirstlane((uw >> (j & 31)) & 1u) != 0;
                    own[a] = (selm[(8 * c.wave + 4 * a + (cc >> 2)) * 4 + (j >> 5)] >> (j & 31)) & 1u; }
                if (!act[0] && !act[1]) continue;
            }
            bf16x8 Kf[4][2];
#pragma unroll
            for (int kt = 0; kt < 4; ++kt) { Kf[kt][0] = *(const LAS bf16x8*)(Kb + kt * 2048 + kaddr0); Kf[kt][1] = *(const LAS bf16x8*)(Kb + kt * 2048 + kaddr1); }
            f32x4 s[2][4];
#pragma unroll
            for (int a = 0; a < 2; ++a) {
                if (!act[a]) continue;
#pragma unroll
                for (int kt = 0; kt < 4; ++kt) {
                    s[a][kt] = __builtin_amdgcn_mfma_f32_16x16x32_bf16(Kf[kt][0], Qf[a][0], (f32x4){0.f, 0.f, 0.f, 0.f}, 0, 0, 0);
                    s[a][kt] = __builtin_amdgcn_mfma_f32_16x16x32_bf16(Kf[kt][1], Qf[a][1], s[a][kt], 0, 0, 0);
                }
            }
            bf16x8 Vf[4][2];
            if (MODE != MODE_C1) {
#pragma unroll
                for (int mt = 0; mt < 4; ++mt) { const int va = vkey + ((((2 * mt) ^ vsw) + vb) << 4) + vwi;
#pragma unroll
                    for (int k2 = 0; k2 < 2; ++k2) {
                        const v4i16_t lo = __builtin_amdgcn_ds_read_tr16_b64_v4i16((LAS v4i16_t*)(Vb + (2 * k2) * 2048 + va));
                        const v4i16_t hi = __builtin_amdgcn_ds_read_tr16_b64_v4i16((LAS v4i16_t*)(Vb + (2 * k2 + 1) * 2048 + va));
                        Vf[mt][k2] = (bf16x8){lo[0], lo[1], lo[2], lo[3], hi[0], hi[1], hi[2], hi[3]}; } }
            }
#pragma unroll
            for (int a = 0; a < 2; ++a) {
                if (!act[a]) continue;
                const int tl = 8 * c.wave + 4 * a + (cc >> 2);
                if (far) {
                    const float cb = own[a] ? c31 : -INFINITY;
#pragma unroll
                    for (int kt = 0; kt < 4; ++kt)
#pragma unroll
                        for (int r = 0; r < 4; ++r) s[a][kt][r] = fmaf(s[a][kt][r], C2, cb);
                } else if (MODE <= MODE_C2) {
                    const int dd0 = 64 * c.cur + tl - 1024 * j - 31;
#pragma unroll
                    for (int kt = 0; kt < 4; ++kt)
#pragma unroll
                        for (int r = 0; r < 4; ++r) { const int d = dd0 - 16 * (16 * kt + 4 * q + r);
                            s[a][kt][r] = fmaf(s[a][kt][r], C2, biasL[d < 0 ? 0 : (d > 128 ? 128 : d)]) + (d >= 0 ? 0.f : -INFINITY); }
                } else {
                    const int dd0 = 64 * back + tl;
                    const int hi_lim = (MODE == MODE_WIN) ? 512 : (MODE == MODE_SWA ? 128 : (1 << 30));
#pragma unroll
                    for (int kt = 0; kt < 4; ++kt)
#pragma unroll
                        for (int r = 0; r < 4; ++r) { const int d = dd0 - (16 * kt + 4 * q + r);
                            s[a][kt][r] = fmaf(s[a][kt][r], C2, biasL[d < 0 ? 0 : (d > 128 ? 128 : d)]) + (((unsigned)d < (unsigned)hi_lim && own[a]) ? 0.f : -INFINITY); }
                }
                if (MODE != MODE_C2) {
                    float bm = fmaxf(fmaxf(fmaxf(s[a][0][0], s[a][0][1]), fmaxf(s[a][0][2], s[a][0][3])), fmaxf(fmaxf(s[a][1][0], s[a][1][1]), fmaxf(s[a][1][2], s[a][1][3])));
                    bm = fmaxf(bm, fmaxf(fmaxf(fmaxf(s[a][2][0], s[a][2][1]), fmaxf(s[a][2][2], s[a][2][3])), fmaxf(fmaxf(s[a][3][0], s[a][3][1]), fmaxf(s[a][3][2], s[a][3][3]))));
                    if (__any(bm > m[a] + THR)) {
                        bm = colmax4(bm);
                        const float mn = fmaxf(m[a], bm);
                        const float alpha = (mn == m[a]) ? 1.0f : ex2(m[a] - mn);
                        m[a] = mn; l[a] *= alpha;
                        if (MODE != MODE_C1) {
#pragma unroll
                            for (int mt = 0; mt < 4; ++mt) O[a][mt] = O[a][mt] * alpha;
                        }
                    }
                }
                const float mu = (m[a] == -INFINITY) ? 0.f : m[a];
                float ps = 0.f;
#pragma unroll
                for (int kt = 0; kt < 4; ++kt)
#pragma unroll
                    for (int r = 0; r < 4; ++r) { float p = ex2(s[a][kt][r] - mu); if (MODE == MODE_C2) p *= invl[a]; s[a][kt][r] = p; ps += p; }
                l[a] += ps;
                if (MODE == MODE_C2) {
#pragma unroll
                    for (int kt = 0; kt < 4; ++kt) {
                        const float s4 = quad_sum((s[a][kt][0] + s[a][kt][1]) + (s[a][kt][2] + s[a][kt][3])), lastv = quad_sum(s[a][kt][3]);
                        const int jp = 16 * j + 4 * kt + q;
                        if ((cc & 3) == 0) { __hip_atomic_fetch_add(impL + tl * 128 + jp, s4, __ATOMIC_RELAXED, __HIP_MEMORY_SCOPE_WORKGROUP);
                            if (jp < 127) __hip_atomic_fetch_add(impL + tl * 128 + jp + 1, lastv, __ATOMIC_RELAXED, __HIP_MEMORY_SCOPE_WORKGROUP); }
                    }
                }
            }
            if (MODE == MODE_C1) continue;
#pragma unroll
            for (int a = 0; a < 2; ++a) {
                if (!act[a]) continue;
                bf16x8 Pf[2];
#pragma unroll
                for (int k2 = 0; k2 < 2; ++k2) { u32x4 w; w.x = cvt_pk_bf16(s[a][2 * k2][0], s[a][2 * k2][1]); w.y = cvt_pk_bf16(s[a][2 * k2][2], s[a][2 * k2][3]); w.z = cvt_pk_bf16(s[a][2 * k2 + 1][0], s[a][2 * k2 + 1][1]); w.w = cvt_pk_bf16(s[a][2 * k2 + 1][2], s[a][2 * k2 + 1][3]);
                    Pf[k2] = __builtin_bit_cast(bf16x8, w); }
#pragma unroll
                for (int mt = 0; mt < 4; ++mt)
#pragma unroll
                    for (int k2 = 0; k2 < 2; ++k2) O[a][mt] = __builtin_amdgcn_mfma_f32_16x16x32_bf16(Vf[mt][k2], Pf[k2], O[a][mt], 0, 0, 0);
            }
        }
        asm volatile("s_waitcnt vmcnt(0)" ::: "memory");
        __syncthreads();
    }
}
__device__ __forceinline__ void clearO(f32x4 (&O)[2][4], float (&m)[2], float (&l)[2], float m0) {
#pragma unroll
    for (int a = 0; a < 2; ++a) { m[a] = m0; l[a] = 0.f;
#pragma unroll
        for (int mt = 0; mt < 4; ++mt) O[a][mt] = (f32x4){0.f, 0.f, 0.f, 0.f}; }
}

__device__ __forceinline__ void store_orow(bf16_t* obase, int q, const u32x2 (&w)[4]) {
#pragma unroll
    for (int p = 0; p < 2; ++p) { u32x2 a = w[2 * p], b = w[2 * p + 1];
        const auto r0 = __builtin_amdgcn_permlane16_swap(a.x, b.x, false, false); a.x = r0[0]; b.x = r0[1];
        const auto r1 = __builtin_amdgcn_permlane16_swap(a.y, b.y, false, false); a.y = r1[0]; b.y = r1[1];
        u32x4 v; v.x = a.x; v.y = a.y; v.z = b.x; v.w = b.y;
        *(u32x4*)(obase + 16 * (2 * p + (q & 1)) + 8 * (q >> 1)) = v; }
}
__device__ __forceinline__ void unit(LAS unsigned char* lds, int tid, int lane, int wave, const bf16_t* qkvg, const bf16_t* kcmp, const bf16_t* vcmp, const float* sinks, bf16_t* oab, int b, int g, int cur) {
    Ctx c; c.lds = lds; c.tid = tid; c.lane = lane; c.wave = wave; c.qkv_b = qkvg + (size_t)b * S * QP; c.kc = kcmp + (size_t)b * 512 * 128 + g * 64; c.vc = vcmp + (size_t)b * 512 * 128 + g * 64; c.cur = cur; c.g = g;
    const int q = lane >> 4, cc = lane & 15, hr = cc & 3, hA = g * 4 + hr;
    const int t0 = 64 * cur;
    LAS unsigned* selm = (LAS unsigned*)(lds + L_SELM); LAS unsigned* uwp = (LAS unsigned*)(lds + L_UW); LAS unsigned char* jl = lds + L_JL;
    LAS float* impL = (LAS float*)(lds + L_IMP);
    bf16x8 Qf[2][2];
    f32x4 O[2][4]; float m[2], l[2], invl[2] = {1.f, 1.f};
    LAS u32x2* stash = (LAS u32x2*)(lds + L_IMP) + wave * 512 + lane;
#pragma unroll
    for (int a = 0; a < 2; ++a) { const bf16_t* qrow = c.qkv_b + (size_t)(t0 + 8 * wave + 4 * a + (cc >> 2)) * QP;
        Qf[a][0] = *(const bf16x8*)(qrow + C_QA + hA * 64 + 8 * q); Qf[a][1] = *(const bf16x8*)(qrow + C_QA + hA * 64 + 32 + 8 * q); }
    { const u32x4 z = {0u, 0u, 0u, 0u};
#pragma unroll
      for (int i = 0; i < 4; ++i) *(LAS u32x4*)(lds + L_IMP + (i * 512 + tid) * 16) = z; }
    const int nbc = (4 * cur + 3 + 63) >> 6;
    clearO(O, m, l, -INFINITY);
    const int nstc = (nbc + NB - 1) / NB;
    branch<MODE_C1>(c, Qf, O, m, l, invl, nbc, 0, hA, 0, [&](int p) {
#pragma unroll
        for (int bi = 0; bi < NB; ++bi) if (bi < nbc) blk_dma<MODE_C2>(c, bi, p * NB + bi); });
#pragma unroll
    for (int a = 0; a < 2; ++a) invl[a] = 1.0f / fmaxf(col_sum4(l[a]), 1e-30f);
    branch<MODE_C2, true>(c, Qf, O, m, l, invl, nbc, 0, hA, nstc & 1);
    {
        unsigned long long un_lo[2] = {0ull, 0ull}, un_hi[2] = {0ull, 0ull};
        for (int i = 0; i < 8; ++i) {
            const int tok = 8 * wave + i;
            unsigned long long mlo, mhi = 0ull;
            if (cur <= 7) mlo = (2ull << cur) - 1ull;
            else {
                mlo = 1ull;
                if (cur - 1 < 64) mlo |= 1ull << (cur - 1); else mhi |= 1ull << (cur - 65);
                if (cur < 64) mlo |= 1ull << cur; else mhi |= 1ull << (cur - 64);
                const bool ok0 = lane >= 1 && lane <= cur - 2, ok1 = lane + 64 <= cur - 2;
                const unsigned k0 = ok0 ? __builtin_bit_cast(unsigned, impL[tok * 128 + lane]) + 1u : 0u;
                const unsigned k1 = ok1 ? __builtin_bit_cast(unsigned, impL[tok * 128 + 64 + lane]) + 1u : 0u;
                unsigned T = 0u;
                for (int bit = 31; bit >= 0; --bit) { const unsigned cand = T | (1u << bit);
                    const int cnt = __popcll(__ballot(k0 >= cand)) + __popcll(__ballot(k1 >= cand));
                    if (cnt >= 5) T = cand; }
                const unsigned long long G0 = __ballot(k0 > T), G1 = __ballot(k1 > T);
                unsigned long long E0 = __ballot(k0 == T), E1 = __ballot(k1 == T), S0 = 0ull, S1 = 0ull;
                int need = 5 - (__popcll(G0) + __popcll(G1));
                while (need > 0 && E0) { const unsigned long long b_ = E0 & (0ull - E0); S0 |= b_; E0 ^= b_; --need; }
                while (need > 0 && E1) { const unsigned long long b_ = E1 & (0ull - E1); S1 |= b_; E1 ^= b_; --need; }
                mlo |= G0 | S0; mhi |= G1 | S1;
            }
            if (lane == 0) { selm[tok * 4 + 0] = (unsigned)mlo; selm[tok * 4 + 1] = (unsigned)(mlo >> 32); selm[tok * 4 + 2] = (unsigned)mhi; selm[tok * 4 + 3] = (unsigned)(mhi >> 32); }
            un_lo[i >> 2] |= mlo; un_hi[i >> 2] |= mhi;
        }
        if (lane == 0) {
#pragma unroll
            for (int a = 0; a < 2; ++a) { LAS unsigned* up = selm + 256 + (2 * wave + a) * 4; up[0] = (unsigned)un_lo[a]; up[1] = (unsigned)(un_lo[a] >> 32); up[2] = (unsigned)un_hi[a]; up[3] = (unsigned)(un_hi[a] >> 32); }
        }
    }
    __syncthreads();
    if (wave == 0) {
        unsigned long long ulo = 0ull, uhi = 0ull;
#pragma unroll
        for (int k = 0; k < 16; ++k) { ulo |= (unsigned long long)selm[256 + 4 * k] | ((unsigned long long)selm[256 + 4 * k + 1] << 32); uhi |= (unsigned long long)selm[256 + 4 * k + 2] | ((unsigned long long)selm[256 + 4 * k + 3] << 32); }
        const unsigned long long below = (1ull << lane) - 1ull;
        const int nlo = __popcll(ulo);
        if ((ulo >> lane) & 1ull) jl[__popcll(ulo & below)] = (unsigned char)lane;
        if ((uhi >> lane) & 1ull) jl[nlo + __popcll(uhi & below)] = (unsigned char)(64 + lane);
        if (lane == 0) uwp[4] = (unsigned)(nlo + __popcll(uhi));
    }
    __syncthreads();
    const int nsel = __builtin_amdgcn_readfirstlane((int)uwp[4]);
#pragma unroll
    for (int a = 0; a < 2; ++a) { const float sc = 1.0f / (1.0f + ex2(-LOG2E * bf2f(c.qkv_b[(size_t)(t0 + 8 * wave + 4 * a + (cc >> 2)) * QP + C_GA + hA * 3 + 0])));
#pragma unroll
        for (int mt = 0; mt < 4; ++mt) { const f32x4 o = O[a][mt] * sc; u32x2 w; w.x = cvt_pk_bf16(o[0], o[1]); w.y = cvt_pk_bf16(o[2], o[3]); stash[(a * 4 + mt) * 64] = w; } }
    clearO(O, m, l, -INFINITY);
    const int jw0 = cur >= 8 ? cur - 8 : 0, nwin = cur - jw0 + 1, jb0 = cur >= 2 ? cur - 2 : 0, nswa = cur - jb0 + 1;
    const int pwin = ((nsel + NB - 1) / NB) & 1, pswa = (pwin + (nwin + NB - 1) / NB) & 1;
    branch<MODE_SEL>(c, Qf, O, m, l, invl, nsel, 0, hA, 0, [&](int p) {
#pragma unroll
        for (int bi = 0; bi < NB; ++bi) if (bi < nwin) blk_dma<MODE_WIN>(c, jw0 + bi, p * NB + bi); });
#pragma unroll
    for (int a = 0; a < 2; ++a) { const float sc = (1.0f / (1.0f + ex2(-LOG2E * bf2f(c.qkv_b[(size_t)(t0 + 8 * wave + 4 * a + (cc >> 2)) * QP + C_GA + hA * 3 + 1])))) / fmaxf(col_sum4(l[a]), 1e-30f);
#pragma unroll
        for (int mt = 0; mt < 4; ++mt) { const u32x2 pv = stash[(a * 4 + mt) * 64]; f32x4 o = O[a][mt] * sc;
            o[0] += __builtin_bit_cast(float, pv.x << 16); o[1] += __builtin_bit_cast(float, pv.x & 0xffff0000u); o[2] += __builtin_bit_cast(float, pv.y << 16); o[3] += __builtin_bit_cast(float, pv.y & 0xffff0000u);
            u32x2 w; w.x = cvt_pk_bf16(o[0], o[1]); w.y = cvt_pk_bf16(o[2], o[3]); stash[(a * 4 + mt) * 64] = w; } }
    clearO(O, m, l, -INFINITY);
    branch<MODE_WIN, true>(c, Qf, O, m, l, invl, nwin, jw0, hA, pwin, [&](int p) {
#pragma unroll
        for (int bi = 0; bi < NB; ++bi) if (bi < nswa) blk_dma<MODE_SWA>(c, jb0 + bi, p * NB + bi); });
#pragma unroll
    for (int a = 0; a < 2; ++a) { const float sc = (1.0f / (1.0f + ex2(-LOG2E * bf2f(c.qkv_b[(size_t)(t0 + 8 * wave + 4 * a + (cc >> 2)) * QP + C_GA + hA * 3 + 2])))) / fmaxf(col_sum4(l[a]), 1e-30f);
        bf16_t* orow = oab + (size_t)(b * S + t0 + 8 * wave + 4 * a + (cc >> 2)) * D + hA * 64;
        u32x2 w[4];
#pragma unroll
        for (int mt = 0; mt < 4; ++mt) { const u32x2 pv = stash[(a * 4 + mt) * 64]; f32x4 o = O[a][mt] * sc;
            o[0] += __builtin_bit_cast(float, pv.x << 16); o[1] += __builtin_bit_cast(float, pv.x & 0xffff0000u); o[2] += __builtin_bit_cast(float, pv.y << 16); o[3] += __builtin_bit_cast(float, pv.y & 0xffff0000u);
            w[mt].x = cvt_pk_bf16(o[0], o[1]); w[mt].y = cvt_pk_bf16(o[2], o[3]); }
        store_orow(orow, q, w); }
    const float sk2 = sinks[hA] * LOG2E;
#pragma unroll
    for (int a = 0; a < 2; ++a) { const bf16_t* qrow = c.qkv_b + (size_t)(t0 + 8 * wave + 4 * a + (cc >> 2)) * QP;
        Qf[a][0] = *(const bf16x8*)(qrow + C_QB + hA * 64 + 8 * q); Qf[a][1] = *(const bf16x8*)(qrow + C_QB + hA * 64 + 32 + 8 * q); }
    clearO(O, m, l, sk2);
    branch<MODE_SWA, true>(c, Qf, O, m, l, invl, nswa, jb0, 8 + hA, pswa);
#pragma unroll
    for (int a = 0; a < 2; ++a) { const float sc = 1.0f / (col_sum4(l[a]) + ex2(sk2 - m[a]));
        bf16_t* orow = oab + (size_t)(b * S + t0 + 8 * wave + 4 * a + (cc >> 2)) * D + 512 + hA * 64;
        u32x2 w[4];
#pragma unroll
        for (int mt = 0; mt < 4; ++mt) { const f32x4 o = O[a][mt] * sc; w[mt].x = cvt_pk_bf16(o[0], o[1]); w[mt].y = cvt_pk_bf16(o[2], o[3]); }
        store_orow(orow, q, w); }
}

constexpr int CMP_PITCH = 144, CMP_NCH = 272 * 8;
__device__ __forceinline__ void compress_load(const bf16_t* qkvg, int u, int tid, u32x4 (&r)[5]) {
    const int nt = u & 31, g = (u >> 5) & 1, b = (u >> 6) & 7, which = u >> 9;
    const bf16_t* base = qkvg + (size_t)(b * S) * QP + (which ? C_VC : C_KC) + g * 64;
#pragma unroll
    for (int i = 0; i < 5; ++i) { int c = tid + 512 * i; c = c < CMP_NCH ? c : CMP_NCH - 1; int tok = 256 * nt + (c >> 3); tok = tok < S ? tok : S - 1;
        r[i] = *(const u32x4*)(base + (size_t)tok * QP + (c & 7) * 8); }
}
__device__ __forceinline__ void compress_stage(LAS unsigned char* lds, int tid, const u32x4 (&r)[5]) {
#pragma unroll
    for (int i = 0; i < 5; ++i) { const int c = tid + 512 * i; const int tr = c >> 3;
        if (c < CMP_NCH) *(LAS u32x4*)(lds + L_KV + ((tr & 15) * 17 + (tr >> 4)) * CMP_PITCH + (c & 7) * 16) = r[i]; }
}
__device__ __forceinline__ void compress_unit(LAS unsigned char* lds, int lane, int wave, const bf16_t* W1T, const bf16_t* W2T, const float* c1, bf16_t* kcmp, bf16_t* vcmp, int u) {
    const int nt = u & 31, g = (u >> 5) & 1, b = (u >> 6) & 7, which = u >> 9, n0 = 16 * nt;
    const int mrow = lane & 15, q = lane >> 4;
    const int n = n0 + mrow, mcl = n > 510 ? mrow - 1 : mrow;
    const LAS unsigned char* arow = lds + L_KV + mcl * CMP_PITCH + 16 * q;
    const bf16_t* brow = W1T + ((size_t)which * 128 + 16 * wave + mrow) * 2048 + 8 * q;
    f32x4 acc = {0.f, 0.f, 0.f, 0.f};
#pragma unroll 16
    for (int ks = 0; ks < 64; ++ks) {
        const bf16x8 a = *(const LAS bf16x8*)(arow + (((ks >> 1) & 15) * 17 + (ks >> 5)) * CMP_PITCH + 64 * (ks & 1));
        const bf16x8 w = *(const bf16x8*)(brow + 32 * ks);
        acc = __builtin_amdgcn_mfma_f32_16x16x32_bf16(w, a, acc, 0, 0, 0);
    }
    LAS bf16_t* hid = (LAS bf16_t*)(lds + L_HID);
    { const f32x4 cb = *(const f32x4*)(c1 + which * 128 + 16 * wave + 4 * q); float hv[4];
#pragma unroll
      for (int r = 0; r < 4; ++r) { const float xx = acc[r] + cb[r]; const float y = 0.7978845608028654f * (xx + 0.044715f * xx * xx * xx);
          const float th = 1.0f - 2.0f / (1.0f + ex2(2.0f * LOG2E * y)); hv[r] = 0.5f * xx * (1.0f + th); }
      u32x2 w; w.x = cvt_pk_bf16(hv[0], hv[1]); w.y = cvt_pk_bf16(hv[2], hv[3]);
      *(LAS u32x2*)(hid + mrow * 136 + 16 * wave + 4 * q) = w; }
    __syncthreads();
    if (wave < 4) {
        f32x4 acc2 = {0.f, 0.f, 0.f, 0.f};
        const bf16_t* w2row = W2T + ((size_t)which * 64 + 16 * wave + mrow) * 128 + 8 * q;
#pragma unroll
        for (int ks = 0; ks < 4; ++ks) {
            const bf16x8 hfr = *(const LAS bf16x8*)(hid + mrow * 136 + 32 * ks + 8 * q);
            const bf16x8 w = *(const bf16x8*)(w2row + 32 * ks);
            acc2 = __builtin_amdgcn_mfma_f32_16x16x32_bf16(w, hfr, acc2, 0, 0, 0);
        }
        u32x2 w; w.x = cvt_pk_bf16(acc2[0], acc2[1]); w.y = cvt_pk_bf16(acc2[2], acc2[3]);
        if (n > 510) { w.x = 0u; w.y = 0u; }
        *(u32x2*)((which ? vcmp : kcmp) + ((size_t)(b * 512 + n) * 2 + g) * 64 + 16 * wave + 4 * q) = w;
    }
    __syncthreads();
}
constexpr int CMP_R1 = 40960, L_HID2 = L_END;
__device__ __forceinline__ void compress_stage1(LAS unsigned char* lds, int tid, const u32x4 (&r)[5]) {
#pragma unroll
    for (int i = 0; i < 5; ++i) { const int c = tid + 512 * i; const int tr = c >> 3;
        if (c < CMP_NCH) *(LAS u32x4*)(lds + L_KV + CMP_R1 + ((tr & 15) * 17 + (tr >> 4)) * CMP_PITCH + (c & 7) * 16) = r[i]; }
}
__device__ __forceinline__ void compress_unit2(LAS unsigned char* lds, int lane, int wave, const bf16_t* W1T, const bf16_t* W2T, const float* c1, bf16_t* kcmp, bf16_t* vcmp, int u) {
    const int nt = u & 31, g = (u >> 5) & 1, b = (u >> 6) & 7, which = u >> 9, n0 = 16 * nt;
    const int mrow = lane & 15, q = lane >> 4;
    const int n = n0 + mrow, mcl = n > 510 ? mrow - 1 : mrow;
    const LAS unsigned char* arow = lds + L_KV + mcl * CMP_PITCH + 16 * q;
    const bf16_t* brow = W1T + ((size_t)which * 128 + 16 * wave + mrow) * 2048 + 8 * q;
    f32x4 acc0 = {0.f, 0.f, 0.f, 0.f}, acc1 = {0.f, 0.f, 0.f, 0.f};
#pragma unroll 16
    for (int ks = 0; ks < 64; ++ks) {
        const int ao = (((ks >> 1) & 15) * 17 + (ks >> 5)) * CMP_PITCH + 64 * (ks & 1);
        const bf16x8 a0 = *(const LAS bf16x8*)(arow + ao), a1 = *(const LAS bf16x8*)(arow + CMP_R1 + ao);
        const bf16x8 w = *(const bf16x8*)(brow + 32 * ks);
        acc0 = __builtin_amdgcn_mfma_f32_16x16x32_bf16(w, a0, acc0, 0, 0, 0);
        acc1 = __builtin_amdgcn_mfma_f32_16x16x32_bf16(w, a1, acc1, 0, 0, 0);
    }
    { const f32x4 cb = *(const f32x4*)(c1 + which * 128 + 16 * wave + 4 * q);
#pragma unroll
      for (int h = 0; h < 2; ++h) { float hv[4];
#pragma unroll
          for (int r = 0; r < 4; ++r) { const float xx = (h ? acc1[r] : acc0[r]) + cb[r]; const float y = 0.7978845608028654f * (xx + 0.044715f * xx * xx * xx);
              const float th = 1.0f - 2.0f / (1.0f + ex2(2.0f * LOG2E * y)); hv[r] = 0.5f * xx * (1.0f + th); }
          u32x2 w; w.x = cvt_pk_bf16(hv[0], hv[1]); w.y = cvt_pk_bf16(hv[2], hv[3]);
          *(LAS u32x2*)((LAS bf16_t*)(lds + (h ? L_HID2 : L_HID)) + mrow * 136 + 16 * wave + 4 * q) = w; } }
    __syncthreads();
    {   const int h = wave >> 2, w4 = wave & 3;
        const LAS bf16_t* hid = (const LAS bf16_t*)(lds + (h ? L_HID2 : L_HID));
        f32x4 acc2 = {0.f, 0.f, 0.f, 0.f};
        const bf16_t* w2row = W2T + ((size_t)which * 64 + 16 * w4 + mrow) * 128 + 8 * q;
#pragma unroll
        for (int ks = 0; ks < 4; ++ks) {
            const bf16x8 hfr = *(const LAS bf16x8*)(hid + mrow * 136 + 32 * ks + 8 * q);
            const bf16x8 w = *(const bf16x8*)(w2row + 32 * ks);
            acc2 = __builtin_amdgcn_mfma_f32_16x16x32_bf16(w, hfr, acc2, 0, 0, 0);
        }
        u32x2 w; w.x = cvt_pk_bf16(acc2[0], acc2[1]); w.y = cvt_pk_bf16(acc2[2], acc2[3]);
        if (n > 510) { w.x = 0u; w.y = 0u; }
        *(u32x2*)((which ? vcmp : kcmp) + ((size_t)((b + 4 * h) * 512 + n) * 2 + g) * 64 + 16 * w4 + 4 * q) = w;
    }
    __syncthreads();
}
}

struct __attribute__((packed, aligned(4))) Rec3 { unsigned x, y, z; };
struct MoeCtx { LAS unsigned char* lds; unsigned char* ws; float* out; const float* ln2g; const float* ln2b; int G, gw, NGW, tid, lane; };
__device__ __forceinline__ MoeTables moe_tb(LAS unsigned char* lds) { MoeTables tb; tb.tn = (LAS int*)(lds + RING_BYTES + 1024); tb.es = tb.tn + 260; tb.us = tb.es + 260; return tb; }
__device__ __forceinline__ void moe_prefix(const unsigned* cnt, LAS int* tn, LAS int* es, LAS int* us, int tid) {
    __syncthreads();
    if (tid < 64) { const int lane = tid; int n[4], tt[4], sa = 0, sb = 0;
#pragma unroll
        for (int j = 0; j < 4; ++j) { n[j] = (int)cnt[4 * lane + j]; tt[j] = (n[j] + 255) >> 8; sa += n[j]; sb += tt[j]; }
        int ia = sa, ib = sb;
#pragma unroll
        for (int o = 1; o < 64; o <<= 1) { const int xa = __shfl_up(ia, o), xb = __shfl_up(ib, o); if (lane >= o) { ia += xa; ib += xb; } }
        int ea = ia - sa, eb = ib - sb;
#pragma unroll
        for (int j = 0; j < 4; ++j) { es[4 * lane + j] = ea; if (us) us[4 * lane + j] = eb; if (tn) tn[4 * lane + j] = n[j]; ea += n[j]; eb += tt[j]; }
        if (lane == 63) { es[256] = ea; es[257] = ea + CHT; if (us) { us[256] = eb; us[257] = eb + CHT / 256; } if (tn) tn[256] = CHT; } }
    __syncthreads();
}
__device__ __forceinline__ LAS int* moe_esc(LAS unsigned char* lds) { return (LAS int*)(lds + RING_BYTES + 13056); }
template <int C> __device__ __forceinline__ void moe_combine(const MoeCtx& mc) {
    LAS int* es = moe_esc(mc.lds);
    const unsigned* eidx = (const unsigned*)(mc.ws + WS_EIDX); const float* gatev = (const float*)(mc.ws + WS_GATE); const unsigned* posv = (const unsigned*)(mc.ws + WS_POS);
    const unsigned char* y8 = mc.ws + WS_Y; const bf16_t* ys = (const bf16_t*)(mc.ws + WS_YS);
    const int lane = mc.lane;
    f32x4 g2v[4], b2v[4];
#pragma unroll
    for (int j = 0; j < 4; ++j) { g2v[j] = *(const f32x4*)(mc.ln2g + 16 * lane + 4 * j); b2v[j] = *(const f32x4*)(mc.ln2b + 16 * lane + 4 * j); }
    for (int tl = mc.gw; tl < CHT; tl += 2 * mc.NGW) {
        const int tl2 = tl + mc.NGW; const bool two = tl2 < CHT;
        const int tA = C * CHT + tl, tB = C * CHT + (two ? tl2 : tl);
        u32x4 ra[10], rb[10]; float ga[8], gb[8];
        { const size_t ie = (size_t)((lane & 8) ? tB : tA) * TOPK + (lane & 7);
          const Rec3 rec = *(const Rec3*)(eidx + 3 * ie);
          const unsigned rowv = (unsigned)es[rec.x] + rec.y; const float gvv = __builtin_bit_cast(float, rec.z) * 0.0625f;
#pragma unroll
          for (int k = 0; k < 8; ++k) {
              const unsigned rowA = (unsigned)__builtin_amdgcn_readlane((int)rowv, k), rowB = (unsigned)__builtin_amdgcn_readlane((int)rowv, 8 + k);
              ga[k] = __builtin_bit_cast(float, __builtin_amdgcn_readlane(__builtin_bit_cast(int, gvv), k)); gb[k] = __builtin_bit_cast(float, __builtin_amdgcn_readlane(__builtin_bit_cast(int, gvv), 8 + k));
              ra[k] = *(const u32x4*)(y8 + (size_t)rowA * D + 16 * lane); rb[k] = *(const u32x4*)(y8 + (size_t)rowB * D + 16 * lane); } }
        { const bf16_t* pa = ys + (size_t)tl * D + 16 * lane; const bf16_t* pb = ys + (size_t)(two ? tl2 : tl) * D + 16 * lane;
          ra[8] = *(const u32x4*)pa; ra[9] = *(const u32x4*)(pa + 8); rb[8] = *(const u32x4*)pb; rb[9] = *(const u32x4*)(pb + 8); }
#pragma unroll
        for (int h = 0; h < 2; ++h) {
            if (h == 1 && !two) break;
            float v[16];
            { const u32x4 a = h ? rb[8] : ra[8], b = h ? rb[9] : ra[9];
#pragma unroll
              for (int j = 0; j < 4; ++j) { v[2 * j] = __builtin_bit_cast(float, a[j] << 16); v[2 * j + 1] = __builtin_bit_cast(float, a[j] & 0xffff0000u);
                  v[8 + 2 * j] = __builtin_bit_cast(float, b[j] << 16); v[8 + 2 * j + 1] = __builtin_bit_cast(float, b[j] & 0xffff0000u); } }
#pragma unroll
            for (int k = 0; k < 8; ++k) { const float gk = h ? gb[k] : ga[k]; const u32x4 a = h ? rb[k] : ra[k];
#pragma unroll
                for (int j = 0; j < 4; ++j) { const f32x2 lo = __builtin_amdgcn_cvt_pk_f32_fp8((int)a[j], false), hi = __builtin_amdgcn_cvt_pk_f32_fp8((int)a[j], true);
                    v[4 * j] += gk * lo.x; v[4 * j + 1] += gk * lo.y; v[4 * j + 2] += gk * hi.x; v[4 * j + 3] += gk * hi.y; } }
            float sm = 0.f;
#pragma unroll
            for (int j = 0; j < 16; ++j) sm += v[j];
            const float mean = wave_sum_x(sm) * (1.f / D); float s2 = 0.f;
#pragma unroll
            for (int j = 0; j < 16; ++j) { v[j] -= mean; s2 += v[j] * v[j]; }
            const float rstd = 1.f / sqrtf(wave_sum_x(s2) * (1.f / D) + LN_EPS);
            float* op = mc.out + (size_t)(h ? tB : tA) * D + 16 * lane;
#pragma unroll
            for (int j = 0; j < 4; ++j) { const f32x4 gg = g2v[j], bb = b2v[j];
                f32x4 o; o.x = v[4 * j] * rstd * gg.x + bb.x; o.y = v[4 * j + 1] * rstd * gg.y + bb.y; o.z = v[4 * j + 2] * rstd * gg.z + bb.z; o.w = v[4 * j + 3] * rstd * gg.w + bb.w;
                *(f32x4*)(op + 4 * j) = o; }
        }
    }
}
template <int C> __device__ __forceinline__ void moe_gu(const MoeCtx& mc) {
    const MoeTables tb = moe_tb(mc.lds);
    const unsigned* cntw = (const unsigned*)(mc.ws + WS_CTL) + CW_CNT;
    bf16_t* h1b = (bf16_t*)((unsigned char*)mc.out + DO_H1B); bf16_t* Wgu = (bf16_t*)(mc.ws + WS_WGU); bf16_t* hb = (bf16_t*)(mc.ws + WS_HB);
    const unsigned short* elist = (const unsigned short*)(mc.ws + WS_LIST);
    moe_prefix(cntw + C * 256, tb.tn, tb.es, tb.us, mc.tid);
    MoeUnits mu; mu.rec = (LAS int*)(mc.lds + RING_BYTES + 4352); mu.cnt = mu.rec + 96; mu.tok = (LAS unsigned short*)(mc.lds + RING_BYTES + 4864);
    moe_units<2, true>(tb, mu, mc.G, (int)blockIdx.x, mc.tid, elist, C);
    { MoeOrder<2> S; S.tb = tb; S.mu = mu; S.Abase = (const char*)h1b; S.apitch = 0; S.Bbase = (const char*)Wgu; S.strideE = (size_t)512 * D * 2; S.stridePN = (size_t)256 * D * 2;
      S.chunk = C; S.colw = 128;
      EpiGLU E{hb};
      pg8::gemm_phase<EpiGLU, MoeOrder<2>, true, true, false, 8>(mc.lds, D, S, E); }
}
template <int C> __device__ __forceinline__ void moe_d(const MoeCtx& mc) {
    const MoeTables tb = moe_tb(mc.lds);
    bf16_t* h1b = (bf16_t*)((unsigned char*)mc.out + DO_H1B); bf16_t* Wd = (bf16_t*)(mc.ws + WS_WD); bf16_t* hb = (bf16_t*)(mc.ws + WS_HB);
    const unsigned short* elist = (const unsigned short*)(mc.ws + WS_LIST);
    MoeUnits mu; mu.rec = (LAS int*)(mc.lds + RING_BYTES + 4352); mu.cnt = mu.rec + 96; mu.tok = (LAS unsigned short*)(mc.lds + RING_BYTES + 4864);
    moe_units<4, false>(tb, mu, mc.G, (int)blockIdx.x, mc.tid, elist, C);
    { MoeOrder<4> S; S.tb = tb; S.mu = mu; S.Abase = (const char*)hb; S.apitch = (size_t)EH * 2; S.Bbase = (const char*)Wd; S.strideE = (size_t)D * EH * 2; S.stridePN = (size_t)256 * EH * 2;
      S.chunk = C; S.colw = 256;
      EpiDown E{mc.ws + WS_Y, (bf16_t*)(mc.ws + WS_YS), h1b, C};
      int kk = EH; asm volatile("" : "+s"(kk));
      pg8::gemm_phase<EpiDown, MoeOrder<4>, true, false, false, 8>(mc.lds, kk, S, E); }
}
template <int C> __device__ __forceinline__ void moe_cgu(const MoeCtx& mc) {
    const unsigned* cntw = (const unsigned*)(mc.ws + WS_CTL) + CW_CNT;
    moe_prefix(cntw + C * 256, nullptr, moe_esc(mc.lds), nullptr, mc.tid);
    const bool first = (((int)blockIdx.x >> 3) & 1) == 0;
    if (first) moe_combine<C>(mc);
    moe_gu<C + 1>(mc);
    if (!first) moe_combine<C>(mc);
}

struct MegaArgs { const float* in[23]; float* out; unsigned char* ws; unsigned phases; unsigned li; };

__device__ __forceinline__ int colmap_win(int c) {
    if (c < 1280) return c;
    if (c < 1792) return O_QB + (c - 1280);
    if (c < 2048) return O_KB + (c - 1792);
    if (c < 2072) return O_GA + (c - 2048);
    if (c < 2304) return -1;
    if (c < 3328) return O_GATEA + (c - 2304);
    return O_GATEB + (c - 3328);
}
template <class CMap> __device__ __forceinline__ void transpose_item(const float* W, int K, int Nsrc, bf16_t* WT, int nblk, LAS unsigned char* scr, int item, int lane, CMap cmap, int ldo = 0, int koff = 0) {
    if (ldo == 0) ldo = K;
    const int kb = item / nblk, nb = item % nblk, k0 = 64 * kb, n0 = 64 * nb;
    const int sc = cmap(n0 + 4 * (lane & 15));
    const float* src = W + (size_t)(k0 + (lane >> 4)) * Nsrc + (sc >= 0 ? sc : 0);
#pragma unroll 8
    for (int i = 0; i < 16; ++i) { f32x4 v = {0.f, 0.f, 0.f, 0.f}; if (sc >= 0) v = __builtin_nontemporal_load((const f32x4*)(src + (size_t)(4 * i) * Nsrc));
        u32x2 w; w.x = pk2(v.x, v.y); w.y = pk2(v.z, v.w);
        *(LAS u32x2*)(scr + (4 * i + (lane >> 4)) * 144 + (lane & 15) * 8) = w; }
    asm volatile("s_waitcnt lgkmcnt(0)" ::: "memory");
    const int q = lane >> 4, cc = lane & 15;
#pragma unroll
    for (int it = 0; it < 8; ++it) { const int ng = it >> 1, kc = 4 * (it & 1) + q;
        const LAS unsigned char* p = scr + (8 * kc + (cc >> 2)) * 144 + (16 * ng + 4 * (cc & 3)) * 2;
        const v4i16_t lo = __builtin_amdgcn_ds_read_tr16_b64_v4i16((LAS v4i16_t*)p);
        const v4i16_t hi = __builtin_amdgcn_ds_read_tr16_b64_v4i16((LAS v4i16_t*)(p + 4 * 144));
        const bf16x8 o = {lo[0], lo[1], lo[2], lo[3], hi[0], hi[1], hi[2], hi[3]};
        *(bf16x8*)(WT + (size_t)(n0 + 16 * ng + cc) * ldo + koff + k0 + 8 * kc) = o; }
    asm volatile("s_waitcnt lgkmcnt(0)" ::: "memory");
}

__device__ __forceinline__ void route_select(const float (&lg)[4], const float (&rb)[4], int lane, unsigned long long (&Sm)[4], float (&sc)[4], float& gsum) {
            float ch[4];
#pragma unroll
            for (int i = 0; i < 4; ++i) { sc[i] = 1.0f / (1.0f + expf(-lg[i])); ch[i] = sc[i] + rb[i]; }
            float gs[8];
#pragma unroll
            for (int i = 0; i < 4; ++i) {
                float m1 = ch[i]; int a1 = lane;
#pragma unroll
                for (int o = 16; o > 0; o >>= 1) { const float om = __shfl_xor(m1, o); const int oa_ = __shfl_xor(a1, o); if (om > m1 || (om == m1 && oa_ < a1)) { m1 = om; a1 = oa_; } }
                float m2 = (lane == a1) ? -INFINITY : ch[i];
#pragma unroll
                for (int o = 16; o > 0; o >>= 1) m2 = fmaxf(m2, __shfl_xor(m2, o));
                const float s2 = m1 + m2;
                gs[2 * i] = __shfl(s2, 0); gs[2 * i + 1] = __shfl(s2, 32);
            }
            float cm[4];
#pragma unroll
            for (int i = 0; i < 4; ++i) { int r0 = 0, r1 = 0;
#pragma unroll
                for (int b = 0; b < 8; ++b) { r0 += (gs[b] > gs[2 * i] || (gs[b] == gs[2 * i] && b < 2 * i)) ? 1 : 0; r1 += (gs[b] > gs[2 * i + 1] || (gs[b] == gs[2 * i + 1] && b < 2 * i + 1)) ? 1 : 0; }
                const bool k = (lane < 32) ? (r0 < 4) : (r1 < 4); cm[i] = k ? ch[i] : -INFINITY; }
            unsigned key[4];
#pragma unroll
            for (int i = 0; i < 4; ++i) { const unsigned b_ = __builtin_bit_cast(unsigned, cm[i]); key[i] = (cm[i] == -INFINITY) ? 0u : (b_ ^ ((b_ >> 31) ? 0xFFFFFFFFu : 0x80000000u)); }
            unsigned Tk = 0u;
            for (int bit = 31; bit >= 0; --bit) { const unsigned cand = Tk | (1u << bit);
                const int cnt = __popcll(__ballot(key[0] >= cand)) + __popcll(__ballot(key[1] >= cand)) + __popcll(__ballot(key[2] >= cand)) + __popcll(__ballot(key[3] >= cand));
                if (cnt >= TOPK) Tk = cand; }
            int need = TOPK;
#pragma unroll
            for (int i = 0; i < 4; ++i) { Sm[i] = __ballot(key[i] > Tk); need -= __popcll(Sm[i]); }
#pragma unroll
            for (int i = 0; i < 4; ++i) { unsigned long long E_ = __ballot(key[i] == Tk);
                while (need > 0 && E_) { const unsigned long long b_ = E_ & (0ull - E_); Sm[i] |= b_; E_ ^= b_; --need; } }
            float gpart = 0.f;
#pragma unroll
            for (int i = 0; i < 4; ++i) gpart += ((Sm[i] >> lane) & 1ull) ? sc[i] : 0.f;
            gsum = wave_sum_x(gpart);
}
__device__ __forceinline__ void route_commit(int t, int lane, const unsigned long long (&Sm)[4], const float (&gv)[4], const unsigned (&p)[4], unsigned* eidx, float* gatev, unsigned* posv, unsigned short* elist) {
            const unsigned long long below = (1ull << lane) - 1ull;
            const int c = t / CHT;
            int base_ = 0;
#pragma unroll
            for (int i = 0; i < 4; ++i) {
                if ((Sm[i] >> lane) & 1ull) {
                    const int slot = base_ + __popcll(Sm[i] & below), e = lane + 64 * i;
                    { Rec3 rec; rec.x = (unsigned)e; rec.y = p[i]; rec.z = __builtin_bit_cast(unsigned, gv[i]);
                      *(Rec3*)(eidx + 3 * ((size_t)t * TOPK + slot)) = rec; }
                    elist[((size_t)c * 256 + e) * CHT + p[i]] = (unsigned short)(t - c * CHT);
                }
                base_ += __popcll(Sm[i]);
            }
}
struct PanelOrder { const char* A; const char* Bt; int K, row0;
    __device__ __forceinline__ bool next(int i, pg8::Unit& u) const { if (i >= 4) return false;
        u.A = A + (size_t)row0 * K * 2; u.B = Bt + (size_t)i * pg8::BM * K * 2; u.row0 = row0; u.col0 = i * pg8::BM; u.nrows = pg8::BM; u.aux = i; u.e = 0; u.ti = 0; u.ord = 0; return true; }
    __device__ __forceinline__ unsigned arow_off(const pg8::Unit&, int) const { return 0u; } };
constexpr int I_GU = (D / 64) * (512 / 64), I_D = (EH / 64) * (D / 64), I_E = I_GU + I_D, I_EXP = 257 * I_E;
__device__ __forceinline__ void expert_load(const float* const* in, int it, int lane, f32x4 (&v)[16]) {
    it = it < I_EXP ? it : I_EXP - 1;
    const int e = it / I_E; int r = it % I_E;
    const float* src; int Nsrc, kb, sc;
    if (r < I_GU) { const int nb = r % 8, bj = (nb >> 1) & 1, pnn = nb >> 2; kb = r / 8;
        src = (e < 256) ? ((bj ? in[16] : in[15]) + (size_t)e * D * EH) : (bj ? in[19] : in[18]); Nsrc = EH; sc = pnn * 128 + 64 * (nb & 1);
    } else { r -= I_GU; src = (e < 256) ? (in[17] + (size_t)e * EH * D) : in[20]; Nsrc = D; kb = r / (D / 64); sc = 64 * (r % (D / 64)); }
    const char* base = (const char*)(src + (size_t)(64 * kb) * Nsrc + sc);
    const unsigned loff = (unsigned)((lane >> 4) * Nsrc + 4 * (lane & 15)) * 4u;
#pragma unroll
    for (int i = 0; i < 16; ++i) v[i] = __builtin_nontemporal_load((const f32x4*)(base + (size_t)(4 * i) * Nsrc * 4 + loff));
}
__device__ __forceinline__ void expert_finish(bf16_t* Wgu, bf16_t* Wd, LAS unsigned char* scr, int it, int lane, const f32x4 (&v)[16]) {
    if (it >= I_EXP) return;
    const int e = it / I_E; int r = it % I_E;
    bf16_t* WT; int ldo, kb, nb;
    if (r < I_GU) { WT = Wgu + (size_t)e * 512 * D; ldo = D; kb = r / 8; nb = r % 8; }
    else { r -= I_GU; WT = Wd + (size_t)e * D * EH; ldo = EH; kb = r / (D / 64); nb = r % (D / 64); }
#pragma unroll
    for (int i = 0; i < 16; ++i) { u32x2 w; w.x = pk2(v[i].x, v[i].y); w.y = pk2(v[i].z, v[i].w);
        *(LAS u32x2*)(scr + (4 * i + (lane >> 4)) * 144 + (lane & 15) * 8) = w; }
    asm volatile("s_waitcnt lgkmcnt(0)" ::: "memory");
    const int q = lane >> 4, cc = lane & 15;
    char* obase = (char*)(WT + (size_t)(64 * nb) * ldo + 64 * kb);
    const unsigned ooff = (unsigned)(cc * ldo + 8 * q) * 2u;
    const LAS unsigned char* p0 = scr + (8 * q + (cc >> 2)) * 144 + (4 * (cc & 3)) * 2;
#pragma unroll
    for (int x = 0; x < 8; ++x) { const int ng = x >> 1, kh = x & 1;
        const LAS unsigned char* p = p0 + (32 * kh) * 144 + (16 * ng) * 2;
        const v4i16_t lo = __builtin_amdgcn_ds_read_tr16_b64_v4i16((LAS v4i16_t*)p);
        const v4i16_t hi = __builtin_amdgcn_ds_read_tr16_b64_v4i16((LAS v4i16_t*)(p + 4 * 144));
        const bf16x8 o = {lo[0], lo[1], lo[2], lo[3], hi[0], hi[1], hi[2], hi[3]};
        *(bf16x8*)(obase + ((size_t)(16 * ng) * ldo + 32 * kh) * 2 + ooff) = o; }
    asm volatile("s_waitcnt lgkmcnt(0)" ::: "memory");
}
struct OneUnit { pg8::Unit u; __device__ __forceinline__ bool next(int i, pg8::Unit& o) const { if (i) return false; o = u; return true; } __device__ __forceinline__ unsigned arow_off(const pg8::Unit&, int) const { return 0u; } };

__global__ void __launch_bounds__(NWAVES * 64, 2) mega(MegaArgs args) {
    extern __shared__ __attribute__((aligned(16))) unsigned char lds_raw[];
    LAS unsigned char* lds = (LAS unsigned char*)lds_raw;
    volatile LAS unsigned* MISC = (volatile LAS unsigned*)(lds + MISC_OFF);
    const int tid = threadIdx.x, lane = tid & 63, wave = __builtin_amdgcn_readfirstlane(tid >> 6);
    const int G = gridDim.x;
    const int vcu = (G % 8 == 0) ? ((int)blockIdx.x % 8) * (G / 8) + (int)blockIdx.x / 8 : (int)blockIdx.x;
    unsigned char* ws = args.ws;
    gu32* ctl = (gu32*)(ws + WS_CTL);
    for (int u = tid; u < (LDS_BYTES - RING_BYTES) / 4; u += NWAVES * 64) ((LAS unsigned*)(lds + RING_BYTES))[u] = 0u;
    __syncthreads();
    XcdBarrier bar = xcd_barrier_post((unsigned*)(ctl + CW_BAR) + (args.li & 255u) * XCD_BAR_WORDS, MISC + 8);
    const unsigned ph = args.phases;
    const float* x = args.in[0]; const float* w_in = args.in[1];
    bf16_t* xb = (bf16_t*)(ws + WS_XB);
    bf16_t* merged = (bf16_t*)((unsigned char*)args.out + DO_MERGED);
    bf16_t* oab = (bf16_t*)((unsigned char*)args.out + DO_OAB);
    bf16_t* WinT = (bf16_t*)(ws + WS_WINT); bf16_t* projT = (bf16_t*)(ws + WS_PROJT); bf16_t* woutT = (bf16_t*)(ws + WS_WOUTT); bf16_t* WrT = (bf16_t*)(ws + WS_WRT);
    bf16_t* qkvg = (bf16_t*)(ws + WS_QKV); bf16_t* gates = (bf16_t*)(ws + WS_GATES);
    bf16_t* pre = (bf16_t*)(ws + WS_PRE);
    bf16_t* h1b = (bf16_t*)((unsigned char*)args.out + DO_H1B);
    bf16_t* Wgu = (bf16_t*)(ws + WS_WGU); bf16_t* Wd = (bf16_t*)(ws + WS_WD);
    bf16_t* hb = (bf16_t*)(ws + WS_HB); bf16_t* ybuf = (bf16_t*)(ws + WS_Y);
    float* logits = (float*)(ws + WS_LOGITS);
    unsigned* eidx = (unsigned*)(ws + WS_EIDX); float* gatev = (float*)(ws + WS_GATE); unsigned* posv = (unsigned*)(ws + WS_POS);
    unsigned short* elist = (unsigned short*)(ws + WS_LIST);
    unsigned* cntw = (unsigned*)(ctl + CW_CNT);
    const int gw = vcu * NWAVES + wave, NGW = G * NWAVES;

    if (ph & 1u) {
        LAS unsigned char* scr = lds + wave * 16384;
        constexpr int NBLK = QW / 64, I_WIN = (D / 64) * NBLK, I_PA = (512 / 64) * (D / 64), I_WO = (D / 64) * (D / 64), I_WR = (D / 64) * (NE / 64);
        constexpr int NITEMS = I_WIN + 2 * I_PA + I_WO + I_WR;
        auto ident = [](int c) { return c; };
        for (int it = gw; it < NITEMS; it += NGW) {
            int r = it;
            if (r < I_WIN) { transpose_item(w_in, D, INW, WinT, NBLK, scr, r, lane, [](int c) { return colmap_win(c); }); continue; } r -= I_WIN;
            if (r < I_PA) { transpose_item(args.in[8], 512, D, projT, D / 64, scr, r, lane, ident, D, 0); continue; } r -= I_PA;
            if (r < I_PA) { transpose_item(args.in[9], 512, D, projT, D / 64, scr, r, lane, ident, D, 512); continue; } r -= I_PA;
            if (r < I_WO) { transpose_item(args.in[10], D, D, woutT, D / 64, scr, r, lane, ident); continue; } r -= I_WO;
            transpose_item(args.in[13], D, NE, WrT, NE / 64, scr, r, lane, ident);
        }
        { bf16_t* W1T = (bf16_t*)(ws + WS_W1T); bf16_t* W2T = (bf16_t*)(ws + WS_W2T); float* c1 = (float*)(ws + WS_C1);
          constexpr int I_1 = (2048 / 64) * (128 / 64), I_2 = (128 / 64) * (64 / 64);
          for (int it = gw; it < 2 * (I_1 + I_2); it += NGW) { const int which = it / (I_1 + I_2); int r = it % (I_1 + I_2);
              if (r < I_1) transpose_item(args.in[3] + (size_t)which * 2048 * 128, 2048, 128, W1T + (size_t)which * 128 * 2048, 2, scr, r, lane, ident);
              else transpose_item(args.in[5] + (size_t)which * 128 * 64, 128, 64, W2T + (size_t)which * 64 * 128, 1, scr, r - I_1, lane, ident); }
          for (int o = gw; o < 256; o += NGW) { const int which = o >> 7, nn = o & 127; const float* pe = args.in[2] + which * 2048; const float* w1 = args.in[3] + (size_t)which * 2048 * 128 + nn;
              float a = 0.f; for (int k = lane; k < 2048; k += 64) a = fmaf(pe[k], w1[(size_t)k * 128], a);
              a = wave_sum_x(a); if (lane == 0) c1[o] = a + args.in[4][o]; } }
        const size_t nchunk = (size_t)T * D / 8, gstep = (size_t)G * NWAVES * 64;
        for (size_t i = (size_t)blockIdx.x * (NWAVES * 64) + tid; i < nchunk; i += 4 * gstep) {
            f32x4 a[4], b[4];
#pragma unroll
            for (int j = 0; j < 4; ++j) { const size_t ii = (i + j * gstep < nchunk) ? i + j * gstep : i; a[j] = __builtin_nontemporal_load((const f32x4*)(x + ii * 8)); b[j] = __builtin_nontemporal_load((const f32x4*)(x + ii * 8 + 4)); }
#pragma unroll
            for (int j = 0; j < 4; ++j) { const size_t ii = (i + j * gstep < nchunk) ? i + j * gstep : i;
                u32x4 o; o.x = pk2(a[j][0], a[j][1]); o.y = pk2(a[j][2], a[j][3]); o.z = pk2(b[j][0], b[j][1]); o.w = pk2(b[j][2], b[j][3]);
                *(u32x4*)(xb + ii * 8) = o; }
        }
        xcd_barrier(bar);
    }
    if (ph & 2u) {
        pg8::DenseOrder S; S.init(xb, WinT, T, QW, D, G, (int)blockIdx.x);
        EpiQKV E{qkvg, gates};
        pg8::gemm_phase<EpiQKV, pg8::DenseOrder, true, false, false, 16>(lds, D, S, E);
        xcd_barrier(bar);
    }
    if (ph & 4u) {
        const bf16_t* W1T = (const bf16_t*)(ws + WS_W1T); const bf16_t* W2T = (const bf16_t*)(ws + WS_W2T); const float* c1 = (const float*)(ws + WS_C1);
        if (G == 256) {
            u32x4 cr0[5], cr1[5]; att::compress_load(qkvg, (int)blockIdx.x, tid, cr0); att::compress_load(qkvg, (int)blockIdx.x + 256, tid, cr1);
            for (int u = (int)blockIdx.x; u < 1024; u += 512) {
                att::compress_stage(lds, tid, cr0); att::compress_stage1(lds, tid, cr1);
                __syncthreads();
                { const int un = u + 512 < 1024 ? u + 512 : u; att::compress_load(qkvg, un, tid, cr0); att::compress_load(qkvg, un + 256, tid, cr1); }
                att::compress_unit2(lds, lane, wave, W1T, W2T, c1, (bf16_t*)(ws + WS_KCMP), (bf16_t*)(ws + WS_VCMP), u);
            }
        } else {
            u32x4 cr[5]; att::compress_load(qkvg, (int)blockIdx.x < 1024 ? (int)blockIdx.x : 0, tid, cr);
            for (int u = (int)blockIdx.x; u < 1024; u += G) {
                att::compress_stage(lds, tid, cr);
                __syncthreads();
                att::compress_load(qkvg, u + G < 1024 ? u + G : u, tid, cr);
                att::compress_unit(lds, lane, wave, W1T, W2T, c1, (bf16_t*)(ws + WS_KCMP), (bf16_t*)(ws + WS_VCMP), u);
            }
        }
        xcd_barrier(bar);
    }
    if (ph & 8u) {
        { LAS float* biasL = (LAS float*)(lds + att::L_BIAS); const float* tab = args.in[7];
          for (int i = tid; i < 16 * 132; i += NWAVES * 64) { const int hh = i / 132, d = i % 132; biasL[i] = tab[(d >= 128 ? 31 : (int)BUCKET[d]) * 16 + hh] * att::LOG2E; } }
        __syncthreads();
        const int nstat = (2048 - 256 - (int)blockIdx.x + G - 1) / G, cgrp = ((int)blockIdx.x >> 3) & 7, cslot = nstat <= 0 ? 0 : (cgrp < nstat ? cgrp : nstat - 1);
        int u = 256 + (int)blockIdx.x;
        for (int itn = 0;; ++itn) {
            int tile = -1, bg = 0;
            if (u < 2048) { const int w = u & 255, k = u >> 8, sub = w >> 4; bg = w & 15; tile = 16 * k + ((k & 1) ? 15 - sub : sub); u += G; }
            else {
                __syncthreads();
                if (tid == 0) *(volatile LAS unsigned*)(lds + att::L_END) = __hip_atomic_fetch_add((unsigned*)(ctl + CW_ATTQ), 1u, __ATOMIC_RELAXED, __HIP_MEMORY_SCOPE_AGENT);
                __syncthreads();
                const int qd = __builtin_amdgcn_readfirstlane((int)*(volatile LAS unsigned*)(lds + att::L_END));
                if (qd < 256) { bg = qd & 15; tile = 15 - (qd >> 4); }
            }
            if (itn == cslot) {
                static_assert(2047 + 23 * 2048 < I_EXP && I_EXP <= 25 * 2048, "conversion share");
                for (int r = 0; r < 8; ++r) {
                    int lane2 = tid; asm volatile("" : "+v"(lane2)); lane2 &= 63;
                    LAS unsigned char* scr = lds + wave * 9216;
                    const int i0 = __builtin_amdgcn_readfirstlane(gw + 3 * r * NGW), i1 = i0 + NGW, i2 = i1 + NGW;
                    f32x4 va[16], vb[16];
                    expert_load(args.in, i0, lane2, va); expert_load(args.in, i1, lane2, vb);
                    expert_finish(Wgu, Wd, scr, i0, lane2, va); expert_load(args.in, i2, lane2, va);
                    expert_finish(Wgu, Wd, scr, i1, lane2, vb);
                    expert_finish(Wgu, Wd, scr, i2, lane2, va);
                }
            }
            if (tile < 0) break;
            __syncthreads();
            { int tidu = tid; asm volatile("" : "+v"(tidu));
              att::unit(lds, tidu, tidu & 63, wave, qkvg, (const bf16_t*)(ws + WS_KCMP), (const bf16_t*)(ws + WS_VCMP), args.in[6], oab, bg >> 1, bg & 1, tile); }
            __syncthreads();
        }
        {
            const int it = gw + 24 * NGW;
            if (it < I_EXP) { int lane2 = tid; asm volatile("" : "+v"(lane2)); lane2 &= 63; f32x4 vc[16]; expert_load(args.in, it, lane2, vc); expert_finish(Wgu, Wd, lds + wave * 9216, it, lane2, vc); }
        }
        xcd_barrier(bar);
    }
    if (ph & 64u) {
        pg8::DenseOrder S; S.init(h1b, WrT, T, NE, D, G, (int)blockIdx.x);
        {
            OneUnit S1; if (!S.next(0, S1.u)) S1.u = pg8::Unit{(const char*)h1b, (const char*)WrT, 0, 0, 256, 0, 0, 0, 0};
            { PanelOrder SP{(const char*)oab, (const char*)projT, D, S1.u.row0}; EpiMerge E{gates, merged}; pg8::gemm_phase<EpiMerge, PanelOrder, true, false, true>(lds, D, SP, E); }
            xcd_barrier(bar);
            { PanelOrder SP{(const char*)merged, (const char*)woutT, D, S1.u.row0}; EpiWout E{xb, pre}; pg8::gemm_phase<EpiWout, PanelOrder, true, false, false>(lds, D, SP, E); }
            asm volatile("s_waitcnt vmcnt(0)" ::: "memory");
            __syncthreads();
            __builtin_amdgcn_fence(__ATOMIC_ACQUIRE, "agent");
            const int r0 = S1.u.row0 + wave * 32;
            f32x4 g1v[4], b1v[4];
#pragma unroll
            for (int j = 0; j < 4; ++j) { g1v[j] = *(const f32x4*)(args.in[11] + 16 * lane + 4 * j); b1v[j] = *(const f32x4*)(args.in[12] + 16 * lane + 4 * j); }
            for (int m = 0; m < 32; m += 4) {
                u32x4 ra[4], rc[4];
#pragma unroll
                for (int j = 0; j < 4; ++j) { const bf16_t* xr = pre + (size_t)(r0 + m + j) * D + 16 * lane; ra[j] = *(const u32x4*)xr; rc[j] = *(const u32x4*)(xr + 8); }
#pragma unroll
                for (int j = 0; j < 4; ++j) ln_regs_to_bf16(ra[j], rc[j], h1b + (size_t)(r0 + m + j) * D, g1v, b1v, lane);
            }
            asm volatile("s_waitcnt vmcnt(0)" ::: "memory");
            __syncthreads();
            { EpiLogits E{logits}; pg8::gemm_phase<EpiLogits, OneUnit, false, false, false>(lds, D, S1, E); }
            asm volatile("s_waitcnt vmcnt(0)" ::: "memory");
            __syncthreads();
            {
                LAS float* lgs = (LAS float*)(lds + wave * 8192);
                float rb[4];
#pragma unroll
                for (int i = 0; i < 4; ++i) rb[i] = args.in[14][lane + 64 * i];
                f32x4 rr[8];
#pragma unroll
                for (int k = 0; k < 8; ++k) rr[k] = *(const f32x4*)(logits + (size_t)(r0 + k) * NE + 4 * lane);
                const unsigned long long below = (1ull << lane) - 1ull;
                unsigned ekp = 0u, gkp = 0u, ppv = 0u;
                for (int mb = 0; mb < 32; mb += 8) {
#pragma unroll
                    for (int k = 0; k < 8; ++k) *(LAS f32x4*)(lgs + k * 256 + 4 * lane) = rr[k];
                    { const int nb_ = mb + 8 < 32 ? mb + 8 : mb;
#pragma unroll
                      for (int k = 0; k < 8; ++k) rr[k] = *(const f32x4*)(logits + (size_t)(r0 + nb_ + k) * NE + 4 * lane); }
                    for (int m = mb; m < mb + 8; ++m) {
                        const int t = r0 + m;
                        float lg[4];
#pragma unroll
                        for (int i = 0; i < 4; ++i) lg[i] = lgs[(m - mb) * 256 + lane + 64 * i];
                        unsigned long long Sm[4]; float sc[4], gsum;
                        route_select(lg, rb, lane, Sm, sc, gsum);
                        unsigned ek = 0u, gk = 0u; int base_ = 0;
#pragma unroll
                        for (int i = 0; i < 4; ++i) { const bool sel = (Sm[i] >> lane) & 1ull;
                            const int tgt = sel ? base_ + __popcll(Sm[i] & below) : 8 + (lane & 7);
                            ek |= (unsigned)__builtin_amdgcn_ds_permute(tgt * 4, lane + 64 * i);
                            gk |= (unsigned)__builtin_amdgcn_ds_permute(tgt * 4, __builtin_bit_cast(int, sc[i] / gsum * 2.5f));
                            base_ += __popcll(Sm[i]); }
                        const int cch = t / CHT;
                        unsigned p = 0u;
                        if (lane < 8) {
                            p = atomicAdd(&cntw[cch * 256 + ek], 1u);
                            if (m > 0) { const int tp = t - 1, cp = tp / CHT; Rec3 rec; rec.x = ekp; rec.y = ppv; rec.z = gkp;
                                *(Rec3*)(eidx + 3 * ((size_t)tp * TOPK + lane)) = rec;
                                elist[((size_t)cp * 256 + ekp) * CHT + ppv] = (unsigned short)(tp - cp * CHT); }
                        }
                        ekp = ek; gkp = gk; ppv = p;
                    }
                }
                if (lane < 8) { const int tp = r0 + 31, cp = tp / CHT; Rec3 rec; rec.x = ekp; rec.y = ppv; rec.z = gkp;
                    *(Rec3*)(eidx + 3 * ((size_t)tp * TOPK + lane)) = rec;
                    elist[((size_t)cp * 256 + ekp) * CHT + ppv] = (unsigned short)(tp - cp * CHT); }
            }
        }
        xcd_barrier(bar);
    }
    if (ph & 512u) {
        MoeCtx mc; mc.lds = lds; mc.ws = ws; mc.out = args.out; mc.ln2g = args.in[21]; mc.ln2b = args.in[22]; mc.G = G; mc.gw = gw; mc.NGW = NGW; mc.tid = tid; mc.lane = lane;
        static_assert(NCH == 2, "MoE chunk program");
        moe_gu<0>(mc); xcd_barrier(bar); moe_d<0>(mc); xcd_barrier(bar);
        moe_cgu<0>(mc); xcd_barrier(bar); moe_d<1>(mc); xcd_barrier(bar);
        moe_prefix((const unsigned*)(ws + WS_CTL) + CW_CNT + 1 * 256, nullptr, moe_esc(lds), nullptr, tid);
        moe_combine<1>(mc);
    }
}

extern "C" void kernel_launch(void* const* d_in, const int* in_sizes, int n_in, void* d_out, int out_size, void* d_ws, size_t ws_size, hipStream_t stream) {
    static int grid = 0;
    if (grid == 0) {
        if (n_in != 23 || in_sizes[0] != T * D || out_size != T * D || ws_size < WS_NEED) { fprintf(stderr, "kernel_launch: unexpected inputs / workspace (%d inputs, %zu bytes)\n", n_in, ws_size); grid = -1; return; }
        int dev = 0, cus = 0;
        if (hipGetDevice(&dev) != hipSuccess || hipDeviceGetAttribute(&cus, hipDeviceAttributeMultiprocessorCount, dev) != hipSuccess) { grid = -1; return; }
        if (hipFuncSetAttribute((const void*)mega, hipFuncAttributeMaxDynamicSharedMemorySize, LDS_BYTES) != hipSuccess) { fprintf(stderr, "kernel_launch: hipFuncSetAttribute failed\n"); grid = -1; return; }
        int per_cu = 0;
        if (hipOccupancyMaxActiveBlocksPerMultiprocessor(&per_cu, (const void*)mega, NWAVES * 64, LDS_BYTES) != hipSuccess || per_cu < 1) fprintf(stderr, "kernel_launch: occupancy query says %d\n", per_cu);
        (void)hipGetLastError();
        if (cus != 256) fprintf(stderr, "kernel_launch: built for the 256 CUs of MI355X (one row panel per workgroup), found %d\n", cus);
        grid = cus;
    }
    if (grid < 0) return;
    (void)hipMemsetAsync((char*)d_ws + WS_CTL, 0, CTL_ZERO_BYTES, stream);
    MegaArgs a{};
    for (int i = 0; i < 23; ++i) a.in[i] = (const float*)d_in[i];
    a.out = (float*)d_out; a.ws = (unsigned char*)d_ws; a.phases = 0x3ffu; a.li = 0u;
    hipLaunchKernelGGL(mega, dim3(grid), dim3(NWAVES * 64), LDS_BYTES, stream, a);
}
```

```cpp
#include <hip/hip_runtime.h>
#include <stdint.h>
#include <math.h>
#include <cstdio>

#define GAS __attribute__((address_space(1)))
#define LAS __attribute__((address_space(3)))
typedef unsigned short bf16_t;
typedef short bf16x8 __attribute__((ext_vector_type(8)));
typedef float f32x4 __attribute__((ext_vector_type(4)));
typedef float f32x2 __attribute__((ext_vector_type(2)));
typedef unsigned u32x4 __attribute__((ext_vector_type(4)));
typedef unsigned u32x2 __attribute__((ext_vector_type(2)));
typedef GAS unsigned gu32;
typedef short v4i16_t __attribute__((ext_vector_type(4)));

constexpr int D = 1024, NB = 8, S = 8192, T = NB * S;
constexpr int INW = 4120;
constexpr int O_QA = 0, O_KC = 512, O_VC = 640, O_KS = 768, O_VS = 896, O_KW = 1024, O_VW = 1152, O_GA = 1280,
              O_QB = 1304, O_KB = 1816, O_VB = 1944, O_GATEA = 2072, O_GATEB = 3096;
constexpr int QW = 4352, QP = 2304, GP = 2048;
constexpr int C_QA = 0, C_KC = 512, C_VC = 640, C_KS = 768, C_VS = 896, C_KW = 1024, C_VW = 1152,
              C_QB = 1280, C_KB = 1792, C_VB = 1920, C_GA = 2048, C_GATEA = 2304, C_GATEB = 3328;
constexpr int NCMP = 511, NSEL = 128;
constexpr int NE = 256, TOPK = 8, EH = 256;
constexpr float DN_ALPHA = 1.189207115002721f;
constexpr float LN_EPS = 1e-5f;
constexpr int MB = 64;
constexpr int NASSIGN = T * TOPK;
constexpr int NTILES_MAX = (NASSIGN + NE * (MB - 1) + MB - 1) / MB;
constexpr int NROWS_MAX = NTILES_MAX * MB;

__device__ const unsigned char BUCKET[128] = {0, 1, 2, 3, 4, 5, 6, 7, 8, 9, 10, 11, 12, 13, 14, 15, 16, 16, 16, 17, 17, 18, 18, 18, 19, 19, 19, 20, 20, 20, 20, 21, 21, 21, 21, 22, 22, 22, 22, 22, 23, 23, 23, 23, 23, 23, 24, 24, 24, 24, 24, 24, 25, 25, 25, 25, 25, 25, 25, 26, 26, 26, 26, 26, 26, 26, 26, 27, 27, 27, 27, 27, 27, 27, 27, 27, 27, 28, 28, 28, 28, 28, 28, 28, 28, 28, 28, 29, 29, 29, 29, 29, 29, 29, 29, 29, 29, 29, 29, 30, 30, 30, 30, 30, 30, 30, 30, 30, 30, 30, 30, 30, 30, 31, 31, 31, 31, 31, 31, 31, 31, 31, 31, 31, 31, 31, 31, 31};
__device__ __forceinline__ int bucket_of(int dist) { return dist >= 128 ? 31 : (int)BUCKET[dist < 0 ? 0 : dist]; }
__device__ __forceinline__ float sigmoidf_(float x) { return 1.0f / (1.0f + expf(-x)); }
__device__ __forceinline__ float bf2f(bf16_t h) { return __builtin_bit_cast(float, (unsigned)h << 16); }
__device__ __forceinline__ unsigned f2bf(float f) { unsigned u = __builtin_bit_cast(unsigned, f); return (u + 0x7fffu + ((u >> 16) & 1u)) >> 16; }
__device__ __forceinline__ unsigned pk2(float lo, float hi) { return f2bf(lo) | (f2bf(hi) << 16); }
typedef __bf16 bf16x2_t __attribute__((ext_vector_type(2)));
__device__ __forceinline__ unsigned cvt_pk_bf16(float lo, float hi) { const f32x2 v = {lo, hi}; const bf16x2_t b = __builtin_convertvector(v, bf16x2_t); return __builtin_bit_cast(unsigned, b); }

constexpr size_t MiB = 1u << 20;
constexpr size_t WS_CTL = 0, CTL_ZERO_BYTES = 1 * MiB;
constexpr size_t WS_WINT = 1 * MiB;
constexpr size_t WS_PROJT = 10 * MiB;
constexpr size_t WS_WOUTT = 12 * MiB;
constexpr size_t WS_WRT = 14 * MiB;
constexpr size_t WS_WGU = 20 * MiB;
constexpr size_t WS_WD = 277 * MiB;
constexpr size_t WS_GATES = 406 * MiB;
constexpr size_t WS_XB = 534 * MiB;
constexpr size_t WS_QKV = 662 * MiB;
constexpr size_t WS_PRE = 662 * MiB;
constexpr size_t WS_HB = 406 * MiB;
constexpr size_t WS_Y = 552 * MiB;
constexpr size_t WS_YS = 892 * MiB;
constexpr size_t WS_LOGITS = 790 * MiB;
constexpr size_t WS_EIDX = 854 * MiB, WS_GATE = 856 * MiB, WS_POS = 858 * MiB;
constexpr size_t WS_LIST = 860 * MiB;
constexpr size_t DO_XB = 0, DO_MERGED = 0, DO_OAB = 128 * MiB, DO_H1B = 128 * MiB;
constexpr size_t WS_KCMP = 1020 * MiB, WS_VCMP = 1021 * MiB;
constexpr size_t WS_NEED = 1030 * MiB;
constexpr int NCH = 2, CHT = T / NCH, CROWS = 9 * CHT;
constexpr int CW_CNT = 32768;
constexpr int CW_BAR = 4096;
constexpr int CW_ATTQ = 65536;

#define XB_TMO      128
#define XB_XCNT(j)  (256  + 64 * (j))
#define XB_XSUB(j)  (1280 + 64 * (j))
#define XB_XGEN(j)  (2304 + 64 * (j))
#define XB_TOP      3328
#define XB_TOPGEN   3392
#define XCD_BAR_WORDS 3456
#define XB_SPIN_CAP (1u << 18)
__device__ __forceinline__ unsigned xb_ld(unsigned* p)              { return __hip_atomic_load(p, __ATOMIC_RELAXED, __HIP_MEMORY_SCOPE_AGENT); }
__device__ __forceinline__ unsigned xb_add(unsigned* p, unsigned v) { return __hip_atomic_fetch_add(p, v, __ATOMIC_RELAXED, __HIP_MEMORY_SCOPE_AGENT); }
__device__ __forceinline__ unsigned xb_xcc_id() { return (unsigned)__builtin_amdgcn_s_getreg((3 << 11) | 20) & 0xFu; }
#define XB_SPIN(cond, bar) do { unsigned _sp = 0; while (cond) { __builtin_amdgcn_s_sleep(1); \
    if ((++_sp & 255u) == 0u) { if (xb_ld(&(bar)[XB_TMO])) break; if (_sp > XB_SPIN_CAP) { atomicAdd(&(bar)[XB_TMO], 1u); break; } } } } while (0)
struct XcdBarrier { unsigned* bar; unsigned x; volatile LAS unsigned* st; };
__device__ __forceinline__ XcdBarrier xcd_barrier_post(unsigned* bar, volatile LAS unsigned* st) {
    XcdBarrier b; b.bar = bar; b.x = xb_xcc_id(); b.st = st;
    if (threadIdx.x == 0) (void)xb_add(&bar[XB_XCNT(b.x)], 1u);
    return b;
}
__device__ __forceinline__ void xcd_barrier_complete(unsigned* bar, unsigned x, unsigned& nloc, unsigned& nx) {
    const unsigned G = gridDim.x * gridDim.y * gridDim.z;
    unsigned sum, cnt, mine, sp = 0u;
    for (;;) {
        sum = 0u; cnt = 0u; mine = 0u;
#pragma unroll
        for (unsigned j = 0; j < 16; ++j) { const unsigned c = xb_ld(&bar[XB_XCNT(j)]); sum += c; cnt += (c > 0u) ? 1u : 0u; mine = (j == x) ? c : mine; }
        if (sum == G) break;
        __builtin_amdgcn_s_sleep(1);
        if ((++sp & 255u) == 0u) { if (xb_ld(&bar[XB_TMO])) break; if (sp > XB_SPIN_CAP) { atomicAdd(&bar[XB_TMO], 1u); break; } }
    }
    nloc = mine > 0u ? mine : 1u; nx = cnt > 0u ? cnt : 1u;
}
__device__ __forceinline__ void xcd_barrier(const XcdBarrier& b) {
    asm volatile("s_waitcnt vmcnt(0)" ::: "memory");
    __syncthreads();
    if (threadIdx.x == 0) {
        unsigned* bar = b.bar;
        __builtin_amdgcn_s_waitcnt(0);
        unsigned nloc = b.st[0], nx = b.st[1];
        if (nloc == 0u) { xcd_barrier_complete(bar, b.x, nloc, nx); b.st[0] = nloc; b.st[1] = nx; }
        const unsigned old = xb_add(&bar[XB_XSUB(b.x)], 1u);
        const unsigned gen = old / nloc;
        if (old + 1u == (gen + 1u) * nloc) {
            __builtin_amdgcn_fence(__ATOMIC_RELEASE, "agent");
            asm volatile("s_waitcnt vmcnt(0)" ::: "memory");
            const unsigned og = xb_add(&bar[XB_TOP], 1u);
            const unsigned tg = og / nx;
            if (og + 1u == (tg + 1u) * nx) xb_add(&bar[XB_TOPGEN], 1u);
            else XB_SPIN(xb_ld(&bar[XB_TOPGEN]) == tg, bar);
            __builtin_amdgcn_fence(__ATOMIC_ACQUIRE, "agent");
            xb_add(&bar[XB_XGEN(b.x)], 1u);
            asm volatile("s_waitcnt vmcnt(0)" ::: "memory");
        } else {
            XB_SPIN(xb_ld(&bar[XB_XGEN(b.x)]) == gen, bar);
            __builtin_amdgcn_fence(__ATOMIC_ACQUIRE, "agent");
            asm volatile("s_waitcnt vmcnt(0)" ::: "memory");
        }
    }
    __syncthreads();
}

namespace pg8 {
constexpr int BM = 256, BK = 64, HALF = 128, HTB = HALF * BK * 2, STAGE_BYTES = 8 * HTB;
__host__ __device__ __forceinline__ int lds_byte(int r, int c) { const int st = (r >> 4) * 2 + (c >> 5), rr = r & 15, cc = c & 31, ob = rr * 64 + cc * 2; return st * 1024 + (ob ^ (((ob >> 9) & 1) << 5)); }
__host__ __device__ __forceinline__ void stage_rc(int b, int& R, int& C) { const int st = b / 1024, sb = b % 1024, swz = sb ^ (((sb >> 9) & 1) << 5); R = (st >> 1) * 16 + swz / 64; C = (st & 1) * 32 + (swz % 64) / 2; }
__host__ __device__ __forceinline__ int perm32(int rho) { const int n = rho >> 4, i = rho & 15; return 8 * (i >> 2) + 4 * n + (i & 3); }

struct Unit { const char* A; const char* B; int row0, col0, nrows, aux, e, ti, ord; };

template <class Epi, class Sched, bool ALIGN_EPI, bool GATHER, bool MIDHOOK, int EPI_VM = 0>
__device__ __forceinline__ void gemm_phase(LAS unsigned char* lds, const int K, const Sched& S, const Epi& E) {
    const int tid = threadIdx.x, wid = __builtin_amdgcn_readfirstlane(tid >> 6), lane = tid & 63, wr = wid >> 2, wc = wid & 3, fr = lane & 15, fq = lane >> 4;
    const int nt = K / BK;
    int Rr[2], Cc[2];
    unsigned vcur[2][2], vnxt[2][2], voffB[2];
#pragma unroll
    for (int i = 0; i < 2; ++i) { int R, C; stage_rc(tid * 16 + i * 8192, R, C); Rr[i] = R; Cc[i] = C; const int Rb = (int)Epi::PERM == 2 ? (64 * (R >> 5) + 16 * ((R & 15) >> 2) + 4 * ((R >> 4) & 1) + (R & 3)) : (Epi::PERM ? ((R & ~31) + perm32(R & 31)) : R);
        voffB[i] = (unsigned)(Rb * K + C) * 2u;
#pragma unroll
        for (int h = 0; h < 2; ++h) { vcur[h][i] = (unsigned)((h * HALF + R) * K + C) * 2u; vnxt[h][i] = vcur[h][i]; } }
    const size_t kstep = (size_t)(BK * 2);
    const size_t hstep = (size_t)HALF * K * 2;
    const size_t hstepB = (int)Epi::PERM == 2 ? (size_t)8 * K * 2 : hstep;
    const unsigned ldsw = (unsigned)wid * 1024u;
    const int aoff = lds_byte(wr * 64 + fr, fq * 8), boff = lds_byte(wc * 32 + fr, fq * 8);
#define PG8_SA(b, h) (((b) * 2 + (h)) * HTB)
#define PG8_SB(b, h) ((4 + (b) * 2 + (h)) * HTB)
#define PG8_STAGE(bufoff, gbase, voff) do { _Pragma("unroll") for (int _i = 0; _i < 2; ++_i) \
        __builtin_amdgcn_global_load_lds((const unsigned*)((const char*)(gbase) + (voff)[_i]), (LAS unsigned*)(lds + (bufoff) + ldsw + _i * 8192), 16, 0, 0); } while (0)
#define PG8_LDA(dst, b, h) do { _Pragma("unroll") for (int m = 0; m < 4; ++m) _Pragma("unroll") for (int k = 0; k < 2; ++k) dst[m][k] = *(const LAS bf16x8*)(lds + PG8_SA(b, h) + aoff + m * 2048 + k * 1024); } while (0)
#define PG8_LDB(dst, b, h) do { _Pragma("unroll") for (int n = 0; n < 2; ++n) _Pragma("unroll") for (int k = 0; k < 2; ++k) dst[n][k] = *(const LAS bf16x8*)(lds + PG8_SB(b, h) + boff + n * 2048 + k * 1024); } while (0)
#define PG8_MMA(ai, bj, At, Bt) do { __builtin_amdgcn_s_setprio(1); _Pragma("unroll") for (int m = 0; m < 4; ++m) _Pragma("unroll") for (int n = 0; n < 2; ++n) _Pragma("unroll") for (int k = 0; k < 2; ++k) \
        acc[ai][bj][m][n] = __builtin_amdgcn_mfma_f32_16x16x32_bf16(Bt[n][k], At[m][k], acc[ai][bj][m][n], 0, 0, 0); __builtin_amdgcn_s_setprio(0); } while (0)
#define PG8_WAIT_V(n) asm volatile("s_waitcnt vmcnt(" #n ")" ::: "memory")
#define PG8_WAIT_L(n) asm volatile("s_waitcnt lgkmcnt(" #n ")" ::: "memory")
#define PG8_BAR __builtin_amdgcn_s_barrier()
#define PG8_SCHED __builtin_amdgcn_sched_barrier(0)
    Unit cur, nxt; int ui = 0; int pfn = 1;
    if (!S.next(0, cur)) return;
    if constexpr (GATHER) {
#pragma unroll
        for (int h = 0; h < 2; ++h)
#pragma unroll
            for (int i = 0; i < 2; ++i) vcur[h][i] = S.arow_off(cur, h * HALF + Rr[i]) + (unsigned)Cc[i] * 2u;
    }
    f32x4 acc[2][2][4][2];
#pragma unroll
    for (int a = 0; a < 2; ++a)
#pragma unroll
        for (int b = 0; b < 2; ++b)
#pragma unroll
            for (int m = 0; m < 4; ++m)
#pragma unroll
                for (int n = 0; n < 2; ++n) acc[a][b][m][n] = (f32x4){0.f, 0.f, 0.f, 0.f};
    bf16x8 At[4][2], B0[2][2], B1[2][2];
    const char* cA = cur.A; const char* cB = cur.B;
    PG8_STAGE(PG8_SB(0, 0), cB, voffB); PG8_STAGE(PG8_SB(0, 1), cB + hstepB, voffB); PG8_STAGE(PG8_SA(0, 0), cA, vcur[0]); PG8_STAGE(PG8_SA(0, 1), cA, vcur[1]);
    if (wr == 1) PG8_BAR;
    PG8_WAIT_V(2); PG8_BAR;
    PG8_STAGE(PG8_SB(1, 0), cB + kstep, voffB); PG8_STAGE(PG8_SA(1, 0), cA + kstep, vcur[0]); PG8_STAGE(PG8_SB(1, 1), cB + hstepB + kstep, voffB);
    PG8_WAIT_V(6); PG8_BAR;
    for (;;) {
        const bool has_next = S.next(ui + 1, nxt);
        const char* nA = has_next ? nxt.A : cA; const char* nB = has_next ? nxt.B : cB;
        if constexpr (GATHER) {
#pragma unroll
            for (int h = 0; h < 2; ++h)
#pragma unroll
                for (int i = 0; i < 2; ++i) vnxt[h][i] = has_next ? (S.arow_off(nxt, h * HALF + Rr[i]) + (unsigned)Cc[i] * 2u) : vcur[h][i];
        }
        for (int t = 0; t < nt; t += 2) {
            const bool last = (t == nt - 2);
            if constexpr (MIDHOOK) { if (t == nt / 2) E.mid(acc, cur, wr, wc, fr, fq); }
            const char* a1 = cA + (size_t)(t + 1) * kstep;
            const char* a2 = last ? nA : cA + (size_t)(t + 2) * kstep; const char* b2 = last ? nB : cB + (size_t)(t + 2) * kstep;
            const char* a3 = a2 + kstep; const char* b3 = b2 + kstep;
            unsigned va2[2][2];
#pragma unroll
            for (int h = 0; h < 2; ++h)
#pragma unroll
                for (int i = 0; i < 2; ++i) va2[h][i] = (GATHER && last) ? vnxt[h][i] : vcur[h][i];
            PG8_LDB(B0, 0, 0); PG8_LDB(B1, 0, 1); PG8_SCHED; PG8_LDA(At, 0, 0); PG8_STAGE(PG8_SA(1, 1), a1, vcur[1]);
            static_assert(EPI_VM == 0 || EPI_VM == 8 || EPI_VM == 16, "EPI_VM");
            if (EPI_VM == 8) asm volatile("s_cmp_lg_u32 %0, 0\n\ts_cbranch_scc1 1f\n\ts_waitcnt vmcnt(16)\n\ts_branch 2f\n1:\n\ts_waitcnt vmcnt(8)\n2:" :: "s"(__builtin_amdgcn_readfirstlane(t | pfn)) : "memory", "scc");
            else if (EPI_VM == 16) asm volatile("s_cmp_lg_u32 %0, 0\n\ts_cbranch_scc1 1f\n\ts_waitcnt vmcnt(24)\n\ts_branch 2f\n1:\n\ts_waitcnt vmcnt(8)\n2:" :: "s"(__builtin_amdgcn_readfirstlane(t | pfn)) : "memory", "scc");
            else PG8_WAIT_V(8);
            PG8_WAIT_L(0); PG8_BAR; PG8_MMA(0, 0, At, B0); PG8_MMA(0, 1, At, B1); PG8_BAR; PG8_SCHED;
            PG8_LDA(At, 0, 1); PG8_STAGE(PG8_SB(0, 0), b2, voffB); PG8_STAGE(PG8_SB(0, 1), b2 + hstepB, voffB); PG8_STAGE(PG8_SA(0, 0), a2, va2[0]);
            PG8_WAIT_V(8); PG8_WAIT_L(0); PG8_BAR; PG8_MMA(1, 0, At, B0); PG8_MMA(1, 1, At, B1); PG8_BAR; PG8_SCHED;
            PG8_LDB(B0, 1, 0); PG8_LDB(B1, 1, 1); PG8_SCHED; PG8_LDA(At, 1, 0); PG8_STAGE(PG8_SA(0, 1), a2, va2[1]);
            PG8_WAIT_V(8); PG8_WAIT_L(0); PG8_BAR; PG8_MMA(0, 0, At, B0); PG8_MMA(0, 1, At, B1); PG8_BAR; PG8_SCHED;
            PG8_LDA(At, 1, 1); PG8_STAGE(PG8_SB(1, 0), b3, voffB); PG8_STAGE(PG8_SB(1, 1), b3 + hstepB, voffB); PG8_STAGE(PG8_SA(1, 0), a3, va2[0]);
            PG8_WAIT_V(8); PG8_WAIT_L(0); PG8_BAR; PG8_MMA(1, 0, At, B0); PG8_MMA(1, 1, At, B1); PG8_BAR; PG8_SCHED;
        }
        if constexpr (ALIGN_EPI) { if (wr == 0) PG8_BAR; }
        E(acc, cur, wr, wc, fr, fq);
        if (!has_next) break;
#pragma unroll
        for (int a = 0; a < 2; ++a)
#pragma unroll
            for (int b = 0; b < 2; ++b)
#pragma unroll
                for (int m = 0; m < 4; ++m)
#pragma unroll
                    for (int n = 0; n < 2; ++n) acc[a][b][m][n] = (f32x4){0.f, 0.f, 0.f, 0.f};
        pfn = (cur.nrows == BM) ? 0 : 1;
        cur = nxt; cA = nA; cB = nB; ++ui;
        if constexpr (GATHER) {
#pragma unroll
            for (int h = 0; h < 2; ++h)
#pragma unroll
                for (int i = 0; i < 2; ++i) vcur[h][i] = vnxt[h][i];
        }
        if constexpr (ALIGN_EPI) { if (wr == 1) PG8_BAR; }
    }
    PG8_WAIT_V(0);
    if constexpr (!ALIGN_EPI) { if (wr == 0) PG8_BAR; }
    PG8_BAR;
#undef PG8_SA
#undef PG8_SB
#undef PG8_STAGE
#undef PG8_LDA
#undef PG8_LDB
#undef PG8_MMA
#undef PG8_WAIT_V
#undef PG8_WAIT_L
#undef PG8_BAR
#undef PG8_SCHED
}

struct DenseOrder {
    const char* A; const char* Bt; int K, nM, nN, nwg, G, c;
    __device__ void init(const void* A_, const void* Bt_, int M, int N, int K_, int G_, int c_) { A = (const char*)A_; Bt = (const char*)Bt_; K = K_; nM = M / BM; nN = N / BM; nwg = nM * nN; G = G_; c = c_; }
    __device__ __forceinline__ bool next(int i, Unit& u) const {
        const long L = (long)i * G + c; if (L >= nwg) return false;
        int wgid = (int)L; { const int q = nwg / 8, r = nwg % 8, xcd = wgid % 8, off = wgid / 8; wgid = (xcd < r ? xcd * (q + 1) : r * (q + 1) + (xcd - r) * q) + off; }
        const int nig = 8 * nN, gid = wgid / nig, fm = gid * 8, gsz = (nM - fm) < 8 ? (nM - fm) : 8;
        const int pm = fm + ((wgid % nig) % gsz), pn = (wgid % nig) / gsz;
        u.A = A + (size_t)pm * BM * K * 2; u.B = Bt + (size_t)pn * BM * K * 2; u.row0 = pm * BM; u.col0 = pn * BM; u.nrows = BM; u.aux = pn; u.e = 0; u.ti = 0; u.ord = 0; return true;
    }
    __device__ __forceinline__ unsigned arow_off(const Unit&, int) const { return 0u; }
};
}

struct EpiQKV {
    static constexpr bool PERM = true;
    bf16_t* O; bf16_t* Gt;
    __device__ __forceinline__ void operator()(const f32x4 (&acc)[2][2][4][2], const pg8::Unit& u, int wr, int wc, int fr, int fq) const {
        const bool sig = u.aux >= 9;
        const int row0 = u.row0 + wr * 64 + fr, col0 = u.col0 + wc * 32 + 8 * fq;
        bf16_t* const base = sig ? Gt - QP : O; const int pitch = sig ? GP : QP;
#pragma unroll
        for (int ai = 0; ai < 2; ++ai)
#pragma unroll
            for (int m = 0; m < 4; ++m) { bf16_t* rowp = base + (size_t)(row0 + ai * 128 + m * 16) * pitch + col0;
#pragma unroll
                for (int bj = 0; bj < 2; ++bj) { f32x4 v0 = acc[ai][bj][m][0], v1 = acc[ai][bj][m][1];
                    if (sig) {
#pragma unroll
                        for (int j = 0; j < 4; ++j) { v0[j] = __builtin_amdgcn_rcpf(1.0f + __builtin_amdgcn_exp2f(-1.4426950408889634f * v0[j])); v1[j] = __builtin_amdgcn_rcpf(1.0f + __builtin_amdgcn_exp2f(-1.4426950408889634f * v1[j])); }
                    }
                    if (sig) { int w0 = 0, w1 = 0;
                        w0 = __builtin_amdgcn_cvt_pk_fp8_f32(v0[0] * 256.f, v0[1] * 256.f, w0, false); w0 = __builtin_amdgcn_cvt_pk_fp8_f32(v0[2] * 256.f, v0[3] * 256.f, w0, true);
                        w1 = __builtin_amdgcn_cvt_pk_fp8_f32(v1[0] * 256.f, v1[1] * 256.f, w1, false); w1 = __builtin_amdgcn_cvt_pk_fp8_f32(v1[2] * 256.f, v1[3] * 256.f, w1, true);
                        u32x2 w; w.x = (unsigned)w0; w.y = (unsigned)w1;
                        *(u32x2*)((unsigned char*)Gt + (size_t)(row0 + ai * 128 + m * 16) * GP + (col0 - QP) + bj * 128) = w;
                    } else {
                        u32x4 w; w.x = cvt_pk_bf16(v0[0], v0[1]); w.y = cvt_pk_bf16(v0[2], v0[3]); w.z = cvt_pk_bf16(v1[0], v1[1]); w.w = cvt_pk_bf16(v1[2], v1[3]);
                        *(u32x4*)(rowp + bj * 128) = w; } } }
    }
};

struct EpiMerge {
    static constexpr int PERM = 2;
    const bf16_t* Gt; bf16_t* O;
    __device__ __forceinline__ void mid(f32x4 (&acc)[2][2][4][2], const pg8::Unit& u, int wr, int wc, int fr, int fq) const {
        int row0 = u.row0 + wr * 64 + fr, col0 = u.col0 + wc * 64 + 16 * fq;
        asm volatile("" : "+v"(row0), "+v"(col0));
#pragma unroll
        for (int ai = 0; ai < 2; ++ai)
#pragma unroll
            for (int m = 0; m < 4; ++m) { const unsigned char* gp = (const unsigned char*)Gt + (size_t)(row0 + ai * 128 + m * 16) * GP + col0;
                const u32x4 a = *(const u32x4*)gp, b = *(const u32x4*)(gp + 1024);
#pragma unroll
                for (int d = 0; d < 4; ++d) {
                    const f32x2 al = __builtin_amdgcn_cvt_pk_f32_fp8((int)a[d], false), ah = __builtin_amdgcn_cvt_pk_f32_fp8((int)a[d], true);
                    const f32x2 bl = __builtin_amdgcn_cvt_pk_f32_fp8((int)b[d], false), bh = __builtin_amdgcn_cvt_pk_f32_fp8((int)b[d], true);
                    acc[ai][d >> 1][m][d & 1][0] *= al.x * __builtin_amdgcn_rcpf(fmaxf(bl.x, 1e-30f)); acc[ai][d >> 1][m][d & 1][1] *= al.y * __builtin_amdgcn_rcpf(fmaxf(bl.y, 1e-30f));
                    acc[ai][d >> 1][m][d & 1][2] *= ah.x * __builtin_amdgcn_rcpf(fmaxf(bh.x, 1e-30f)); acc[ai][d >> 1][m][d & 1][3] *= ah.y * __builtin_amdgcn_rcpf(fmaxf(bh.y, 1e-30f)); }
                asm volatile("" ::: "memory"); }
    }
    __device__ __forceinline__ void operator()(const f32x4 (&acc)[2][2][4][2], const pg8::Unit& u, int wr, int wc, int fr, int fq) const {
        int row0 = u.row0 + wr * 64 + fr, col0 = u.col0 + wc * 64 + 16 * fq;
        asm volatile("" : "+v"(row0), "+v"(col0));
#pragma unroll
        for (int ai = 0; ai < 2; ++ai)
#pragma unroll
            for (int m = 0; m < 4; ++m) { const unsigned char* gp = (const unsigned char*)Gt + (size_t)(row0 + ai * 128 + m * 16) * GP + col0; bf16_t* rowp = O + (size_t)(row0 + ai * 128 + m * 16) * D + col0;
                const u32x4 b = *(const u32x4*)(gp + 1024); float v[16];
#pragma unroll
                for (int d = 0; d < 4; ++d) { const f32x2 bl = __builtin_amdgcn_cvt_pk_f32_fp8((int)b[d], false), bh = __builtin_amdgcn_cvt_pk_f32_fp8((int)b[d], true);
                    v[4 * d] = acc[ai][d >> 1][m][d & 1][0] * (fmaxf(bl.x, 1e-30f) * 0.00390625f); v[4 * d + 1] = acc[ai][d >> 1][m][d & 1][1] * (fmaxf(bl.y, 1e-30f) * 0.00390625f);
                    v[4 * d + 2] = acc[ai][d >> 1][m][d & 1][2] * (fmaxf(bh.x, 1e-30f) * 0.00390625f); v[4 * d + 3] = acc[ai][d >> 1][m][d & 1][3] * (fmaxf(bh.y, 1e-30f) * 0.00390625f); }
                u32x4 w0, w1; w0.x = cvt_pk_bf16(v[0], v[1]); w0.y = cvt_pk_bf16(v[2], v[3]); w0.z = cvt_pk_bf16(v[4], v[5]); w0.w = cvt_pk_bf16(v[6], v[7]);
                w1.x = cvt_pk_bf16(v[8], v[9]); w1.y = cvt_pk_bf16(v[10], v[11]); w1.z = cvt_pk_bf16(v[12], v[13]); w1.w = cvt_pk_bf16(v[14], v[15]);
                *(u32x4*)rowp = w0; *(u32x4*)(rowp + 8) = w1;
                asm volatile("" ::: "memory"); }
    }
};
struct EpiWout {
    static constexpr bool PERM = true;
    const bf16_t* X; bf16_t* O;
    __device__ __forceinline__ void operator()(const f32x4 (&acc)[2][2][4][2], const pg8::Unit& u, int wr, int wc, int fr, int fq) const {
        int row0 = u.row0 + wr * 64 + fr, col0 = u.col0 + wc * 32 + 8 * fq;
        asm volatile("" : "+v"(row0), "+v"(col0));
#pragma unroll
        for (int ai = 0; ai < 2; ++ai)
#pragma unroll
            for (int m = 0; m < 4; ++m) { const size_t off = (size_t)(row0 + ai * 128 + m * 16) * D + col0;
#pragma unroll
                for (int bj = 0; bj < 2; ++bj) { const u32x4 xv = *(const u32x4*)(X + off + bj * 128);
                    f32x4 x0, x1; x0[0] = __builtin_bit_cast(float, xv[0] << 16); x0[1] = __builtin_bit_cast(float, xv[0] & 0xffff0000u); x0[2] = __builtin_bit_cast(float, xv[1] << 16); x0[3] = __builtin_bit_cast(float, xv[1] & 0xffff0000u);
                    x1[0] = __builtin_bit_cast(float, xv[2] << 16); x1[1] = __builtin_bit_cast(float, xv[2] & 0xffff0000u); x1[2] = __builtin_bit_cast(float, xv[3] << 16); x1[3] = __builtin_bit_cast(float, xv[3] & 0xffff0000u);
                    const f32x4 v0 = x0 * DN_ALPHA + acc[ai][bj][m][0], v1 = x1 * DN_ALPHA + acc[ai][bj][m][1];
                    u32x4 w; w.x = cvt_pk_bf16(v0[0], v0[1]); w.y = cvt_pk_bf16(v0[2], v0[3]); w.z = cvt_pk_bf16(v1[0], v1[1]); w.w = cvt_pk_bf16(v1[2], v1[3]);
                    *(u32x4*)(O + off + bj * 128) = w; }
                if (m & 1) asm volatile("" ::: "memory"); }
    }
};

__device__ __forceinline__ float wave_sum_x(float v) {
#pragma unroll
    for (int o = 1; o < 64; o <<= 1) v += __shfl_xor(v, o);
    return v;
}
__device__ __forceinline__ void ln_regs_to_bf16(const u32x4 a, const u32x4 c, bf16_t* orow, const f32x4 (&gv)[4], const f32x4 (&bv)[4], int lane) {
    float v[16];
#pragma unroll
    for (int j = 0; j < 4; ++j) { v[2 * j] = __builtin_bit_cast(float, a[j] << 16); v[2 * j + 1] = __builtin_bit_cast(float, a[j] & 0xffff0000u); v[8 + 2 * j] = __builtin_bit_cast(float, c[j] << 16); v[8 + 2 * j + 1] = __builtin_bit_cast(float, c[j] & 0xffff0000u); }
    float sm = 0.f;
#pragma unroll
    for (int j = 0; j < 16; ++j) sm += v[j];
    const float mean = wave_sum_x(sm) * (1.f / D); float s2 = 0.f;
#pragma unroll
    for (int j = 0; j < 16; ++j) { v[j] -= mean; s2 += v[j] * v[j]; }
    const float rstd = 1.f / sqrtf(wave_sum_x(s2) * (1.f / D) + LN_EPS);
    u32x4 o[2];
#pragma unroll
    for (int j = 0; j < 4; ++j) { const f32x4 gg = gv[j], bb = bv[j];
        const float y0 = v[4 * j] * rstd * gg.x + bb.x, y1 = v[4 * j + 1] * rstd * gg.y + bb.y, y2 = v[4 * j + 2] * rstd * gg.z + bb.z, y3 = v[4 * j + 3] * rstd * gg.w + bb.w;
        o[j >> 1][(j & 1) * 2] = pk2(y0, y1); o[j >> 1][(j & 1) * 2 + 1] = pk2(y2, y3); }
    *(u32x4*)(orow + 16 * lane) = o[0]; *(u32x4*)(orow + 16 * lane + 8) = o[1];
}

constexpr int NWAVES = 8;
constexpr int RING_BYTES = 131072, MISC_OFF = RING_BYTES + 320, LDS_BYTES = 147456;
struct EpiLogits {
    static constexpr bool PERM = false;
    float* O;
    __device__ __forceinline__ void operator()(const f32x4 (&acc)[2][2][4][2], const pg8::Unit& u, int wr, int wc, int fr, int fq) const {
        int row0 = u.row0 + wr * 64 + fr, col0 = u.col0 + wc * 32 + 4 * fq;
        asm volatile("" : "+v"(row0), "+v"(col0));
#pragma unroll
        for (int ai = 0; ai < 2; ++ai)
#pragma unroll
            for (int m = 0; m < 4; ++m) { const size_t off = (size_t)(row0 + ai * 128 + m * 16) * NE + col0;
#pragma unroll
                for (int bj = 0; bj < 2; ++bj)
#pragma unroll
                    for (int n = 0; n < 2; ++n) *(f32x4*)(O + off + bj * 128 + n * 16) = acc[ai][bj][m][n]; }
    }
};
struct MoeTables { LAS int* tn; LAS int* es; LAS int* us; };
struct MoeUnits { LAS int* rec; LAS int* cnt; LAS unsigned short* tok; };
template <int NPN> struct MoeOrder {
    MoeTables tb; MoeUnits mu; const char* Abase; const char* Bbase; size_t strideE, stridePN; size_t apitch;
    int chunk; int colw;
    __device__ __forceinline__ bool next(int i, pg8::Unit& u) const {
        if (i >= __builtin_amdgcn_readfirstlane(mu.cnt[0])) return false;
        const int e = __builtin_amdgcn_readfirstlane(mu.rec[4 * i]), ti = __builtin_amdgcn_readfirstlane(mu.rec[4 * i + 1]), pn = __builtin_amdgcn_readfirstlane(mu.rec[4 * i + 2]);
        const int ne = __builtin_amdgcn_readfirstlane(tb.tn[e]), e0 = __builtin_amdgcn_readfirstlane(tb.es[e]);
        u.e = e; u.ti = ti; u.aux = pn; u.ord = i; u.row0 = e0 + ti * 256; u.nrows = (ne - ti * 256) < 256 ? (ne - ti * 256) : 256; u.col0 = pn * colw;
        u.A = Abase + (size_t)u.row0 * apitch; u.B = Bbase + (size_t)e * strideE + (size_t)pn * stridePN;
        return true;
    }
    __device__ __forceinline__ unsigned arow_off(const pg8::Unit& u, int r) const { return (unsigned)(chunk * CHT + (int)mu.tok[u.ord * 256 + r]) * (unsigned)(D * 2); }
};
template <int NPN, bool GATHER> __device__ __forceinline__ void moe_units(const MoeTables& tb, const MoeUnits& mu, int G, int c, int tid, const unsigned short* list, int chunk) {
    __syncthreads();
    const int NU = tb.us[257] * NPN;
    if (tid < 24) {
        const long L = (long)tid * G + c;
        if (L < NU) {
            int wgid = (int)L; { const int q = NU / 8, r = NU % 8, xcd = wgid % 8, off = wgid / 8; wgid = (xcd < r ? xcd * (q + 1) : r * (q + 1) + (xcd - r) * q) + off; }
            const int rt = wgid / NPN, pn = wgid % NPN;
            int lo = 0, hi = 257;
            while (hi - lo > 1) { const int mid = (lo + hi) >> 1; if (tb.us[mid] <= rt) lo = mid; else hi = mid; }
            mu.rec[4 * tid] = lo; mu.rec[4 * tid + 1] = rt - tb.us[lo]; mu.rec[4 * tid + 2] = pn;
        }
    }
    const int n = c < NU ? (NU - 1 - c) / G + 1 : 0;
    if (tid == 0) mu.cnt[0] = n < 24 ? n : 24;
    __syncthreads();
    if (GATHER) {
        const int nn = n < 16 ? n : 16;
        for (int x = tid; x < nn * 256; x += NWAVES * 64) { const int ui = x >> 8, r = x & 255, e = mu.rec[4 * ui], ti = mu.rec[4 * ui + 1];
            const int nr = tb.tn[e] - ti * 256, rr = r < nr ? r : nr - 1; int tl = ti * 256 + rr;
            if (e < 256) tl = (int)list[((size_t)chunk * 256 + e) * CHT + tl];
            mu.tok[x] = (unsigned short)tl; }
        __syncthreads();
    }
}
struct EpiGLU {
    static constexpr bool PERM = true;
    bf16_t* HB;
    __device__ __forceinline__ void operator()(const f32x4 (&acc)[2][2][4][2], const pg8::Unit& u, int wr, int wc, int fr, int fq) const {
        int rt0 = wr * 64 + fr, col0 = u.col0 + wc * 32 + 8 * fq;
        asm volatile("" : "+v"(rt0), "+v"(col0));
#pragma unroll
        for (int ai = 0; ai < 2; ++ai)
#pragma unroll
            for (int m = 0; m < 4; ++m) { int rt = rt0 + ai * 128 + m * 16;
                asm volatile("" : "+v"(rt));
                float v[8];
#pragma unroll
                for (int j = 0; j < 8; ++j) { const float g = acc[ai][0][m][j >> 2][j & 3], up = acc[ai][1][m][j >> 2][j & 3];
                    v[j] = g * __builtin_amdgcn_rcpf(1.0f + __builtin_amdgcn_exp2f(-1.4426950408889634f * g)) * up; }
                u32x4 w; w.x = cvt_pk_bf16(v[0], v[1]); w.y = cvt_pk_bf16(v[2], v[3]); w.z = cvt_pk_bf16(v[4], v[5]); w.w = cvt_pk_bf16(v[6], v[7]);
                if (rt < u.nrows) *(u32x4*)(HB + (size_t)(u.row0 + rt) * EH + col0) = w; }
    }
};
struct EpiDown {
    static constexpr int PERM = 2;
    unsigned char* Y8; bf16_t* YS; const bf16_t* H1; int chunk;
    __device__ __forceinline__ void operator()(const f32x4 (&acc)[2][2][4][2], const pg8::Unit& u, int wr, int wc, int fr, int fq) const {
        int rt0 = wr * 64 + fr, col0 = u.col0 + wc * 64 + 16 * fq;
        asm volatile("" : "+v"(rt0), "+v"(col0));
        const bool shared = u.e == 256;
#pragma unroll
        for (int ai = 0; ai < 2; ++ai)
#pragma unroll
            for (int m = 0; m < 4; ++m) { int rt = rt0 + ai * 128 + m * 16;
                asm volatile("" : "+v"(rt));
                if (rt < u.nrows) {
                    float v[16];
#pragma unroll
                    for (int j = 0; j < 16; ++j) v[j] = acc[ai][j >> 3][m][(j >> 2) & 1][j & 3];
                    if (shared) { const bf16_t* hp = H1 + (size_t)(chunk * CHT + u.ti * 256 + rt) * D + col0; const u32x4 h0 = *(const u32x4*)hp, h1 = *(const u32x4*)(hp + 8);
#pragma unroll
                        for (int j = 0; j < 4; ++j) { v[2 * j] += DN_ALPHA * __builtin_bit_cast(float, h0[j] << 16); v[2 * j + 1] += DN_ALPHA * __builtin_bit_cast(float, h0[j] & 0xffff0000u);
                            v[8 + 2 * j] += DN_ALPHA * __builtin_bit_cast(float, h1[j] << 16); v[8 + 2 * j + 1] += DN_ALPHA * __builtin_bit_cast(float, h1[j] & 0xffff0000u); }
                        u32x4 w0, w1; w0.x = cvt_pk_bf16(v[0], v[1]); w0.y = cvt_pk_bf16(v[2], v[3]); w0.z = cvt_pk_bf16(v[4], v[5]); w0.w = cvt_pk_bf16(v[6], v[7]);
                        w1.x = cvt_pk_bf16(v[8], v[9]); w1.y = cvt_pk_bf16(v[10], v[11]); w1.z = cvt_pk_bf16(v[12], v[13]); w1.w = cvt_pk_bf16(v[14], v[15]);
                        bf16_t* yp = YS + (size_t)(u.ti * 256 + rt) * D + col0; *(u32x4*)yp = w0; *(u32x4*)(yp + 8) = w1;
                    } else { int w[4] = {0, 0, 0, 0};
#pragma unroll
                        for (int d = 0; d < 4; ++d) { w[d] = __builtin_amdgcn_cvt_pk_fp8_f32(v[4 * d] * 16.f, v[4 * d + 1] * 16.f, w[d], false); w[d] = __builtin_amdgcn_cvt_pk_fp8_f32(v[4 * d + 2] * 16.f, v[4 * d + 3] * 16.f, w[d], true); }
                        u32x4 ww; ww.x = (unsigned)w[0]; ww.y = (unsigned)w[1]; ww.z = (unsigned)w[2]; ww.w = (unsigned)w[3];
                        *(u32x4*)(Y8 + (size_t)(u.row0 + rt) * D + col0) = ww; } }
                asm volatile("" ::: "memory"); }
    }
};

constexpr size_t WS_W1T = 15 * MiB;
constexpr size_t WS_W2T = 16 * MiB;
constexpr size_t WS_C1 = 16 * MiB + 65536;
namespace att {
constexpr float LOG2E = 1.4426950408889634f;
constexpr float C2 = 0.125f * LOG2E;
constexpr float THR = 8.0f;
constexpr int NB = 2;
constexpr int L_KV = 0, L_IMP = 65536, L_SELM = 98304, L_UW = 99584, L_JL = 99616, L_BIAS = 99840, L_HID = 108288, L_END = 112640;
constexpr int MODE_C1 = 0, MODE_C2 = 1, MODE_SEL = 2, MODE_WIN = 3, MODE_SWA = 4;
struct Ctx {
    LAS unsigned char* lds; int tid, lane, wave;
    const bf16_t* qkv_b;
    const bf16_t* kc; const bf16_t* vc;
    int cur, g;
};
__device__ __forceinline__ float ex2(float x) { return __builtin_amdgcn_exp2f(x); }
__device__ __forceinline__ float colmax4(float x) { x = fmaxf(x, __shfl_xor(x, 16)); return fmaxf(x, __shfl_xor(x, 32)); }
__device__ __forceinline__ float col_sum4(float x) { x += __shfl_xor(x, 16); return x + __shfl_xor(x, 32); }
__device__ __forceinline__ float quad_sum(float x) {
    x += __builtin_bit_cast(float, __builtin_amdgcn_update_dpp(0u, __builtin_bit_cast(unsigned, x), 0xB1, 0xF, 0xF, true));
    x += __builtin_bit_cast(float, __builtin_amdgcn_update_dpp(0u, __builtin_bit_cast(unsigned, x), 0x4E, 0xF, 0xF, true));
    return x;
}
__device__ __forceinline__ void glds16(const void* gsrc, unsigned lds_dst) { unsigned keep;
    asm volatile("s_mov_b32 %0, m0\n\ts_mov_b32 m0, %2\n\ts_nop 0\n\tglobal_load_lds_dwordx4 %1, off\n\ts_mov_b32 m0, %0" : "=&s"(keep) : "v"(gsrc), "s"(lds_dst) : "memory"); }
template <int MODE> __device__ __forceinline__ void blk_dma(const Ctx& c, int j, int slot) {
    const int key = c.tid >> 3, chs = c.tid & 7;
    const int kch = chs ^ (key & 7), vch = chs ^ (((key >> 1) & 3) << 1);
    const unsigned dst = (unsigned)__builtin_amdgcn_readfirstlane((int)(unsigned)(uintptr_t)(c.lds + L_KV + slot * 16384 + c.wave * 1024));
    if (MODE <= MODE_C2) { const size_t o = (size_t)(64 * j + key) * 128;
        glds16(c.kc + o + kch * 8, dst);
        if (MODE == MODE_C2) glds16(c.vc + o + vch * 8, dst + 8192u);
    } else { constexpr int KC = MODE == MODE_SEL ? C_KS : (MODE == MODE_WIN ? C_KW : C_KB), VC = MODE == MODE_SEL ? C_VS : (MODE == MODE_WIN ? C_VW : C_VB);
        const bf16_t* rp = c.qkv_b + (size_t)(64 * j + key) * QP + c.g * 64;
        glds16(rp + KC + kch * 8, dst);
        glds16(rp + VC + vch * 8, dst + 8192u); }
}
struct NoDma { __device__ __forceinline__ void operator()(int) const {} };
template <int MODE, bool PRE = false, class NextDma = NoDma> __device__ __forceinline__ void branch(const Ctx& c, const bf16x8 (&Qf)[2][2], f32x4 (&O)[2][4], float (&m)[2], float (&l)[2], const float (&invl)[2], int nblk, int j0, int hh, int par = 0, NextDma nextdma = NoDma()) {
    const int lane = c.lane, q = lane >> 4, cc = lane & 15;
    const LAS unsigned char* jl = c.lds + L_JL;
    const LAS float* biasL = (const LAS float*)(c.lds + L_BIAS) + hh * 132;
    LAS float* impL = (LAS float*)(c.lds + L_IMP);
    const LAS unsigned* selm = (const LAS unsigned*)(c.lds + L_SELM);
    const float c31 = biasL[128];
    const int nstage = (nblk + NB - 1) / NB;
    if (!PRE) {
#pragma unroll
        for (int bi = 0; bi < NB; ++bi) if (bi < nblk) blk_dma<MODE>(c, (MODE == MODE_SEL) ? (int)jl[bi] : j0 + bi, par * NB + bi);
    }
    asm volatile("s_waitcnt vmcnt(0)" ::: "memory");
    __syncthreads();
    const int kaddr0 = cc * 128 + (((0 + q) ^ (lane & 7)) << 4), kaddr1 = cc * 128 + (((4 + q) ^ (lane & 7)) << 4);
    const int vsw = ((2 * q + (cc >> 3)) & 3) << 1, vkey = (4 * q + (cc >> 2)) * 128, vb = (cc & 3) >> 1, vwi = (cc & 1) * 8;
    for (int st = 0; st < nstage; ++st) {
        if (st + 1 < nstage) {
#pragma unroll
            for (int bi = 0; bi < NB; ++bi) { const int i2 = (st + 1) * NB + bi; if (i2 < nblk) blk_dma<MODE>(c, (MODE == MODE_SEL) ? (int)jl[i2] : j0 + i2, ((st + 1 + par) & 1) * NB + bi); }
        } else nextdma((st + 1 + par) & 1);
#pragma unroll
        for (int bi = 0; bi < NB; ++bi) {
            const int i = st * NB + bi;
            if (i >= nblk) break;
            const int j = (MODE == MODE_SEL) ? (int)jl[i] : j0 + i;
            const LAS unsigned char* Kb = c.lds + L_KV + (((st + par) & 1) * NB + bi) * 16384;
            const LAS unsigned char* Vb = Kb + 8192;
            const int back = c.cur - j;
            bool far;
            if (MODE <= MODE_C2) far = !(64 * (j + 1) > 4 * c.cur - 10);
            else far = back >= 3 && !(MODE == MODE_WIN && back == 8);
            bool act[2] = {true, true}, own[2] = {true, true};
            if (MODE == MODE_SEL) {
#pragma unroll
                for (int a = 0; a < 2; ++a) { const unsigned uw = selm[256 + (2 * c.wave + a) * 4 + (j >> 5)];
                    act[a] = __builtin_amdgcn_readfirstlane((uw >> (j & 31)) & 1u) != 0;
                    own[a] = (selm[(8 * c.wave + 4 * a + (cc >> 2)) * 4 + (j >> 5)] >> (j & 31)) & 1u; }
                if (!act[0] && !act[1]) continue;
            }
            bf16x8 Kf[4][2];
#pragma unroll
            for (int kt = 0; kt < 4; ++kt) { Kf[kt][0] = *(const LAS bf16x8*)(Kb + kt * 2048 + kaddr0); Kf[kt][1] = *(const LAS bf16x8*)(Kb + kt * 2048 + kaddr1); }
            f32x4 s[2][4];
#pragma unroll
            for (int a = 0; a < 2; ++a) {
                if (!act[a]) continue;
#pragma unroll
                for (int kt = 0; kt < 4; ++kt) {
                    s[a][kt] = __builtin_amdgcn_mfma_f32_16x16x32_bf16(Kf[kt][0], Qf[a][0], (f32x4){0.f, 0.f, 0.f, 0.f}, 0, 0, 0);
                    s[a][kt] = __builtin_amdgcn_mfma_f32_16x16x32_bf16(Kf[kt][1], Qf[a][1], s[a][kt], 0, 0, 0);
                }
            }
            bf16x8 Vf[4][2];
            if (MODE != MODE_C1) {
#pragma unroll
                for (int mt = 0; mt < 4; ++mt) { const int va = vkey + ((((2 * mt) ^ vsw) + vb) << 4) + vwi;
#pragma unroll
                    for (int k2 = 0; k2 < 2; ++k2) {
                        const v4i16_t lo = __builtin_amdgcn_ds_read_tr16_b64_v4i16((LAS v4i16_t*)(Vb + (2 * k2) * 2048 + va));
                        const v4i16_t hi = __builtin_amdgcn_ds_read_tr16_b64_v4i16((LAS v4i16_t*)(Vb + (2 * k2 + 1) * 2048 + va));
                        Vf[mt][k2] = (bf16x8){lo[0], lo[1], lo[2], lo[3], hi[0], hi[1], hi[2], hi[3]}; } }
            }
#pragma unroll
            for (int a = 0; a < 2; ++a) {
                if (!act[a]) continue;
                const int tl = 8 * c.wave + 4 * a + (cc >> 2);
                if (far) {
                    const float cb = own[a] ? c31 : -INFINITY;
#pragma unroll
                    for (int kt = 0; kt < 4; ++kt)
#pragma unroll
                        for (int r = 0; r < 4; ++r) s[a][kt][r] = fmaf(s[a][kt][r], C2, cb);
                } else if (MODE <= MODE_C2) {
                    const int dd0 = 64 * c.cur + tl - 1024 * j - 31;
#pragma unroll
                    for (int kt = 0; kt < 4; ++kt)
#pragma unroll
                        for (int r = 0; r < 4; ++r) { const int d = dd0 - 16 * (16 * kt + 4 * q + r);
                            s[a][kt][r] = fmaf(s[a][kt][r], C2, biasL[d < 0 ? 0 : (d > 128 ? 128 : d)]) + (d >= 0 ? 0.f : -INFINITY); }
                } else {
                    const int dd0 = 64 * back + tl;
                    const int hi_lim = (MODE == MODE_WIN) ? 512 : (MODE == MODE_SWA ? 128 : (1 << 30));
#pragma unroll
                    for (int kt = 0; kt < 4; ++kt)
#pragma unroll
                        for (int r = 0; r < 4; ++r) { const int d = dd0 - (16 * kt + 4 * q + r);
                            s[a][kt][r] = fmaf(s[a][kt][r], C2, biasL[d < 0 ? 0 : (d > 128 ? 128 : d)]) + (((unsigned)d < (unsigned)hi_lim && own[a]) ? 0.f : -INFINITY); }
                }
                if (MODE != MODE_C2) {
                    float bm = fmaxf(fmaxf(fmaxf(s[a][0][0], s[a][0][1]), fmaxf(s[a][0][2], s[a][0][3])), fmaxf(fmaxf(s[a][1][0], s[a][1][1]), fmaxf(s[a][1][2], s[a][1][3])));
                    bm = fmaxf(bm, fmaxf(fmaxf(fmaxf(s[a][2][0], s[a][2][1]), fmaxf(s[a][2][2], s[a][2][3])), fmaxf(fmaxf(s[a][3][0], s[a][3][1]), fmaxf(s[a][3][2], s[a][3][3]))));
                    if (__any(bm > m[a] + THR)) {
                        bm = colmax4(bm);
                        const float mn = fmaxf(m[a], bm);
                        const float alpha = (mn == m[a]) ? 1.0f : ex2(m[a] - mn);
                        m[a] = mn; l[a] *= alpha;
                        if (MODE != MODE_C1) {
#pragma unroll
                            for (int mt = 0; mt < 4; ++mt) O[a][mt] = O[a][mt] * alpha;
                        }
                    }
                }
                const float mu = (m[a] == -INFINITY) ? 0.f : m[a];
                float ps = 0.f;
#pragma unroll
                for (int kt = 0; kt < 4; ++kt)
#pragma unroll
                    for (int r = 0; r < 4; ++r) { float p = ex2(s[a][kt][r] - mu); if (MODE == MODE_C2) p *= invl[a]; s[a][kt][r] = p; ps += p; }
                l[a] += ps;
                if (MODE == MODE_C2) {
#pragma unroll
                    for (int kt = 0; kt < 4; ++kt) {
                        const float s4 = quad_sum((s[a][kt][0] + s[a][kt][1]) + (s[a][kt][2] + s[a][kt][3])), lastv = quad_sum(s[a][kt][3]);
                        const int jp = 16 * j + 4 * kt + q;
                        if ((cc & 3) == 0) { __hip_atomic_fetch_add(impL + tl * 128 + jp, s4, __ATOMIC_RELAXED, __HIP_MEMORY_SCOPE_WORKGROUP);
                            if (jp < 127) __hip_atomic_fetch_add(impL + tl * 128 + jp + 1, lastv, __ATOMIC_RELAXED, __HIP_MEMORY_SCOPE_WORKGROUP); }
                    }
                }
            }
            if (MODE == MODE_C1) continue;
#pragma unroll
            for (int a = 0; a < 2; ++a) {
                if (!act[a]) continue;
                bf16x8 Pf[2];
#pragma unroll
                for (int k2 = 0; k2 < 2; ++k2) { u32x4 w; w.x = cvt_pk_bf16(s[a][2 * k2][0], s[a][2 * k2][1]); w.y = cvt_pk_bf16(s[a][2 * k2][2], s[a][2 * k2][3]); w.z = cvt_pk_bf16(s[a][2 * k2 + 1][0], s[a][2 * k2 + 1][1]); w.w = cvt_pk_bf16(s[a][2 * k2 + 1][2], s[a][2 * k2 + 1][3]);
                    Pf[k2] = __builtin_bit_cast(bf16x8, w); }
#pragma unroll
                for (int mt = 0; mt < 4; ++mt)
#pragma unroll
                    for (int k2 = 0; k2 < 2; ++k2) O[a][mt] = __builtin_amdgcn_mfma_f32_16x16x32_bf16(Vf[mt][k2], Pf[k2], O[a][mt], 0, 0, 0);
            }
        }
        asm volatile("s_waitcnt vmcnt(0)" ::: "memory");
        __syncthreads();
    }
}
__device__ __forceinline__ void clearO(f32x4 (&O)[2][4], float (&m)[2], float (&l)[2], float m0) {
#pragma unroll
    for (int a = 0; a < 2; ++a) { m[a] = m0; l[a] = 0.f;
#pragma unroll
        for (int mt = 0; mt < 4; ++mt) O[a][mt] = (f32x4){0.f, 0.f, 0.f, 0.f}; }
}

__device__ __forceinline__ void store_orow(bf16_t* obase, int q, const u32x2 (&w)[4]) {
#pragma unroll
    for (int p = 0; p < 2; ++p) { u32x2 a = w[2 * p], b = w[2 * p + 1];
        const auto r0 = __builtin_amdgcn_permlane16_swap(a.x, b.x, false, false); a.x = r0[0]; b.x = r0[1];
        const auto r1 = __builtin_amdgcn_permlane16_swap(a.y, b.y, false, false); a.y = r1[0]; b.y = r1[1];
        u32x4 v; v.x = a.x; v.y = a.y; v.z = b.x; v.w = b.y;
        *(u32x4*)(obase + 16 * (2 * p + (q & 1)) + 8 * (q >> 1)) = v; }
}
__device__ __forceinline__ void unit(LAS unsigned char* lds, int tid, int lane, int wave, const bf16_t* qkvg, const bf16_t* kcmp, const bf16_t* vcmp, const float* sinks, bf16_t* oab, int b, int g, int cur) {
    Ctx c; c.lds = lds; c.tid = tid; c.lane = lane; c.wave = wave; c.qkv_b = qkvg + (size_t)b * S * QP; c.kc = kcmp + (size_t)b * 512 * 128 + g * 64; c.vc = vcmp + (size_t)b * 512 * 128 + g * 64; c.cur = cur; c.g = g;
    const int q = lane >> 4, cc = lane & 15, hr = cc & 3, hA = g * 4 + hr;
    const int t0 = 64 * cur;
    LAS unsigned* selm = (LAS unsigned*)(lds + L_SELM); LAS unsigned* uwp = (LAS unsigned*)(lds + L_UW); LAS unsigned char* jl = lds + L_JL;
    LAS float* impL = (LAS float*)(lds + L_IMP);
    bf16x8 Qf[2][2];
    f32x4 O[2][4]; float m[2], l[2], invl[2] = {1.f, 1.f};
    LAS u32x2* stash = (LAS u32x2*)(lds + L_IMP) + wave * 512 + lane;
#pragma unroll
    for (int a = 0; a < 2; ++a) { const bf16_t* qrow = c.qkv_b + (size_t)(t0 + 8 * wave + 4 * a + (cc >> 2)) * QP;
        Qf[a][0] = *(const bf16x8*)(qrow + C_QA + hA * 64 + 8 * q); Qf[a][1] = *(const bf16x8*)(qrow + C_QA + hA * 64 + 32 + 8 * q); }
    { const u32x4 z = {0u, 0u, 0u, 0u};
#pragma unroll
      for (int i = 0; i < 4; ++i) *(LAS u32x4*)(lds + L_IMP + (i * 512 + tid) * 16) = z; }
    const int nbc = (4 * cur + 3 + 63) >> 6;
    clearO(O, m, l, -INFINITY);
    const int nstc = (nbc + NB - 1) / NB;
    branch<MODE_C1>(c, Qf, O, m, l, invl, nbc, 0, hA, 0, [&](int p) {
#pragma unroll
        for (int bi = 0; bi < NB; ++bi) if (bi < nbc) blk_dma<MODE_C2>(c, bi, p * NB + bi); });
#pragma unroll
    for (int a = 0; a < 2; ++a) invl[a] = 1.0f / fmaxf(col_sum4(l[a]), 1e-30f);
    branch<MODE_C2, true>(c, Qf, O, m, l, invl, nbc, 0, hA, nstc & 1);
    {
        unsigned long long un_lo[2] = {0ull, 0ull}, un_hi[2] = {0ull, 0ull};
        for (int i = 0; i < 8; ++i) {
            const int tok = 8 * wave + i;
            unsigned long long mlo, mhi = 0ull;
            if (cur <= 7) mlo = (2ull << cur) - 1ull;
            else {
                mlo = 1ull;
                if (cur - 1 < 64) mlo |= 1ull << (cur - 1); else mhi |= 1ull << (cur - 65);
                if (cur < 64) mlo |= 1ull << cur; else mhi |= 1ull << (cur - 64);
                const bool ok0 = lane >= 1 && lane <= cur - 2, ok1 = lane + 64 <= cur - 2;
                const unsigned k0 = ok0 ? __builtin_bit_cast(unsigned, impL[tok * 128 + lane]) + 1u : 0u;
                const unsigned k1 = ok1 ? __builtin_bit_cast(unsigned, impL[tok * 128 + 64 + lane]) + 1u : 0u;
                unsigned T = 0u;
                for (int bit = 31; bit >= 8; --bit) { const unsigned cand = T | (1u << bit);
                    const int cnt = __popcll(__ballot(k0 >= cand)) + __popcll(__ballot(k1 >= cand));
                    if (cnt >= 5) T = cand; }
                unsigned long long G0 = __ballot(k0 >= T), G1 = __ballot(k1 >= T), S0 = 0ull, S1 = 0ull;
                if (__popcll(G0) + __popcll(G1) != 5) {
                    for (int bit = 7; bit >= 0; --bit) { const unsigned cand = T | (1u << bit);
                        const int cnt = __popcll(__ballot(k0 >= cand)) + __popcll(__ballot(k1 >= cand));
                        if (cnt >= 5) T = cand; }
                    G0 = __ballot(k0 > T); G1 = __ballot(k1 > T);
                    unsigned long long E0 = __ballot(k0 == T), E1 = __ballot(k1 == T);
                    int need = 5 - (__popcll(G0) + __popcll(G1));
                    while (need > 0 && E0) { const unsigned long long b_ = E0 & (0ull - E0); S0 |= b_; E0 ^= b_; --need; }
                    while (need > 0 && E1) { const unsigned long long b_ = E1 & (0ull - E1); S1 |= b_; E1 ^= b_; --need; }
                }
                mlo |= G0 | S0; mhi |= G1 | S1;
            }
            if (lane == 0) { selm[tok * 4 + 0] = (unsigned)mlo; selm[tok * 4 + 1] = (unsigned)(mlo >> 32); selm[tok * 4 + 2] = (unsigned)mhi; selm[tok * 4 + 3] = (unsigned)(mhi >> 32); }
            un_lo[i >> 2] |= mlo; un_hi[i >> 2] |= mhi;
        }
        if (lane == 0) {
#pragma unroll
            for (int a = 0; a < 2; ++a) { LAS unsigned* up = selm + 256 + (2 * wave + a) * 4; up[0] = (unsigned)un_lo[a]; up[1] = (unsigned)(un_lo[a] >> 32); up[2] = (unsigned)un_hi[a]; up[3] = (unsigned)(un_hi[a] >> 32); }
        }
    }
    __syncthreads();
    if (wave == 0) {
        unsigned long long ulo = 0ull, uhi = 0ull;
#pragma unroll
        for (int k = 0; k < 16; ++k) { ulo |= (unsigned long long)selm[256 + 4 * k] | ((unsigned long long)selm[256 + 4 * k + 1] << 32); uhi |= (unsigned long long)selm[256 + 4 * k + 2] | ((unsigned long long)selm[256 + 4 * k + 3] << 32); }
        const unsigned long long below = (1ull << lane) - 1ull;
        const int nlo = __popcll(ulo);
        if ((ulo >> lane) & 1ull) jl[__popcll(ulo & below)] = (unsigned char)lane;
        if ((uhi >> lane) & 1ull) jl[nlo + __popcll(uhi & below)] = (unsigned char)(64 + lane);
        if (lane == 0) uwp[4] = (unsigned)(nlo + __popcll(uhi));
    }
    __syncthreads();
    const int nsel = __builtin_amdgcn_readfirstlane((int)uwp[4]);
#pragma unroll
    for (int a = 0; a < 2; ++a) { const float sc = 1.0f / (1.0f + ex2(-LOG2E * bf2f(c.qkv_b[(size_t)(t0 + 8 * wave + 4 * a + (cc >> 2)) * QP + C_GA + hA * 3 + 0])));
#pragma unroll
        for (int mt = 0; mt < 4; ++mt) { const f32x4 o = O[a][mt] * sc; u32x2 w; w.x = cvt_pk_bf16(o[0], o[1]); w.y = cvt_pk_bf16(o[2], o[3]); stash[(a * 4 + mt) * 64] = w; } }
    clearO(O, m, l, -INFINITY);
    const int jw0 = cur >= 8 ? cur - 8 : 0, nwin = cur - jw0 + 1, jb0 = cur >= 2 ? cur - 2 : 0, nswa = cur - jb0 + 1;
    const int pwin = ((nsel + NB - 1) / NB) & 1, pswa = (pwin + (nwin + NB - 1) / NB) & 1;
    branch<MODE_SEL>(c, Qf, O, m, l, invl, nsel, 0, hA, 0, [&](int p) {
#pragma unroll
        for (int bi = 0; bi < NB; ++bi) if (bi < nwin) blk_dma<MODE_WIN>(c, jw0 + bi, p * NB + bi); });
#pragma unroll
    for (int a = 0; a < 2; ++a) { const float sc = (1.0f / (1.0f + ex2(-LOG2E * bf2f(c.qkv_b[(size_t)(t0 + 8 * wave + 4 * a + (cc >> 2)) * QP + C_GA + hA * 3 + 1])))) / fmaxf(col_sum4(l[a]), 1e-30f);
#pragma unroll
        for (int mt = 0; mt < 4; ++mt) { const u32x2 pv = stash[(a * 4 + mt) * 64]; f32x4 o = O[a][mt] * sc;
            o[0] += __builtin_bit_cast(float, pv.x << 16); o[1] += __builtin_bit_cast(float, pv.x & 0xffff0000u); o[2] += __builtin_bit_cast(float, pv.y << 16); o[3] += __builtin_bit_cast(float, pv.y & 0xffff0000u);
            u32x2 w; w.x = cvt_pk_bf16(o[0], o[1]); w.y = cvt_pk_bf16(o[2], o[3]); stash[(a * 4 + mt) * 64] = w; } }
    clearO(O, m, l, -INFINITY);
    branch<MODE_WIN, true>(c, Qf, O, m, l, invl, nwin, jw0, hA, pwin, [&](int p) {
#pragma unroll
        for (int bi = 0; bi < NB; ++bi) if (bi < nswa) blk_dma<MODE_SWA>(c, jb0 + bi, p * NB + bi); });
#pragma unroll
    for (int a = 0; a < 2; ++a) { const float sc = (1.0f / (1.0f + ex2(-LOG2E * bf2f(c.qkv_b[(size_t)(t0 + 8 * wave + 4 * a + (cc >> 2)) * QP + C_GA + hA * 3 + 2])))) / fmaxf(col_sum4(l[a]), 1e-30f);
        bf16_t* orow = oab + (size_t)(b * S + t0 + 8 * wave + 4 * a + (cc >> 2)) * D + hA * 64;
        u32x2 w[4];
#pragma unroll
        for (int mt = 0; mt < 4; ++mt) { const u32x2 pv = stash[(a * 4 + mt) * 64]; f32x4 o = O[a][mt] * sc;
            o[0] += __builtin_bit_cast(float, pv.x << 16); o[1] += __builtin_bit_cast(float, pv.x & 0xffff0000u); o[2] += __builtin_bit_cast(float, pv.y << 16); o[3] += __builtin_bit_cast(float, pv.y & 0xffff0000u);
            w[mt].x = cvt_pk_bf16(o[0], o[1]); w[mt].y = cvt_pk_bf16(o[2], o[3]); }
        store_orow(orow, q, w); }
    const float sk2 = sinks[hA] * LOG2E;
#pragma unroll
    for (int a = 0; a < 2; ++a) { const bf16_t* qrow = c.qkv_b + (size_t)(t0 + 8 * wave + 4 * a + (cc >> 2)) * QP;
        Qf[a][0] = *(const bf16x8*)(qrow + C_QB + hA * 64 + 8 * q); Qf[a][1] = *(const bf16x8*)(qrow + C_QB + hA * 64 + 32 + 8 * q); }
    clearO(O, m, l, sk2);
    branch<MODE_SWA, true>(c, Qf, O, m, l, invl, nswa, jb0, 8 + hA, pswa);
#pragma unroll
    for (int a = 0; a < 2; ++a) { const float sc = 1.0f / (col_sum4(l[a]) + ex2(sk2 - m[a]));
        bf16_t* orow = oab + (size_t)(b * S + t0 + 8 * wave + 4 * a + (cc >> 2)) * D + 512 + hA * 64;
        u32x2 w[4];
#pragma unroll
        for (int mt = 0; mt < 4; ++mt) { const f32x4 o = O[a][mt] * sc; w[mt].x = cvt_pk_bf16(o[0], o[1]); w[mt].y = cvt_pk_bf16(o[2], o[3]); }
        store_orow(orow, q, w); }
}

constexpr int CMP_PITCH = 144, CMP_NCH = 272 * 8;
__device__ __forceinline__ void compress_load(const bf16_t* qkvg, int u, int tid, u32x4 (&r)[5]) {
    const int nt = u & 31, g = (u >> 5) & 1, b = (u >> 6) & 7, which = u >> 9;
    const bf16_t* base = qkvg + (size_t)(b * S) * QP + (which ? C_VC : C_KC) + g * 64;
#pragma unroll
    for (int i = 0; i < 5; ++i) { int c = tid + 512 * i; c = c < CMP_NCH ? c : CMP_NCH - 1; int tok = 256 * nt + (c >> 3); tok = tok < S ? tok : S - 1;
        r[i] = *(const u32x4*)(base + (size_t)tok * QP + (c & 7) * 8); }
}
__device__ __forceinline__ void compress_stage(LAS unsigned char* lds, int tid, const u32x4 (&r)[5]) {
#pragma unroll
    for (int i = 0; i < 5; ++i) { const int c = tid + 512 * i; const int tr = c >> 3;
        if (c < CMP_NCH) *(LAS u32x4*)(lds + L_KV + ((tr & 15) * 17 + (tr >> 4)) * CMP_PITCH + (c & 7) * 16) = r[i]; }
}
__device__ __forceinline__ void compress_unit(LAS unsigned char* lds, int lane, int wave, const bf16_t* W1T, const bf16_t* W2T, const float* c1, bf16_t* kcmp, bf16_t* vcmp, int u) {
    const int nt = u & 31, g = (u >> 5) & 1, b = (u >> 6) & 7, which = u >> 9, n0 = 16 * nt;
    const int mrow = lane & 15, q = lane >> 4;
    const int n = n0 + mrow, mcl = n > 510 ? mrow - 1 : mrow;
    const LAS unsigned char* arow = lds + L_KV + mcl * CMP_PITCH + 16 * q;
    const bf16_t* brow = W1T + ((size_t)which * 128 + 16 * wave + mrow) * 2048 + 8 * q;
    f32x4 acc = {0.f, 0.f, 0.f, 0.f};
#pragma unroll 16
    for (int ks = 0; ks < 64; ++ks) {
        const bf16x8 a = *(const LAS bf16x8*)(arow + (((ks >> 1) & 15) * 17 + (ks >> 5)) * CMP_PITCH + 64 * (ks & 1));
        const bf16x8 w = *(const bf16x8*)(brow + 32 * ks);
        acc = __builtin_amdgcn_mfma_f32_16x16x32_bf16(w, a, acc, 0, 0, 0);
    }
    LAS bf16_t* hid = (LAS bf16_t*)(lds + L_HID);
    { const f32x4 cb = *(const f32x4*)(c1 + which * 128 + 16 * wave + 4 * q); float hv[4];
#pragma unroll
      for (int r = 0; r < 4; ++r) { const float xx = acc[r] + cb[r]; const float y = 0.7978845608028654f * (xx + 0.044715f * xx * xx * xx);
          const float th = 1.0f - 2.0f / (1.0f + ex2(2.0f * LOG2E * y)); hv[r] = 0.5f * xx * (1.0f + th); }
      u32x2 w; w.x = cvt_pk_bf16(hv[0], hv[1]); w.y = cvt_pk_bf16(hv[2], hv[3]);
      *(LAS u32x2*)(hid + mrow * 136 + 16 * wave + 4 * q) = w; }
    __syncthreads();
    if (wave < 4) {
        f32x4 acc2 = {0.f, 0.f, 0.f, 0.f};
        const bf16_t* w2row = W2T + ((size_t)which * 64 + 16 * wave + mrow) * 128 + 8 * q;
#pragma unroll
        for (int ks = 0; ks < 4; ++ks) {
            const bf16x8 hfr = *(const LAS bf16x8*)(hid + mrow * 136 + 32 * ks + 8 * q);
            const bf16x8 w = *(const bf16x8*)(w2row + 32 * ks);
            acc2 = __builtin_amdgcn_mfma_f32_16x16x32_bf16(w, hfr, acc2, 0, 0, 0);
        }
        u32x2 w; w.x = cvt_pk_bf16(acc2[0], acc2[1]); w.y = cvt_pk_bf16(acc2[2], acc2[3]);
        if (n > 510) { w.x = 0u; w.y = 0u; }
        *(u32x2*)((which ? vcmp : kcmp) + ((size_t)(b * 512 + n) * 2 + g) * 64 + 16 * wave + 4 * q) = w;
    }
    __syncthreads();
}
constexpr int CMP_R1 = 40960, L_HID2 = L_END;
__device__ __forceinline__ void compress_stage1(LAS unsigned char* lds, int tid, const u32x4 (&r)[5]) {
#pragma unroll
    for (int i = 0; i < 5; ++i) { const int c = tid + 512 * i; const int tr = c >> 3;
        if (c < CMP_NCH) *(LAS u32x4*)(lds + L_KV + CMP_R1 + ((tr & 15) * 17 + (tr >> 4)) * CMP_PITCH + (c & 7) * 16) = r[i]; }
}
__device__ __forceinline__ void compress_unit2(LAS unsigned char* lds, int lane, int wave, const bf16_t* W1T, const bf16_t* W2T, const float* c1, bf16_t* kcmp, bf16_t* vcmp, int u) {
    const int nt = u & 31, g = (u >> 5) & 1, b = (u >> 6) & 7, which = u >> 9, n0 = 16 * nt;
    const int mrow = lane & 15, q = lane >> 4;
    const int n = n0 + mrow, mcl = n > 510 ? mrow - 1 : mrow;
    const LAS unsigned char* arow = lds + L_KV + mcl * CMP_PITCH + 16 * q;
    const bf16_t* brow = W1T + ((size_t)which * 128 + 16 * wave + mrow) * 2048 + 8 * q;
    f32x4 acc0 = {0.f, 0.f, 0.f, 0.f}, acc1 = {0.f, 0.f, 0.f, 0.f};
#pragma unroll 16
    for (int ks = 0; ks < 64; ++ks) {
        const int ao = (((ks >> 1) & 15) * 17 + (ks >> 5)) * CMP_PITCH + 64 * (ks & 1);
        const bf16x8 a0 = *(const LAS bf16x8*)(arow + ao), a1 = *(const LAS bf16x8*)(arow + CMP_R1 + ao);
        const bf16x8 w = *(const bf16x8*)(brow + 32 * ks);
        acc0 = __builtin_amdgcn_mfma_f32_16x16x32_bf16(w, a0, acc0, 0, 0, 0);
        acc1 = __builtin_amdgcn_mfma_f32_16x16x32_bf16(w, a1, acc1, 0, 0, 0);
    }
    { const f32x4 cb = *(const f32x4*)(c1 + which * 128 + 16 * wave + 4 * q);
#pragma unroll
      for (int h = 0; h < 2; ++h) { float hv[4];
#pragma unroll
          for (int r = 0; r < 4; ++r) { const float xx = (h ? acc1[r] : acc0[r]) + cb[r]; const float y = 0.7978845608028654f * (xx + 0.044715f * xx * xx * xx);
              const float th = 1.0f - 2.0f / (1.0f + ex2(2.0f * LOG2E * y)); hv[r] = 0.5f * xx * (1.0f + th); }
          u32x2 w; w.x = cvt_pk_bf16(hv[0], hv[1]); w.y = cvt_pk_bf16(hv[2], hv[3]);
          *(LAS u32x2*)((LAS bf16_t*)(lds + (h ? L_HID2 : L_HID)) + mrow * 136 + 16 * wave + 4 * q) = w; } }
    __syncthreads();
    {   const int h = wave >> 2, w4 = wave & 3;
        const LAS bf16_t* hid = (const LAS bf16_t*)(lds + (h ? L_HID2 : L_HID));
        f32x4 acc2 = {0.f, 0.f, 0.f, 0.f};
        const bf16_t* w2row = W2T + ((size_t)which * 64 + 16 * w4 + mrow) * 128 + 8 * q;
#pragma unroll
        for (int ks = 0; ks < 4; ++ks) {
            const bf16x8 hfr = *(const LAS bf16x8*)(hid + mrow * 136 + 32 * ks + 8 * q);
            const bf16x8 w = *(const bf16x8*)(w2row + 32 * ks);
            acc2 = __builtin_amdgcn_mfma_f32_16x16x32_bf16(w, hfr, acc2, 0, 0, 0);
        }
        u32x2 w; w.x = cvt_pk_bf16(acc2[0], acc2[1]); w.y = cvt_pk_bf16(acc2[2], acc2[3]);
        if (n > 510) { w.x = 0u; w.y = 0u; }
        *(u32x2*)((which ? vcmp : kcmp) + ((size_t)((b + 4 * h) * 512 + n) * 2 + g) * 64 + 16 * w4 + 4 * q) = w;
    }
    __syncthreads();
}
}

struct __attribute__((packed, aligned(4))) Rec3 { unsigned x, y, z; };
struct MoeCtx { LAS unsigned char* lds; unsigned char* ws; float* out; const float* ln2g; const float* ln2b; int G, gw, NGW, tid, lane; };
__device__ __forceinline__ MoeTables moe_tb(LAS unsigned char* lds) { MoeTables tb; tb.tn = (LAS int*)(lds + RING_BYTES + 1024); tb.es = tb.tn + 260; tb.us = tb.es + 260; return tb; }
__device__ __forceinline__ void moe_prefix(const unsigned* cnt, LAS int* tn, LAS int* es, LAS int* us, int tid) {
    __syncthreads();
    if (tid < 64) { const int lane = tid; int n[4], tt[4], sa = 0, sb = 0;
#pragma unroll
        for (int j = 0; j < 4; ++j) { n[j] = (int)cnt[4 * lane + j]; tt[j] = (n[j] + 255) >> 8; sa += n[j]; sb += tt[j]; }
        int ia = sa, ib = sb;
#pragma unroll
        for (int o = 1; o < 64; o <<= 1) { const int xa = __shfl_up(ia, o), xb = __shfl_up(ib, o); if (lane >= o) { ia += xa; ib += xb; } }
        int ea = ia - sa, eb = ib - sb;
#pragma unroll
        for (int j = 0; j < 4; ++j) { es[4 * lane + j] = ea; if (us) us[4 * lane + j] = eb; if (tn) tn[4 * lane + j] = n[j]; ea += n[j]; eb += tt[j]; }
        if (lane == 63) { es[256] = ea; es[257] = ea + CHT; if (us) { us[256] = eb; us[257] = eb + CHT / 256; } if (tn) tn[256] = CHT; } }
    __syncthreads();
}
__device__ __forceinline__ LAS int* moe_esc(LAS unsigned char* lds) { return (LAS int*)(lds + RING_BYTES + 13056); }
template <int C> __device__ __forceinline__ void moe_combine(const MoeCtx& mc) {
    LAS int* es = moe_esc(mc.lds);
    const unsigned* eidx = (const unsigned*)(mc.ws + WS_EIDX); const float* gatev = (const float*)(mc.ws + WS_GATE); const unsigned* posv = (const unsigned*)(mc.ws + WS_POS);
    const unsigned char* y8 = mc.ws + WS_Y; const bf16_t* ys = (const bf16_t*)(mc.ws + WS_YS);
    const int lane = mc.lane;
    f32x4 g2v[4], b2v[4];
#pragma unroll
    for (int j = 0; j < 4; ++j) { g2v[j] = *(const f32x4*)(mc.ln2g + 16 * lane + 4 * j); b2v[j] = *(const f32x4*)(mc.ln2b + 16 * lane + 4 * j); }
    for (int tl = mc.gw; tl < CHT; tl += 2 * mc.NGW) {
        const int tl2 = tl + mc.NGW; const bool two = tl2 < CHT;
        const int tA = C * CHT + tl, tB = C * CHT + (two ? tl2 : tl);
        u32x4 ra[10], rb[10]; float ga[8], gb[8];
        { const size_t ie = (size_t)((lane & 8) ? tB : tA) * TOPK + (lane & 7);
          const Rec3 rec = *(const Rec3*)(eidx + 3 * ie);
          const unsigned rowv = (unsigned)es[rec.x] + rec.y; const float gvv = __builtin_bit_cast(float, rec.z) * 0.0625f;
#pragma unroll
          for (int k = 0; k < 8; ++k) {
              const unsigned rowA = (unsigned)__builtin_amdgcn_readlane((int)rowv, k), rowB = (unsigned)__builtin_amdgcn_readlane((int)rowv, 8 + k);
              ga[k] = __builtin_bit_cast(float, __builtin_amdgcn_readlane(__builtin_bit_cast(int, gvv), k)); gb[k] = __builtin_bit_cast(float, __builtin_amdgcn_readlane(__builtin_bit_cast(int, gvv), 8 + k));
              ra[k] = *(const u32x4*)(y8 + (size_t)rowA * D + 16 * lane); rb[k] = *(const u32x4*)(y8 + (size_t)rowB * D + 16 * lane); } }
        { const bf16_t* pa = ys + (size_t)tl * D + 16 * lane; const bf16_t* pb = ys + (size_t)(two ? tl2 : tl) * D + 16 * lane;
          ra[8] = *(const u32x4*)pa; ra[9] = *(const u32x4*)(pa + 8); rb[8] = *(const u32x4*)pb; rb[9] = *(const u32x4*)(pb + 8); }
#pragma unroll
        for (int h = 0; h < 2; ++h) {
            if (h == 1 && !two) break;
            float v[16];
            { const u32x4 a = h ? rb[8] : ra[8], b = h ? rb[9] : ra[9];
#pragma unroll
              for (int j = 0; j < 4; ++j) { v[2 * j] = __builtin_bit_cast(float, a[j] << 16); v[2 * j + 1] = __builtin_bit_cast(float, a[j] & 0xffff0000u);
                  v[8 + 2 * j] = __builtin_bit_cast(float, b[j] << 16); v[8 + 2 * j + 1] = __builtin_bit_cast(float, b[j] & 0xffff0000u); } }
#pragma unroll
            for (int k = 0; k < 8; ++k) { const float gk = h ? gb[k] : ga[k]; const u32x4 a = h ? rb[k] : ra[k];
#pragma unroll
                for (int j = 0; j < 4; ++j) { const f32x2 lo = __builtin_amdgcn_cvt_pk_f32_fp8((int)a[j], false), hi = __builtin_amdgcn_cvt_pk_f32_fp8((int)a[j], true);
                    v[4 * j] += gk * lo.x; v[4 * j + 1] += gk * lo.y; v[4 * j + 2] += gk * hi.x; v[4 * j + 3] += gk * hi.y; } }
            float sm = 0.f;
#pragma unroll
            for (int j = 0; j < 16; ++j) sm += v[j];
            const float mean = wave_sum_x(sm) * (1.f / D); float s2 = 0.f;
#pragma unroll
            for (int j = 0; j < 16; ++j) { v[j] -= mean; s2 += v[j] * v[j]; }
            const float rstd = 1.f / sqrtf(wave_sum_x(s2) * (1.f / D) + LN_EPS);
            float* op = mc.out + (size_t)(h ? tB : tA) * D + 16 * lane;
#pragma unroll
            for (int j = 0; j < 4; ++j) { const f32x4 gg = g2v[j], bb = b2v[j];
                f32x4 o; o.x = v[4 * j] * rstd * gg.x + bb.x; o.y = v[4 * j + 1] * rstd * gg.y + bb.y; o.z = v[4 * j + 2] * rstd * gg.z + bb.z; o.w = v[4 * j + 3] * rstd * gg.w + bb.w;
                *(f32x4*)(op + 4 * j) = o; }
        }
    }
}
template <int C> __device__ __forceinline__ void moe_gu(const MoeCtx& mc) {
    const MoeTables tb = moe_tb(mc.lds);
    const unsigned* cntw = (const unsigned*)(mc.ws + WS_CTL) + CW_CNT;
    bf16_t* h1b = (bf16_t*)((unsigned char*)mc.out + DO_H1B); bf16_t* Wgu = (bf16_t*)(mc.ws + WS_WGU); bf16_t* hb = (bf16_t*)(mc.ws + WS_HB);
    const unsigned short* elist = (const unsigned short*)(mc.ws + WS_LIST);
    moe_prefix(cntw + C * 256, tb.tn, tb.es, tb.us, mc.tid);
    MoeUnits mu; mu.rec = (LAS int*)(mc.lds + RING_BYTES + 4352); mu.cnt = mu.rec + 96; mu.tok = (LAS unsigned short*)(mc.lds + RING_BYTES + 4864);
    moe_units<2, true>(tb, mu, mc.G, (int)blockIdx.x, mc.tid, elist, C);
    { MoeOrder<2> S; S.tb = tb; S.mu = mu; S.Abase = (const char*)h1b; S.apitch = 0; S.Bbase = (const char*)Wgu; S.strideE = (size_t)512 * D * 2; S.stridePN = (size_t)256 * D * 2;
      S.chunk = C; S.colw = 128;
      EpiGLU E{hb};
      pg8::gemm_phase<EpiGLU, MoeOrder<2>, true, true, false, 8>(mc.lds, D, S, E); }
}
template <int C> __device__ __forceinline__ void moe_d(const MoeCtx& mc) {
    const MoeTables tb = moe_tb(mc.lds);
    bf16_t* h1b = (bf16_t*)((unsigned char*)mc.out + DO_H1B); bf16_t* Wd = (bf16_t*)(mc.ws + WS_WD); bf16_t* hb = (bf16_t*)(mc.ws + WS_HB);
    const unsigned short* elist = (const unsigned short*)(mc.ws + WS_LIST);
    MoeUnits mu; mu.rec = (LAS int*)(mc.lds + RING_BYTES + 4352); mu.cnt = mu.rec + 96; mu.tok = (LAS unsigned short*)(mc.lds + RING_BYTES + 4864);
    moe_units<4, false>(tb, mu, mc.G, (int)blockIdx.x, mc.tid, elist, C);
    { MoeOrder<4> S; S.tb = tb; S.mu = mu; S.Abase = (const char*)hb; S.apitch = (size_t)EH * 2; S.Bbase = (const char*)Wd; S.strideE = (size_t)D * EH * 2; S.stridePN = (size_t)256 * EH * 2;
      S.chunk = C; S.colw = 256;
      EpiDown E{mc.ws + WS_Y, (bf16_t*)(mc.ws + WS_YS), h1b, C};
      int kk = EH; asm volatile("" : "+s"(kk));
      pg8::gemm_phase<EpiDown, MoeOrder<4>, true, false, false, 8>(mc.lds, kk, S, E); }
}
template <int C> __device__ __forceinline__ void moe_cgu(const MoeCtx& mc) {
    const unsigned* cntw = (const unsigned*)(mc.ws + WS_CTL) + CW_CNT;
    moe_prefix(cntw + C * 256, nullptr, moe_esc(mc.lds), nullptr, mc.tid);
    const bool first = (((int)blockIdx.x >> 3) & 1) == 0;
    if (first) moe_combine<C>(mc);
    moe_gu<C + 1>(mc);
    if (!first) moe_combine<C>(mc);
}

struct MegaArgs { const float* in[23]; float* out; unsigned char* ws; unsigned phases; unsigned li; };

__device__ __forceinline__ int colmap_win(int c) {
    if (c < 1280) return c;
    if (c < 1792) return O_QB + (c - 1280);
    if (c < 2048) return O_KB + (c - 1792);
    if (c < 2072) return O_GA + (c - 2048);
    if (c < 2304) return -1;
    if (c < 3328) return O_GATEA + (c - 2304);
    return O_GATEB + (c - 3328);
}
template <class CMap> __device__ __forceinline__ void transpose_item(const float* W, int K, int Nsrc, bf16_t* WT, int nblk, LAS unsigned char* scr, int item, int lane, CMap cmap, int ldo = 0, int koff = 0) {
    if (ldo == 0) ldo = K;
    const int kb = item / nblk, nb = item % nblk, k0 = 64 * kb, n0 = 64 * nb;
    const int sc = cmap(n0 + 4 * (lane & 15));
    const float* src = W + (size_t)(k0 + (lane >> 4)) * Nsrc + (sc >= 0 ? sc : 0);
#pragma unroll 8
    for (int i = 0; i < 16; ++i) { f32x4 v = {0.f, 0.f, 0.f, 0.f}; if (sc >= 0) v = __builtin_nontemporal_load((const f32x4*)(src + (size_t)(4 * i) * Nsrc));
        u32x2 w; w.x = pk2(v.x, v.y); w.y = pk2(v.z, v.w);
        *(LAS u32x2*)(scr + (4 * i + (lane >> 4)) * 144 + (lane & 15) * 8) = w; }
    asm volatile("s_waitcnt lgkmcnt(0)" ::: "memory");
    const int q = lane >> 4, cc = lane & 15;
#pragma unroll
    for (int it = 0; it < 8; ++it) { const int ng = it >> 1, kc = 4 * (it & 1) + q;
        const LAS unsigned char* p = scr + (8 * kc + (cc >> 2)) * 144 + (16 * ng + 4 * (cc & 3)) * 2;
        const v4i16_t lo = __builtin_amdgcn_ds_read_tr16_b64_v4i16((LAS v4i16_t*)p);
        const v4i16_t hi = __builtin_amdgcn_ds_read_tr16_b64_v4i16((LAS v4i16_t*)(p + 4 * 144));
        const bf16x8 o = {lo[0], lo[1], lo[2], lo[3], hi[0], hi[1], hi[2], hi[3]};
        *(bf16x8*)(WT + (size_t)(n0 + 16 * ng + cc) * ldo + koff + k0 + 8 * kc) = o; }
    asm volatile("s_waitcnt lgkmcnt(0)" ::: "memory");
}

__device__ __forceinline__ void route_select(const float (&lg)[4], const float (&rb)[4], int lane, unsigned long long (&Sm)[4], float (&sc)[4], float& gsum) {
            float ch[4];
#pragma unroll
            for (int i = 0; i < 4; ++i) { sc[i] = 1.0f / (1.0f + expf(-lg[i])); ch[i] = sc[i] + rb[i]; }
            float gs[8];
#pragma unroll
            for (int i = 0; i < 4; ++i) {
                float m1 = ch[i]; int a1 = lane;
#pragma unroll
                for (int o = 16; o > 0; o >>= 1) { const float om = __shfl_xor(m1, o); const int oa_ = __shfl_xor(a1, o); if (om > m1 || (om == m1 && oa_ < a1)) { m1 = om; a1 = oa_; } }
                float m2 = (lane == a1) ? -INFINITY : ch[i];
#pragma unroll
                for (int o = 16; o > 0; o >>= 1) m2 = fmaxf(m2, __shfl_xor(m2, o));
                const float s2 = m1 + m2;
                gs[2 * i] = __shfl(s2, 0); gs[2 * i + 1] = __shfl(s2, 32);
            }
            float cm[4];
#pragma unroll
            for (int i = 0; i < 4; ++i) { int r0 = 0, r1 = 0;
#pragma unroll
                for (int b = 0; b < 8; ++b) { r0 += (gs[b] > gs[2 * i] || (gs[b] == gs[2 * i] && b < 2 * i)) ? 1 : 0; r1 += (gs[b] > gs[2 * i + 1] || (gs[b] == gs[2 * i + 1] && b < 2 * i + 1)) ? 1 : 0; }
                const bool k = (lane < 32) ? (r0 < 4) : (r1 < 4); cm[i] = k ? ch[i] : -INFINITY; }
            unsigned key[4];
#pragma unroll
            for (int i = 0; i < 4; ++i) { const unsigned b_ = __builtin_bit_cast(unsigned, cm[i]); key[i] = (cm[i] == -INFINITY) ? 0u : (b_ ^ ((b_ >> 31) ? 0xFFFFFFFFu : 0x80000000u)); }
            unsigned Tk = 0u;
            for (int bit = 31; bit >= 8; --bit) { const unsigned cand = Tk | (1u << bit);
                const int cnt = __popcll(__ballot(key[0] >= cand)) + __popcll(__ballot(key[1] >= cand)) + __popcll(__ballot(key[2] >= cand)) + __popcll(__ballot(key[3] >= cand));
                if (cnt >= TOPK) Tk = cand; }
            int cge = 0;
#pragma unroll
            for (int i = 0; i < 4; ++i) { Sm[i] = __ballot(key[i] >= Tk); cge += __popcll(Sm[i]); }
            if (cge != TOPK) {
                for (int bit = 7; bit >= 0; --bit) { const unsigned cand = Tk | (1u << bit);
                    const int cnt = __popcll(__ballot(key[0] >= cand)) + __popcll(__ballot(key[1] >= cand)) + __popcll(__ballot(key[2] >= cand)) + __popcll(__ballot(key[3] >= cand));
                    if (cnt >= TOPK) Tk = cand; }
                int need = TOPK;
#pragma unroll
                for (int i = 0; i < 4; ++i) { Sm[i] = __ballot(key[i] > Tk); need -= __popcll(Sm[i]); }
#pragma unroll
                for (int i = 0; i < 4; ++i) { unsigned long long E_ = __ballot(key[i] == Tk);
                    while (need > 0 && E_) { const unsigned long long b_ = E_ & (0ull - E_); Sm[i] |= b_; E_ ^= b_; --need; } }
            }
            float gpart = 0.f;
#pragma unroll
            for (int i = 0; i < 4; ++i) gpart += ((Sm[i] >> lane) & 1ull) ? sc[i] : 0.f;
            gsum = wave_sum_x(gpart);
}
__device__ __forceinline__ void route_commit(int t, int lane, const unsigned long long (&Sm)[4], const float (&gv)[4], const unsigned (&p)[4], unsigned* eidx, float* gatev, unsigned* posv, unsigned short* elist) {
            const unsigned long long below = (1ull << lane) - 1ull;
            const int c = t / CHT;
            int base_ = 0;
#pragma unroll
            for (int i = 0; i < 4; ++i) {
                if ((Sm[i] >> lane) & 1ull) {
                    const int slot = base_ + __popcll(Sm[i] & below), e = lane + 64 * i;
                    { Rec3 rec; rec.x = (unsigned)e; rec.y = p[i]; rec.z = __builtin_bit_cast(unsigned, gv[i]);
                      *(Rec3*)(eidx + 3 * ((size_t)t * TOPK + slot)) = rec; }
                    elist[((size_t)c * 256 + e) * CHT + p[i]] = (unsigned short)(t - c * CHT);
                }
                base_ += __popcll(Sm[i]);
            }
}
struct PanelOrder { const char* A; const char* Bt; int K, row0;
    __device__ __forceinline__ bool next(int i, pg8::Unit& u) const { if (i >= 4) return false;
        u.A = A + (size_t)row0 * K * 2; u.B = Bt + (size_t)i * pg8::BM * K * 2; u.row0 = row0; u.col0 = i * pg8::BM; u.nrows = pg8::BM; u.aux = i; u.e = 0; u.ti = 0; u.ord = 0; return true; }
    __device__ __forceinline__ unsigned arow_off(const pg8::Unit&, int) const { return 0u; } };
constexpr int I_GU = (D / 64) * (512 / 64), I_D = (EH / 64) * (D / 64), I_E = I_GU + I_D, I_EXP = 257 * I_E;
__device__ __forceinline__ void expert_load(const float* const* in, int it, int lane, f32x4 (&v)[16]) {
    it = it < I_EXP ? it : I_EXP - 1;
    const int e = it / I_E; int r = it % I_E;
    const float* src; int Nsrc, kb, sc;
    if (r < I_GU) { const int nb = r % 8, bj = (nb >> 1) & 1, pnn = nb >> 2; kb = r / 8;
        src = (e < 256) ? ((bj ? in[16] : in[15]) + (size_t)e * D * EH) : (bj ? in[19] : in[18]); Nsrc = EH; sc = pnn * 128 + 64 * (nb & 1);
    } else { r -= I_GU; src = (e < 256) ? (in[17] + (size_t)e * EH * D) : in[20]; Nsrc = D; kb = r / (D / 64); sc = 64 * (r % (D / 64)); }
    const char* base = (const char*)(src + (size_t)(64 * kb) * Nsrc + sc);
    const unsigned loff = (unsigned)((lane >> 4) * Nsrc + 4 * (lane & 15)) * 4u;
#pragma unroll
    for (int i = 0; i < 16; ++i) v[i] = __builtin_nontemporal_load((const f32x4*)(base + (size_t)(4 * i) * Nsrc * 4 + loff));
}
__device__ __forceinline__ void expert_finish(bf16_t* Wgu, bf16_t* Wd, LAS unsigned char* scr, int it, int lane, const f32x4 (&v)[16]) {
    if (it >= I_EXP) return;
    const int e = it / I_E; int r = it % I_E;
    bf16_t* WT; int ldo, kb, nb;
    if (r < I_GU) { WT = Wgu + (size_t)e * 512 * D; ldo = D; kb = r / 8; nb = r % 8; }
    else { r -= I_GU; WT = Wd + (size_t)e * D * EH; ldo = EH; kb = r / (D / 64); nb = r % (D / 64); }
#pragma unroll
    for (int i = 0; i < 16; ++i) { u32x2 w; w.x = pk2(v[i].x, v[i].y); w.y = pk2(v[i].z, v[i].w);
        *(LAS u32x2*)(scr + (4 * i + (lane >> 4)) * 144 + (lane & 15) * 8) = w; }
    asm volatile("s_waitcnt lgkmcnt(0)" ::: "memory");
    const int q = lane >> 4, cc = lane & 15;
    char* obase = (char*)(WT + (size_t)(64 * nb) * ldo + 64 * kb);
    const unsigned ooff = (unsigned)(cc * ldo + 8 * q) * 2u;
    const LAS unsigned char* p0 = scr + (8 * q + (cc >> 2)) * 144 + (4 * (cc & 3)) * 2;
#pragma unroll
    for (int x = 0; x < 8; ++x) { const int ng = x >> 1, kh = x & 1;
        const LAS unsigned char* p = p0 + (32 * kh) * 144 + (16 * ng) * 2;
        const v4i16_t lo = __builtin_amdgcn_ds_read_tr16_b64_v4i16((LAS v4i16_t*)p);
        const v4i16_t hi = __builtin_amdgcn_ds_read_tr16_b64_v4i16((LAS v4i16_t*)(p + 4 * 144));
        const bf16x8 o = {lo[0], lo[1], lo[2], lo[3], hi[0], hi[1], hi[2], hi[3]};
        *(bf16x8*)(obase + ((size_t)(16 * ng) * ldo + 32 * kh) * 2 + ooff) = o; }
    asm volatile("s_waitcnt lgkmcnt(0)" ::: "memory");
}
struct OneUnit { pg8::Unit u; __device__ __forceinline__ bool next(int i, pg8::Unit& o) const { if (i) return false; o = u; return true; } __device__ __forceinline__ unsigned arow_off(const pg8::Unit&, int) const { return 0u; } };

__global__ void __launch_bounds__(NWAVES * 64, 2) mega(MegaArgs args) {
    extern __shared__ __attribute__((aligned(16))) unsigned char lds_raw[];
    LAS unsigned char* lds = (LAS unsigned char*)lds_raw;
    volatile LAS unsigned* MISC = (volatile LAS unsigned*)(lds + MISC_OFF);
    const int tid = threadIdx.x, lane = tid & 63, wave = __builtin_amdgcn_readfirstlane(tid >> 6);
    const int G = gridDim.x;
    const int vcu = (G % 8 == 0) ? ((int)blockIdx.x % 8) * (G / 8) + (int)blockIdx.x / 8 : (int)blockIdx.x;
    unsigned char* ws = args.ws;
    gu32* ctl = (gu32*)(ws + WS_CTL);
    for (int u = tid; u < (LDS_BYTES - RING_BYTES) / 4; u += NWAVES * 64) ((LAS unsigned*)(lds + RING_BYTES))[u] = 0u;
    __syncthreads();
    XcdBarrier bar = xcd_barrier_post((unsigned*)(ctl + CW_BAR) + (args.li & 255u) * XCD_BAR_WORDS, MISC + 8);
    const unsigned ph = args.phases;
    const float* x = args.in[0]; const float* w_in = args.in[1];
    bf16_t* xb = (bf16_t*)(ws + WS_XB);
    bf16_t* merged = (bf16_t*)((unsigned char*)args.out + DO_MERGED);
    bf16_t* oab = (bf16_t*)((unsigned char*)args.out + DO_OAB);
    bf16_t* WinT = (bf16_t*)(ws + WS_WINT); bf16_t* projT = (bf16_t*)(ws + WS_PROJT); bf16_t* woutT = (bf16_t*)(ws + WS_WOUTT); bf16_t* WrT = (bf16_t*)(ws + WS_WRT);
    bf16_t* qkvg = (bf16_t*)(ws + WS_QKV); bf16_t* gates = (bf16_t*)(ws + WS_GATES);
    bf16_t* pre = (bf16_t*)(ws + WS_PRE);
    bf16_t* h1b = (bf16_t*)((unsigned char*)args.out + DO_H1B);
    bf16_t* Wgu = (bf16_t*)(ws + WS_WGU); bf16_t* Wd = (bf16_t*)(ws + WS_WD);
    bf16_t* hb = (bf16_t*)(ws + WS_HB); bf16_t* ybuf = (bf16_t*)(ws + WS_Y);
    float* logits = (float*)(ws + WS_LOGITS);
    unsigned* eidx = (unsigned*)(ws + WS_EIDX); float* gatev = (float*)(ws + WS_GATE); unsigned* posv = (unsigned*)(ws + WS_POS);
    unsigned short* elist = (unsigned short*)(ws + WS_LIST);
    unsigned* cntw = (unsigned*)(ctl + CW_CNT);
    const int gw = vcu * NWAVES + wave, NGW = G * NWAVES;

    if (ph & 1u) {
        LAS unsigned char* scr = lds + wave * 16384;
        constexpr int NBLK = QW / 64, I_WIN = (D / 64) * NBLK, I_PA = (512 / 64) * (D / 64), I_WO = (D / 64) * (D / 64), I_WR = (D / 64) * (NE / 64);
        constexpr int NITEMS = I_WIN + 2 * I_PA + I_WO + I_WR;
        auto ident = [](int c) { return c; };
        for (int it = gw; it < NITEMS; it += NGW) {
            int r = it;
            if (r < I_WIN) { transpose_item(w_in, D, INW, WinT, NBLK, scr, r, lane, [](int c) { return colmap_win(c); }); continue; } r -= I_WIN;
            if (r < I_PA) { transpose_item(args.in[8], 512, D, projT, D / 64, scr, r, lane, ident, D, 0); continue; } r -= I_PA;
            if (r < I_PA) { transpose_item(args.in[9], 512, D, projT, D / 64, scr, r, lane, ident, D, 512); continue; } r -= I_PA;
            if (r < I_WO) { transpose_item(args.in[10], D, D, woutT, D / 64, scr, r, lane, ident); continue; } r -= I_WO;
            transpose_item(args.in[13], D, NE, WrT, NE / 64, scr, r, lane, ident);
        }
        { bf16_t* W1T = (bf16_t*)(ws + WS_W1T); bf16_t* W2T = (bf16_t*)(ws + WS_W2T); float* c1 = (float*)(ws + WS_C1);
          constexpr int I_1 = (2048 / 64) * (128 / 64), I_2 = (128 / 64) * (64 / 64);
          for (int it = gw; it < 2 * (I_1 + I_2); it += NGW) { const int which = it / (I_1 + I_2); int r = it % (I_1 + I_2);
              if (r < I_1) transpose_item(args.in[3] + (size_t)which * 2048 * 128, 2048, 128, W1T + (size_t)which * 128 * 2048, 2, scr, r, lane, ident);
              else transpose_item(args.in[5] + (size_t)which * 128 * 64, 128, 64, W2T + (size_t)which * 64 * 128, 1, scr, r - I_1, lane, ident); }
          for (int o = gw; o < 256; o += NGW) { const int which = o >> 7, nn = o & 127; const float* pe = args.in[2] + which * 2048; const float* w1 = args.in[3] + (size_t)which * 2048 * 128 + nn;
              float a = 0.f; for (int k = lane; k < 2048; k += 64) a = fmaf(pe[k], w1[(size_t)k * 128], a);
              a = wave_sum_x(a); if (lane == 0) c1[o] = a + args.in[4][o]; } }
        const size_t nchunk = (size_t)T * D / 8, gstep = (size_t)G * NWAVES * 64;
        for (size_t i = (size_t)blockIdx.x * (NWAVES * 64) + tid; i < nchunk; i += 4 * gstep) {
            f32x4 a[4], b[4];
#pragma unroll
            for (int j = 0; j < 4; ++j) { const size_t ii = (i + j * gstep < nchunk) ? i + j * gstep : i; a[j] = __builtin_nontemporal_load((const f32x4*)(x + ii * 8)); b[j] = __builtin_nontemporal_load((const f32x4*)(x + ii * 8 + 4)); }
#pragma unroll
            for (int j = 0; j < 4; ++j) { const size_t ii = (i + j * gstep < nchunk) ? i + j * gstep : i;
                u32x4 o; o.x = pk2(a[j][0], a[j][1]); o.y = pk2(a[j][2], a[j][3]); o.z = pk2(b[j][0], b[j][1]); o.w = pk2(b[j][2], b[j][3]);
                *(u32x4*)(xb + ii * 8) = o; }
        }
        xcd_barrier(bar);
    }
    if (ph & 2u) {
        pg8::DenseOrder S; S.init(xb, WinT, T, QW, D, G, (int)blockIdx.x);
        EpiQKV E{qkvg, gates};
        pg8::gemm_phase<EpiQKV, pg8::DenseOrder, true, false, false, 16>(lds, D, S, E);
        xcd_barrier(bar);
    }
    if (ph & 4u) {
        const bf16_t* W1T = (const bf16_t*)(ws + WS_W1T); const bf16_t* W2T = (const bf16_t*)(ws + WS_W2T); const float* c1 = (const float*)(ws + WS_C1);
        if (G == 256) {
            u32x4 cr0[5], cr1[5]; att::compress_load(qkvg, (int)blockIdx.x, tid, cr0); att::compress_load(qkvg, (int)blockIdx.x + 256, tid, cr1);
            for (int u = (int)blockIdx.x; u < 1024; u += 512) {
                att::compress_stage(lds, tid, cr0); att::compress_stage1(lds, tid, cr1);
                __syncthreads();
                { const int un = u + 512 < 1024 ? u + 512 : u; att::compress_load(qkvg, un, tid, cr0); att::compress_load(qkvg, un + 256, tid, cr1); }
                att::compress_unit2(lds, lane, wave, W1T, W2T, c1, (bf16_t*)(ws + WS_KCMP), (bf16_t*)(ws + WS_VCMP), u);
            }
        } else {
            u32x4 cr[5]; att::compress_load(qkvg, (int)blockIdx.x < 1024 ? (int)blockIdx.x : 0, tid, cr);
            for (int u = (int)blockIdx.x; u < 1024; u += G) {
                att::compress_stage(lds, tid, cr);
                __syncthreads();
                att::compress_load(qkvg, u + G < 1024 ? u + G : u, tid, cr);
                att::compress_unit(lds, lane, wave, W1T, W2T, c1, (bf16_t*)(ws + WS_KCMP), (bf16_t*)(ws + WS_VCMP), u);
            }
        }
        xcd_barrier(bar);
    }
    if (ph & 8u) {
        { LAS float* biasL = (LAS float*)(lds + att::L_BIAS); const float* tab = args.in[7];
          for (int i = tid; i < 16 * 132; i += NWAVES * 64) { const int hh = i / 132, d = i % 132; biasL[i] = tab[(d >= 128 ? 31 : (int)BUCKET[d]) * 16 + hh] * att::LOG2E; } }
        __syncthreads();
        const int nstat = (2048 - 256 - (int)blockIdx.x + G - 1) / G, cgrp = ((int)blockIdx.x >> 3) & 7, cslot = nstat <= 0 ? 0 : (cgrp < nstat ? cgrp : nstat - 1);
        int u = 256 + (int)blockIdx.x;
        for (int itn = 0;; ++itn) {
            int tile = -1, bg = 0;
            if (u < 2048) { const int w = u & 255, k = u >> 8, sub = w >> 4; bg = w & 15; tile = 16 * k + ((k & 1) ? 15 - sub : sub); u += G; }
            else {
                __syncthreads();
                if (tid == 0) *(volatile LAS unsigned*)(lds + att::L_END) = __hip_atomic_fetch_add((unsigned*)(ctl + CW_ATTQ), 1u, __ATOMIC_RELAXED, __HIP_MEMORY_SCOPE_AGENT);
                __syncthreads();
                const int qd = __builtin_amdgcn_readfirstlane((int)*(volatile LAS unsigned*)(lds + att::L_END));
                if (qd < 256) { bg = qd & 15; tile = 15 - (qd >> 4); }
            }
            if (itn == cslot) {
                static_assert(2047 + 23 * 2048 < I_EXP && I_EXP <= 25 * 2048, "conversion share");
                for (int r = 0; r < 8; ++r) {
                    int lane2 = tid; asm volatile("" : "+v"(lane2)); lane2 &= 63;
                    LAS unsigned char* scr = lds + wave * 9216;
                    const int i0 = __builtin_amdgcn_readfirstlane(gw + 3 * r * NGW), i1 = i0 + NGW, i2 = i1 + NGW;
                    f32x4 va[16], vb[16];
                    expert_load(args.in, i0, lane2, va); expert_load(args.in, i1, lane2, vb);
                    expert_finish(Wgu, Wd, scr, i0, lane2, va); expert_load(args.in, i2, lane2, va);
                    expert_finish(Wgu, Wd, scr, i1, lane2, vb);
                    expert_finish(Wgu, Wd, scr, i2, lane2, va);
                }
            }
            if (tile < 0) break;
            __syncthreads();
            { int tidu = tid; asm volatile("" : "+v"(tidu));
              att::unit(lds, tidu, tidu & 63, wave, qkvg, (const bf16_t*)(ws + WS_KCMP), (const bf16_t*)(ws + WS_VCMP), args.in[6], oab, bg >> 1, bg & 1, tile); }
            __syncthreads();
        }
        {
            const int it = gw + 24 * NGW;
            if (it < I_EXP) { int lane2 = tid; asm volatile("" : "+v"(lane2)); lane2 &= 63; f32x4 vc[16]; expert_load(args.in, it, lane2, vc); expert_finish(Wgu, Wd, lds + wave * 9216, it, lane2, vc); }
        }
        xcd_barrier(bar);
    }
    if (ph & 64u) {
        pg8::DenseOrder S; S.init(h1b, WrT, T, NE, D, G, (int)blockIdx.x);
        {
            OneUnit S1; if (!S.next(0, S1.u)) S1.u = pg8::Unit{(const char*)h1b, (const char*)WrT, 0, 0, 256, 0, 0, 0, 0};
            { PanelOrder SP{(const char*)oab, (const char*)projT, D, S1.u.row0}; EpiMerge E{gates, merged}; pg8::gemm_phase<EpiMerge, PanelOrder, true, false, true>(lds, D, SP, E); }
            xcd_barrier(bar);
            { PanelOrder SP{(const char*)merged, (const char*)woutT, D, S1.u.row0}; EpiWout E{xb, pre}; pg8::gemm_phase<EpiWout, PanelOrder, true, false, false>(lds, D, SP, E); }
            asm volatile("s_waitcnt vmcnt(0)" ::: "memory");
            __syncthreads();
            __builtin_amdgcn_fence(__ATOMIC_ACQUIRE, "agent");
            const int r0 = S1.u.row0 + wave * 32;
            f32x4 g1v[4], b1v[4];
#pragma unroll
            for (int j = 0; j < 4; ++j) { g1v[j] = *(const f32x4*)(args.in[11] + 16 * lane + 4 * j); b1v[j] = *(const f32x4*)(args.in[12] + 16 * lane + 4 * j); }
            for (int m = 0; m < 32; m += 4) {
                u32x4 ra[4], rc[4];
#pragma unroll
                for (int j = 0; j < 4; ++j) { const bf16_t* xr = pre + (size_t)(r0 + m + j) * D + 16 * lane; ra[j] = *(const u32x4*)xr; rc[j] = *(const u32x4*)(xr + 8); }
#pragma unroll
                for (int j = 0; j < 4; ++j) ln_regs_to_bf16(ra[j], rc[j], h1b + (size_t)(r0 + m + j) * D, g1v, b1v, lane);
            }
            asm volatile("s_waitcnt vmcnt(0)" ::: "memory");
            __syncthreads();
            { EpiLogits E{logits}; pg8::gemm_phase<EpiLogits, OneUnit, false, false, false>(lds, D, S1, E); }
            asm volatile("s_waitcnt vmcnt(0)" ::: "memory");
            __syncthreads();
            {
                LAS float* lgs = (LAS float*)(lds + wave * 8192);
                float rb[4];
#pragma unroll
                for (int i = 0; i < 4; ++i) rb[i] = args.in[14][lane + 64 * i];
                f32x4 rr[8];
#pragma unroll
                for (int k = 0; k < 8; ++k) rr[k] = *(const f32x4*)(logits + (size_t)(r0 + k) * NE + 4 * lane);
                unsigned long long pSm[4] = {0ull, 0ull, 0ull, 0ull}; float pg[4] = {0.f, 0.f, 0.f, 0.f}; unsigned pp[4] = {0u, 0u, 0u, 0u};
                for (int mb = 0; mb < 32; mb += 8) {
#pragma unroll
                    for (int k = 0; k < 8; ++k) *(LAS f32x4*)(lgs + k * 256 + 4 * lane) = rr[k];
                    { const int nb_ = mb + 8 < 32 ? mb + 8 : mb;
#pragma unroll
                      for (int k = 0; k < 8; ++k) rr[k] = *(const f32x4*)(logits + (size_t)(r0 + nb_ + k) * NE + 4 * lane); }
                    for (int m = mb; m < mb + 8; ++m) {
                        const int t = r0 + m;
                        float lg[4];
#pragma unroll
                        for (int i = 0; i < 4; ++i) lg[i] = lgs[(m - mb) * 256 + lane + 64 * i];
                        unsigned long long Sm[4]; float sc[4], gsum;
                        route_select(lg, rb, lane, Sm, sc, gsum);
                        unsigned p[4];
#pragma unroll
                        for (int i = 0; i < 4; ++i) { p[i] = 0u; if ((Sm[i] >> lane) & 1ull) p[i] = atomicAdd(&cntw[(t / CHT) * 256 + lane + 64 * i], 1u); }
                        if (m > 0) route_commit(t - 1, lane, pSm, pg, pp, eidx, gatev, posv, elist);
#pragma unroll
                        for (int i = 0; i < 4; ++i) { pSm[i] = Sm[i]; pg[i] = sc[i] / gsum * 2.5f; pp[i] = p[i]; }
                    }
                }
                route_commit(r0 + 31, lane, pSm, pg, pp, eidx, gatev, posv, elist);
            }
        }
        xcd_barrier(bar);
    }
    if (ph & 512u) {
        MoeCtx mc; mc.lds = lds; mc.ws = ws; mc.out = args.out; mc.ln2g = args.in[21]; mc.ln2b = args.in[22]; mc.G = G; mc.gw = gw; mc.NGW = NGW; mc.tid = tid; mc.lane = lane;
        static_assert(NCH == 2, "MoE chunk program");
        moe_gu<0>(mc); xcd_barrier(bar); moe_d<0>(mc); xcd_barrier(bar);
        moe_cgu<0>(mc); xcd_barrier(bar); moe_d<1>(mc); xcd_barrier(bar);
        moe_prefix((const unsigned*)(ws + WS_CTL) + CW_CNT + 1 * 256, nullptr, moe_esc(lds), nullptr, tid);
        moe_combine<1>(mc);
    }
}

extern "C" void kernel_launch(void* const* d_in, const int* in_sizes, int n_in, void* d_out, int out_size, void* d_ws, size_t ws_size, hipStream_t stream) {
    static int grid = 0;
    if (grid == 0) {
        if (n_in != 23 || in_sizes[0] != T * D || out_size != T * D || ws_size < WS_NEED) { fprintf(stderr, "kernel_launch: unexpected inputs / workspace (%d inputs, %zu bytes)\n", n_in, ws_size); grid = -1; return; }
        int dev = 0, cus = 0;
        if (hipGetDevice(&dev) != hipSuccess || hipDeviceGetAttribute(&cus, hipDeviceAttributeMultiprocessorCount, dev) != hipSuccess) { grid = -1; return; }
        if (hipFuncSetAttribute((const void*)mega, hipFuncAttributeMaxDynamicSharedMemorySize, LDS_BYTES) != hipSuccess) { fprintf(stderr, "kernel_launch: hipFuncSetAttribute failed\n"); grid = -1; return; }
        int per_cu = 0;
        if (hipOccupancyMaxActiveBlocksPerMultiprocessor(&per_cu, (const void*)mega, NWAVES * 64, LDS_BYTES) != hipSuccess || per_cu < 1) fprintf(stderr, "kernel_launch: occupancy query says %d\n", per_cu);
        (void)hipGetLastError();
        if (cus != 256) fprintf(stderr, "kernel_launch: built for the 256 CUs of MI355X (one row panel per workgroup), found %d\n", cus);
        grid = cus;
    }
    if (grid < 0) return;
    (void)hipMemsetAsync((char*)d_ws + WS_CTL, 0, CTL_ZERO_BYTES, stream);
    MegaArgs a{};
    for (int i = 0; i < 23; ++i) a.in[i] = (const float*)d_in[i];
    a.out = (float*)d_out; a.ws = (unsigned char*)d_ws; a.phases = 0x3ffu; a.li = 0u;
    hipLaunchKernelGGL(mega, dim3(grid), dim3(NWAVES * 64), LDS_BYTES, stream, a);
}
```

```cpp
#include <hip/hip_runtime.h>
#include <stdint.h>
#include <math.h>
#include <cstdio>

#define GAS __attribute__((address_space(1)))
#define LAS __attribute__((address_space(3)))
typedef unsigned short bf16_t;
typedef short bf16x8 __attribute__((ext_vector_type(8)));
typedef float f32x4 __attribute__((ext_vector_type(4)));
typedef float f32x2 __attribute__((ext_vector_type(2)));
typedef unsigned u32x4 __attribute__((ext_vector_type(4)));
typedef unsigned u32x2 __attribute__((ext_vector_type(2)));
typedef GAS unsigned gu32;
typedef short v4i16_t __attribute__((ext_vector_type(4)));

constexpr int D = 1024, NB = 8, S = 8192, T = NB * S;
constexpr int INW = 4120;
constexpr int O_QA = 0, O_KC = 512, O_VC = 640, O_KS = 768, O_VS = 896, O_KW = 1024, O_VW = 1152, O_GA = 1280,
              O_QB = 1304, O_KB = 1816, O_VB = 1944, O_GATEA = 2072, O_GATEB = 3096;
constexpr int QW = 4352, QP = 2304, GP = 2048;
constexpr int C_QA = 0, C_KC = 512, C_VC = 640, C_KS = 768, C_VS = 896, C_KW = 1024, C_VW = 1152,
              C_QB = 1280, C_KB = 1792, C_VB = 1920, C_GA = 2048, C_GATEA = 2304, C_GATEB = 3328;
constexpr int NCMP = 511, NSEL = 128;
constexpr int NE = 256, TOPK = 8, EH = 256;
constexpr float DN_ALPHA = 1.189207115002721f;
constexpr float LN_EPS = 1e-5f;
constexpr int MB = 64;
constexpr int NASSIGN = T * TOPK;
constexpr int NTILES_MAX = (NASSIGN + NE * (MB - 1) + MB - 1) / MB;
constexpr int NROWS_MAX = NTILES_MAX * MB;

__device__ const unsigned char BUCKET[128] = {0, 1, 2, 3, 4, 5, 6, 7, 8, 9, 10, 11, 12, 13, 14, 15, 16, 16, 16, 17, 17, 18, 18, 18, 19, 19, 19, 20, 20, 20, 20, 21, 21, 21, 21, 22, 22, 22, 22, 22, 23, 23, 23, 23, 23, 23, 24, 24, 24, 24, 24, 24, 25, 25, 25, 25, 25, 25, 25, 26, 26, 26, 26, 26, 26, 26, 26, 27, 27, 27, 27, 27, 27, 27, 27, 27, 27, 28, 28, 28, 28, 28, 28, 28, 28, 28, 28, 29, 29, 29, 29, 29, 29, 29, 29, 29, 29, 29, 29, 30, 30, 30, 30, 30, 30, 30, 30, 30, 30, 30, 30, 30, 30, 31, 31, 31, 31, 31, 31, 31, 31, 31, 31, 31, 31, 31, 31, 31};
__device__ __forceinline__ int bucket_of(int dist) { return dist >= 128 ? 31 : (int)BUCKET[dist < 0 ? 0 : dist]; }
__device__ __forceinline__ float sigmoidf_(float x) { return 1.0f / (1.0f + expf(-x)); }
__device__ __forceinline__ float bf2f(bf16_t h) { return __builtin_bit_cast(float, (unsigned)h << 16); }
__device__ __forceinline__ unsigned f2bf(float f) { unsigned u = __builtin_bit_cast(unsigned, f); return (u + 0x7fffu + ((u >> 16) & 1u)) >> 16; }
__device__ __forceinline__ unsigned pk2(float lo, float hi) { return f2bf(lo) | (f2bf(hi) << 16); }
typedef __bf16 bf16x2_t __attribute__((ext_vector_type(2)));
__device__ __forceinline__ unsigned cvt_pk_bf16(float lo, float hi) { const f32x2 v = {lo, hi}; const bf16x2_t b = __builtin_convertvector(v, bf16x2_t); return __builtin_bit_cast(unsigned, b); }

constexpr size_t MiB = 1u << 20;
constexpr size_t WS_CTL = 0, CTL_ZERO_BYTES = 1 * MiB;
constexpr size_t WS_WINT = 1 * MiB;
constexpr size_t WS_PROJT = 10 * MiB;
constexpr size_t WS_WOUTT = 12 * MiB;
constexpr size_t WS_WRT = 14 * MiB;
constexpr size_t WS_WGU = 20 * MiB;
constexpr size_t WS_WD = 277 * MiB;
constexpr size_t WS_GATES = 406 * MiB;
constexpr size_t WS_XB = 534 * MiB;
constexpr size_t WS_QKV = 662 * MiB;
constexpr size_t WS_PRE = 662 * MiB;
constexpr size_t WS_HB = 406 * MiB;
constexpr size_t WS_Y = 552 * MiB;
constexpr size_t WS_YS = 892 * MiB;
constexpr size_t WS_LOGITS = 790 * MiB;
constexpr size_t WS_EIDX = 854 * MiB, WS_GATE = 856 * MiB, WS_POS = 858 * MiB;
constexpr size_t WS_LIST = 860 * MiB;
constexpr size_t DO_XB = 0, DO_MERGED = 0, DO_OAB = 128 * MiB, DO_H1B = 128 * MiB;
constexpr size_t WS_KCMP = 1020 * MiB, WS_VCMP = 1021 * MiB;
constexpr size_t WS_NEED = 1030 * MiB;
constexpr int NCH = 2, CHT = T / NCH, CROWS = 9 * CHT;
constexpr int CW_CNT = 32768;
constexpr int CW_BAR = 4096;
constexpr int CW_ATTQ = 65536;

#define XB_TMO      128
#define XB_XCNT(j)  (256  + 64 * (j))
#define XB_XSUB(j)  (1280 + 64 * (j))
#define XB_XGEN(j)  (2304 + 64 * (j))
#define XB_TOP      3328
#define XB_TOPGEN   3392
#define XCD_BAR_WORDS 3456
#define XB_SPIN_CAP (1u << 18)
__device__ __forceinline__ unsigned xb_ld(unsigned* p)              { return __hip_atomic_load(p, __ATOMIC_RELAXED, __HIP_MEMORY_SCOPE_AGENT); }
__device__ __forceinline__ unsigned xb_add(unsigned* p, unsigned v) { return __hip_atomic_fetch_add(p, v, __ATOMIC_RELAXED, __HIP_MEMORY_SCOPE_AGENT); }
__device__ __forceinline__ unsigned xb_xcc_id() { return (unsigned)__builtin_amdgcn_s_getreg((3 << 11) | 20) & 0xFu; }
#define XB_SPIN(cond, bar) do { unsigned _sp = 0; while (cond) { __builtin_amdgcn_s_sleep(1); \
    if ((++_sp & 255u) == 0u) { if (xb_ld(&(bar)[XB_TMO])) break; if (_sp > XB_SPIN_CAP) { atomicAdd(&(bar)[XB_TMO], 1u); break; } } } } while (0)
struct XcdBarrier { unsigned* bar; unsigned x; volatile LAS unsigned* st; };
__device__ __forceinline__ XcdBarrier xcd_barrier_post(unsigned* bar, volatile LAS unsigned* st) {
    XcdBarrier b; b.bar = bar; b.x = xb_xcc_id(); b.st = st;
    if (threadIdx.x == 0) (void)xb_add(&bar[XB_XCNT(b.x)], 1u);
    return b;
}
__device__ __forceinline__ void xcd_barrier_complete(unsigned* bar, unsigned x, unsigned& nloc, unsigned& nx) {
    const unsigned G = gridDim.x * gridDim.y * gridDim.z;
    unsigned sum, cnt, mine, sp = 0u;
    for (;;) {
        sum = 0u; cnt = 0u; mine = 0u;
#pragma unroll
        for (unsigned j = 0; j < 16; ++j) { const unsigned c = xb_ld(&bar[XB_XCNT(j)]); sum += c; cnt += (c > 0u) ? 1u : 0u; mine = (j == x) ? c : mine; }
        if (sum == G) break;
        __builtin_amdgcn_s_sleep(1);
        if ((++sp & 255u) == 0u) { if (xb_ld(&bar[XB_TMO])) break; if (sp > XB_SPIN_CAP) { atomicAdd(&bar[XB_TMO], 1u); break; } }
    }
    nloc = mine > 0u ? mine : 1u; nx = cnt > 0u ? cnt : 1u;
}
__device__ __forceinline__ void xcd_barrier(const XcdBarrier& b) {
    asm volatile("s_waitcnt vmcnt(0)" ::: "memory");
    __syncthreads();
    if (threadIdx.x == 0) {
        unsigned* bar = b.bar;
        __builtin_amdgcn_s_waitcnt(0);
        unsigned nloc = b.st[0], nx = b.st[1];
        if (nloc == 0u) { xcd_barrier_complete(bar, b.x, nloc, nx); b.st[0] = nloc; b.st[1] = nx; }
        const unsigned old = xb_add(&bar[XB_XSUB(b.x)], 1u);
        const unsigned gen = old / nloc;
        if (old + 1u == (gen + 1u) * nloc) {
            __builtin_amdgcn_fence(__ATOMIC_RELEASE, "agent");
            asm volatile("s_waitcnt vmcnt(0)" ::: "memory");
            const unsigned og = xb_add(&bar[XB_TOP], 1u);
            const unsigned tg = og / nx;
            if (og + 1u == (tg + 1u) * nx) xb_add(&bar[XB_TOPGEN], 1u);
            else XB_SPIN(xb_ld(&bar[XB_TOPGEN]) == tg, bar);
            __builtin_amdgcn_fence(__ATOMIC_ACQUIRE, "agent");
            xb_add(&bar[XB_XGEN(b.x)], 1u);
            asm volatile("s_waitcnt vmcnt(0)" ::: "memory");
        } else {
            XB_SPIN(xb_ld(&bar[XB_XGEN(b.x)]) == gen, bar);
            __builtin_amdgcn_fence(__ATOMIC_ACQUIRE, "agent");
            asm volatile("s_waitcnt vmcnt(0)" ::: "memory");
        }
    }
    __syncthreads();
}

namespace pg8 {
constexpr int BM = 256, BK = 64, HALF = 128, HTB = HALF * BK * 2, STAGE_BYTES = 8 * HTB;
__host__ __device__ __forceinline__ int lds_byte(int r, int c) { const int st = (r >> 4) * 2 + (c >> 5), rr = r & 15, cc = c & 31, ob = rr * 64 + cc * 2; return st * 1024 + (ob ^ (((ob >> 9) & 1) << 5)); }
__host__ __device__ __forceinline__ void stage_rc(int b, int& R, int& C) { const int st = b / 1024, sb = b % 1024, swz = sb ^ (((sb >> 9) & 1) << 5); R = (st >> 1) * 16 + swz / 64; C = (st & 1) * 32 + (swz % 64) / 2; }
__host__ __device__ __forceinline__ int perm32(int rho) { const int n = rho >> 4, i = rho & 15; return 8 * (i >> 2) + 4 * n + (i & 3); }

struct Unit { const char* A; const char* B; int row0, col0, nrows, aux, e, ti, ord; };

template <class Epi, class Sched, bool ALIGN_EPI, bool GATHER, bool MIDHOOK, int EPI_VM = 0>
__device__ __forceinline__ void gemm_phase(LAS unsigned char* lds, const int K, const Sched& S, const Epi& E) {
    const int tid = threadIdx.x, wid = __builtin_amdgcn_readfirstlane(tid >> 6), lane = tid & 63, wr = wid >> 2, wc = wid & 3, fr = lane & 15, fq = lane >> 4;
    const int nt = K / BK;
    int Rr[2], Cc[2];
    unsigned vcur[2][2], vnxt[2][2], voffB[2];
#pragma unroll
    for (int i = 0; i < 2; ++i) { int R, C; stage_rc(tid * 16 + i * 8192, R, C); Rr[i] = R; Cc[i] = C; const int Rb = (int)Epi::PERM == 2 ? (64 * (R >> 5) + 16 * ((R & 15) >> 2) + 4 * ((R >> 4) & 1) + (R & 3)) : (Epi::PERM ? ((R & ~31) + perm32(R & 31)) : R);
        voffB[i] = (unsigned)(Rb * K + C) * 2u;
#pragma unroll
        for (int h = 0; h < 2; ++h) { vcur[h][i] = (unsigned)((h * HALF + R) * K + C) * 2u; vnxt[h][i] = vcur[h][i]; } }
    const size_t kstep = (size_t)(BK * 2);
    const size_t hstep = (size_t)HALF * K * 2;
    const size_t hstepB = (int)Epi::PERM == 2 ? (size_t)8 * K * 2 : hstep;
    const unsigned ldsw = (unsigned)wid * 1024u;
    const int aoff = lds_byte(wr * 64 + fr, fq * 8), boff = lds_byte(wc * 32 + fr, fq * 8);
#define PG8_SA(b, h) (((b) * 2 + (h)) * HTB)
#define PG8_SB(b, h) ((4 + (b) * 2 + (h)) * HTB)
#define PG8_STAGE(bufoff, gbase, voff) do { _Pragma("unroll") for (int _i = 0; _i < 2; ++_i) \
        __builtin_amdgcn_global_load_lds((const unsigned*)((const char*)(gbase) + (voff)[_i]), (LAS unsigned*)(lds + (bufoff) + ldsw + _i * 8192), 16, 0, 0); } while (0)
#define PG8_LDA(dst, b, h) do { _Pragma("unroll") for (int m = 0; m < 4; ++m) _Pragma("unroll") for (int k = 0; k < 2; ++k) dst[m][k] = *(const LAS bf16x8*)(lds + PG8_SA(b, h) + aoff + m * 2048 + k * 1024); } while (0)
#define PG8_LDB(dst, b, h) do { _Pragma("unroll") for (int n = 0; n < 2; ++n) _Pragma("unroll") for (int k = 0; k < 2; ++k) dst[n][k] = *(const LAS bf16x8*)(lds + PG8_SB(b, h) + boff + n * 2048 + k * 1024); } while (0)
#define PG8_MMA(ai, bj, At, Bt) do { __builtin_amdgcn_s_setprio(1); _Pragma("unroll") for (int m = 0; m < 4; ++m) _Pragma("unroll") for (int n = 0; n < 2; ++n) _Pragma("unroll") for (int k = 0; k < 2; ++k) \
        acc[ai][bj][m][n] = __builtin_amdgcn_mfma_f32_16x16x32_bf16(Bt[n][k], At[m][k], acc[ai][bj][m][n], 0, 0, 0); __builtin_amdgcn_s_setprio(0); } while (0)
#define PG8_WAIT_V(n) asm volatile("s_waitcnt vmcnt(" #n ")" ::: "memory")
#define PG8_WAIT_L(n) asm volatile("s_waitcnt lgkmcnt(" #n ")" ::: "memory")
#define PG8_BAR __builtin_amdgcn_s_barrier()
#define PG8_SCHED __builtin_amdgcn_sched_barrier(0)
    Unit cur, nxt; int ui = 0; int pfn = 1;
    if (!S.next(0, cur)) return;
    if constexpr (GATHER) {
#pragma unroll
        for (int h = 0; h < 2; ++h)
#pragma unroll
            for (int i = 0; i < 2; ++i) vcur[h][i] = S.arow_off(cur, h * HALF + Rr[i]) + (unsigned)Cc[i] * 2u;
    }
    f32x4 acc[2][2][4][2];
#pragma unroll
    for (int a = 0; a < 2; ++a)
#pragma unroll
        for (int b = 0; b < 2; ++b)
#pragma unroll
            for (int m = 0; m < 4; ++m)
#pragma unroll
                for (int n = 0; n < 2; ++n) acc[a][b][m][n] = (f32x4){0.f, 0.f, 0.f, 0.f};
    bf16x8 At[4][2], B0[2][2], B1[2][2];
    const char* cA = cur.A; const char* cB = cur.B;
    PG8_STAGE(PG8_SB(0, 0), cB, voffB); PG8_STAGE(PG8_SB(0, 1), cB + hstepB, voffB); PG8_STAGE(PG8_SA(0, 0), cA, vcur[0]); PG8_STAGE(PG8_SA(0, 1), cA, vcur[1]);
    if (wr == 1) PG8_BAR;
    PG8_WAIT_V(2); PG8_BAR;
    PG8_STAGE(PG8_SB(1, 0), cB + kstep, voffB); PG8_STAGE(PG8_SA(1, 0), cA + kstep, vcur[0]); PG8_STAGE(PG8_SB(1, 1), cB + hstepB + kstep, voffB);
    PG8_WAIT_V(6); PG8_BAR;
    for (;;) {
        const bool has_next = S.next(ui + 1, nxt);
        const char* nA = has_next ? nxt.A : cA; const char* nB = has_next ? nxt.B : cB;
        if constexpr (GATHER) {
#pragma unroll
            for (int h = 0; h < 2; ++h)
#pragma unroll
                for (int i = 0; i < 2; ++i) vnxt[h][i] = has_next ? (S.arow_off(nxt, h * HALF + Rr[i]) + (unsigned)Cc[i] * 2u) : vcur[h][i];
        }
        for (int t = 0; t < nt; t += 2) {
            const bool last = (t == nt - 2);
            if constexpr (MIDHOOK) { if (t == nt / 2) E.mid(acc, cur, wr, wc, fr, fq); }
            const char* a1 = cA + (size_t)(t + 1) * kstep;
            const char* a2 = last ? nA : cA + (size_t)(t + 2) * kstep; const char* b2 = last ? nB : cB + (size_t)(t + 2) * kstep;
            const char* a3 = a2 + kstep; const char* b3 = b2 + kstep;
            unsigned va2[2][2];
#pragma unroll
            for (int h = 0; h < 2; ++h)
#pragma unroll
                for (int i = 0; i < 2; ++i) va2[h][i] = (GATHER && last) ? vnxt[h][i] : vcur[h][i];
            PG8_LDB(B0, 0, 0); PG8_LDB(B1, 0, 1); PG8_SCHED; PG8_LDA(At, 0, 0); PG8_STAGE(PG8_SA(1, 1), a1, vcur[1]);
            static_assert(EPI_VM == 0 || EPI_VM == 8 || EPI_VM == 16, "EPI_VM");
            if (EPI_VM == 8) asm volatile("s_cmp_lg_u32 %0, 0\n\ts_cbranch_scc1 1f\n\ts_waitcnt vmcnt(16)\n\ts_branch 2f\n1:\n\ts_waitcnt vmcnt(8)\n2:" :: "s"(__builtin_amdgcn_readfirstlane(t | pfn)) : "memory", "scc");
            else if (EPI_VM == 16) asm volatile("s_cmp_lg_u32 %0, 0\n\ts_cbranch_scc1 1f\n\ts_waitcnt vmcnt(24)\n\ts_branch 2f\n1:\n\ts_waitcnt vmcnt(8)\n2:" :: "s"(__builtin_amdgcn_readfirstlane(t | pfn)) : "memory", "scc");
            else PG8_WAIT_V(8);
            PG8_WAIT_L(0); PG8_BAR; PG8_MMA(0, 0, At, B0); PG8_MMA(0, 1, At, B1); PG8_BAR; PG8_SCHED;
            PG8_LDA(At, 0, 1); PG8_STAGE(PG8_SB(0, 0), b2, voffB); PG8_STAGE(PG8_SB(0, 1), b2 + hstepB, voffB); PG8_STAGE(PG8_SA(0, 0), a2, va2[0]);
            PG8_WAIT_V(8); PG8_WAIT_L(0); PG8_BAR; PG8_MMA(1, 0, At, B0); PG8_MMA(1, 1, At, B1); PG8_BAR; PG8_SCHED;
            PG8_LDB(B0, 1, 0); PG8_LDB(B1, 1, 1); PG8_SCHED; PG8_LDA(At, 1, 0); PG8_STAGE(PG8_SA(0, 1), a2, va2[1]);
            PG8_WAIT_V(8); PG8_WAIT_L(0); PG8_BAR; PG8_MMA(0, 0, At, B0); PG8_MMA(0, 1, At, B1); PG8_BAR; PG8_SCHED;
            PG8_LDA(At, 1, 1); PG8_STAGE(PG8_SB(1, 0), b3, voffB); PG8_STAGE(PG8_SB(1, 1), b3 + hstepB, voffB); PG8_STAGE(PG8_SA(1, 0), a3, va2[0]);
            PG8_WAIT_V(8); PG8_WAIT_L(0); PG8_BAR; PG8_MMA(1, 0, At, B0); PG8_MMA(1, 1, At, B1); PG8_BAR; PG8_SCHED;
        }
        if constexpr (ALIGN_EPI) { if (wr == 0) PG8_BAR; }
        E(acc, cur, wr, wc, fr, fq);
        if (!has_next) break;
#pragma unroll
        for (int a = 0; a < 2; ++a)
#pragma unroll
            for (int b = 0; b < 2; ++b)
#pragma unroll
                for (int m = 0; m < 4; ++m)
#pragma unroll
                    for (int n = 0; n < 2; ++n) acc[a][b][m][n] = (f32x4){0.f, 0.f, 0.f, 0.f};
        pfn = (cur.nrows == BM) ? 0 : 1;
        cur = nxt; cA = nA; cB = nB; ++ui;
        if constexpr (GATHER) {
#pragma unroll
            for (int h = 0; h < 2; ++h)
#pragma unroll
                for (int i = 0; i < 2; ++i) vcur[h][i] = vnxt[h][i];
        }
        if constexpr (ALIGN_EPI) { if (wr == 1) PG8_BAR; }
    }
    PG8_WAIT_V(0);
    if constexpr (!ALIGN_EPI) { if (wr == 0) PG8_BAR; }
    PG8_BAR;
#undef PG8_SA
#undef PG8_SB
#undef PG8_STAGE
#undef PG8_LDA
#undef PG8_LDB
#undef PG8_MMA
#undef PG8_WAIT_V
#undef PG8_WAIT_L
#undef PG8_BAR
#undef PG8_SCHED
}

struct DenseOrder {
    const char* A; const char* Bt; int K, nM, nN, nwg, G, c;
    __device__ void init(const void* A_, const void* Bt_, int M, int N, int K_, int G_, int c_) { A = (const char*)A_; Bt = (const char*)Bt_; K = K_; nM = M / BM; nN = N / BM; nwg = nM * nN; G = G_; c = c_; }
    __device__ __forceinline__ bool next(int i, Unit& u) const {
        const long L = (long)i * G + c; if (L >= nwg) return false;
        int wgid = (int)L; { const int q = nwg / 8, r = nwg % 8, xcd = wgid % 8, off = wgid / 8; wgid = (xcd < r ? xcd * (q + 1) : r * (q + 1) + (xcd - r) * q) + off; }
        const int nig = 8 * nN, gid = wgid / nig, fm = gid * 8, gsz = (nM - fm) < 8 ? (nM - fm) : 8;
        const int pm = fm + ((wgid % nig) % gsz), pn = (wgid % nig) / gsz;
        u.A = A + (size_t)pm * BM * K * 2; u.B = Bt + (size_t)pn * BM * K * 2; u.row0 = pm * BM; u.col0 = pn * BM; u.nrows = BM; u.aux = pn; u.e = 0; u.ti = 0; u.ord = 0; return true;
    }
    __device__ __forceinline__ unsigned arow_off(const Unit&, int) const { return 0u; }
};
}

struct EpiQKV {
    static constexpr bool PERM = true;
    bf16_t* O; bf16_t* Gt;
    __device__ __forceinline__ void operator()(const f32x4 (&acc)[2][2][4][2], const pg8::Unit& u, int wr, int wc, int fr, int fq) const {
        const bool sig = u.aux >= 9;
        const int row0 = u.row0 + wr * 64 + fr, col0 = u.col0 + wc * 32 + 8 * fq;
        bf16_t* const base = sig ? Gt - QP : O; const int pitch = sig ? GP : QP;
#pragma unroll
        for (int ai = 0; ai < 2; ++ai)
#pragma unroll
            for (int m = 0; m < 4; ++m) { bf16_t* rowp = base + (size_t)(row0 + ai * 128 + m * 16) * pitch + col0;
#pragma unroll
                for (int bj = 0; bj < 2; ++bj) { f32x4 v0 = acc[ai][bj][m][0], v1 = acc[ai][bj][m][1];
                    if (sig) {
#pragma unroll
                        for (int j = 0; j < 4; ++j) { v0[j] = __builtin_amdgcn_rcpf(1.0f + __builtin_amdgcn_exp2f(-1.4426950408889634f * v0[j])); v1[j] = __builtin_amdgcn_rcpf(1.0f + __builtin_amdgcn_exp2f(-1.4426950408889634f * v1[j])); }
                    }
                    if (sig) { int w0 = 0, w1 = 0;
                        w0 = __builtin_amdgcn_cvt_pk_fp8_f32(v0[0] * 256.f, v0[1] * 256.f, w0, false); w0 = __builtin_amdgcn_cvt_pk_fp8_f32(v0[2] * 256.f, v0[3] * 256.f, w0, true);
                        w1 = __builtin_amdgcn_cvt_pk_fp8_f32(v1[0] * 256.f, v1[1] * 256.f, w1, false); w1 = __builtin_amdgcn_cvt_pk_fp8_f32(v1[2] * 256.f, v1[3] * 256.f, w1, true);
                        u32x2 w; w.x = (unsigned)w0; w.y = (unsigned)w1;
                        *(u32x2*)((unsigned char*)Gt + (size_t)(row0 + ai * 128 + m * 16) * GP + (col0 - QP) + bj * 128) = w;
                    } else {
                        u32x4 w; w.x = cvt_pk_bf16(v0[0], v0[1]); w.y = cvt_pk_bf16(v0[2], v0[3]); w.z = cvt_pk_bf16(v1[0], v1[1]); w.w = cvt_pk_bf16(v1[2], v1[3]);
                        *(u32x4*)(rowp + bj * 128) = w; } } }
    }
};

struct EpiMerge {
    static constexpr int PERM = 2;
    const bf16_t* Gt; bf16_t* O;
    __device__ __forceinline__ void mid(f32x4 (&acc)[2][2][4][2], const pg8::Unit& u, int wr, int wc, int fr, int fq) const {
        int row0 = u.row0 + wr * 64 + fr, col0 = u.col0 + wc * 64 + 16 * fq;
        asm volatile("" : "+v"(row0), "+v"(col0));
#pragma unroll
        for (int ai = 0; ai < 2; ++ai)
#pragma unroll
            for (int m = 0; m < 4; ++m) { const unsigned char* gp = (const unsigned char*)Gt + (size_t)(row0 + ai * 128 + m * 16) * GP + col0;
                const u32x4 a = *(const u32x4*)gp, b = *(const u32x4*)(gp + 1024);
#pragma unroll
                for (int d = 0; d < 4; ++d) {
                    const f32x2 al = __builtin_amdgcn_cvt_pk_f32_fp8((int)a[d], false), ah = __builtin_amdgcn_cvt_pk_f32_fp8((int)a[d], true);
                    const f32x2 bl = __builtin_amdgcn_cvt_pk_f32_fp8((int)b[d], false), bh = __builtin_amdgcn_cvt_pk_f32_fp8((int)b[d], true);
                    acc[ai][d >> 1][m][d & 1][0] *= al.x * __builtin_amdgcn_rcpf(fmaxf(bl.x, 1e-30f)); acc[ai][d >> 1][m][d & 1][1] *= al.y * __builtin_amdgcn_rcpf(fmaxf(bl.y, 1e-30f));
                    acc[ai][d >> 1][m][d & 1][2] *= ah.x * __builtin_amdgcn_rcpf(fmaxf(bh.x, 1e-30f)); acc[ai][d >> 1][m][d & 1][3] *= ah.y * __builtin_amdgcn_rcpf(fmaxf(bh.y, 1e-30f)); }
                asm volatile("" ::: "memory"); }
    }
    __device__ __forceinline__ void operator()(const f32x4 (&acc)[2][2][4][2], const pg8::Unit& u, int wr, int wc, int fr, int fq) const {
        int row0 = u.row0 + wr * 64 + fr, col0 = u.col0 + wc * 64 + 16 * fq;
        asm volatile("" : "+v"(row0), "+v"(col0));
#pragma unroll
        for (int ai = 0; ai < 2; ++ai)
#pragma unroll
            for (int m = 0; m < 4; ++m) { const unsigned char* gp = (const unsigned char*)Gt + (size_t)(row0 + ai * 128 + m * 16) * GP + col0; bf16_t* rowp = O + (size_t)(row0 + ai * 128 + m * 16) * D + col0;
                const u32x4 b = *(const u32x4*)(gp + 1024); float v[16];
#pragma unroll
                for (int d = 0; d < 4; ++d) { const f32x2 bl = __builtin_amdgcn_cvt_pk_f32_fp8((int)b[d], false), bh = __builtin_amdgcn_cvt_pk_f32_fp8((int)b[d], true);
                    v[4 * d] = acc[ai][d >> 1][m][d & 1][0] * (fmaxf(bl.x, 1e-30f) * 0.00390625f); v[4 * d + 1] = acc[ai][d >> 1][m][d & 1][1] * (fmaxf(bl.y, 1e-30f) * 0.00390625f);
                    v[4 * d + 2] = acc[ai][d >> 1][m][d & 1][2] * (fmaxf(bh.x, 1e-30f) * 0.00390625f); v[4 * d + 3] = acc[ai][d >> 1][m][d & 1][3] * (fmaxf(bh.y, 1e-30f) * 0.00390625f); }
                u32x4 w0, w1; w0.x = cvt_pk_bf16(v[0], v[1]); w0.y = cvt_pk_bf16(v[2], v[3]); w0.z = cvt_pk_bf16(v[4], v[5]); w0.w = cvt_pk_bf16(v[6], v[7]);
                w1.x = cvt_pk_bf16(v[8], v[9]); w1.y = cvt_pk_bf16(v[10], v[11]); w1.z = cvt_pk_bf16(v[12], v[13]); w1.w = cvt_pk_bf16(v[14], v[15]);
                *(u32x4*)rowp = w0; *(u32x4*)(rowp + 8) = w1;
                asm volatile("" ::: "memory"); }
    }
};
struct EpiWout {
    static constexpr bool PERM = true;
    const bf16_t* X; bf16_t* O;
    __device__ __forceinline__ void operator()(const f32x4 (&acc)[2][2][4][2], const pg8::Unit& u, int wr, int wc, int fr, int fq) const {
        int row0 = u.row0 + wr * 64 + fr, col0 = u.col0 + wc * 32 + 8 * fq;
        asm volatile("" : "+v"(row0), "+v"(col0));
#pragma unroll
        for (int ai = 0; ai < 2; ++ai)
#pragma unroll
            for (int m = 0; m < 4; ++m) { const size_t off = (size_t)(row0 + ai * 128 + m * 16) * D + col0;
#pragma unroll
                for (int bj = 0; bj < 2; ++bj) { const u32x4 xv = *(const u32x4*)(X + off + bj * 128);
                    f32x4 x0, x1; x0[0] = __builtin_bit_cast(float, xv[0] << 16); x0[1] = __builtin_bit_cast(float, xv[0] & 0xffff0000u); x0[2] = __builtin_bit_cast(float, xv[1] << 16); x0[3] = __builtin_bit_cast(float, xv[1] & 0xffff0000u);
                    x1[0] = __builtin_bit_cast(float, xv[2] << 16); x1[1] = __builtin_bit_cast(float, xv[2] & 0xffff0000u); x1[2] = __builtin_bit_cast(float, xv[3] << 16); x1[3] = __builtin_bit_cast(float, xv[3] & 0xffff0000u);
                    const f32x4 v0 = x0 * DN_ALPHA + acc[ai][bj][m][0], v1 = x1 * DN_ALPHA + acc[ai][bj][m][1];
                    u32x4 w; w.x = cvt_pk_bf16(v0[0], v0[1]); w.y = cvt_pk_bf16(v0[2], v0[3]); w.z = cvt_pk_bf16(v1[0], v1[1]); w.w = cvt_pk_bf16(v1[2], v1[3]);
                    *(u32x4*)(O + off + bj * 128) = w; }
                if (m & 1) asm volatile("" ::: "memory"); }
    }
};

__device__ __forceinline__ float wave_sum_x(float v) {
#pragma unroll
    for (int o = 1; o < 64; o <<= 1) v += __shfl_xor(v, o);
    return v;
}
__device__ __forceinline__ void ln_regs_to_bf16(const u32x4 a, const u32x4 c, bf16_t* orow, const f32x4 (&gv)[4], const f32x4 (&bv)[4], int lane) {
    float v[16];
#pragma unroll
    for (int j = 0; j < 4; ++j) { v[2 * j] = __builtin_bit_cast(float, a[j] << 16); v[2 * j + 1] = __builtin_bit_cast(float, a[j] & 0xffff0000u); v[8 + 2 * j] = __builtin_bit_cast(float, c[j] << 16); v[8 + 2 * j + 1] = __builtin_bit_cast(float, c[j] & 0xffff0000u); }
    float sm = 0.f;
#pragma unroll
    for (int j = 0; j < 16; ++j) sm += v[j];
    const float mean = wave_sum_x(sm) * (1.f / D); float s2 = 0.f;
#pragma unroll
    for (int j = 0; j < 16; ++j) { v[j] -= mean; s2 += v[j] * v[j]; }
    const float rstd = 1.f / sqrtf(wave_sum_x(s2) * (1.f / D) + LN_EPS);
    u32x4 o[2];
#pragma unroll
    for (int j = 0; j < 4; ++j) { const f32x4 gg = gv[j], bb = bv[j];
        const float y0 = v[4 * j] * rstd * gg.x + bb.x, y1 = v[4 * j + 1] * rstd * gg.y + bb.y, y2 = v[4 * j + 2] * rstd * gg.z + bb.z, y3 = v[4 * j + 3] * rstd * gg.w + bb.w;
        o[j >> 1][(j & 1) * 2] = pk2(y0, y1); o[j >> 1][(j & 1) * 2 + 1] = pk2(y2, y3); }
    *(u32x4*)(orow + 16 * lane) = o[0]; *(u32x4*)(orow + 16 * lane + 8) = o[1];
}

constexpr int NWAVES = 8;
constexpr int RING_BYTES = 131072, MISC_OFF = RING_BYTES + 320, LDS_BYTES = 147456;
struct EpiLogits {
    static constexpr bool PERM = false;
    float* O;
    __device__ __forceinline__ void operator()(const f32x4 (&acc)[2][2][4][2], const pg8::Unit& u, int wr, int wc, int fr, int fq) const {
        int row0 = u.row0 + wr * 64 + fr, col0 = u.col0 + wc * 32 + 4 * fq;
        asm volatile("" : "+v"(row0), "+v"(col0));
#pragma unroll
        for (int ai = 0; ai < 2; ++ai)
#pragma unroll
            for (int m = 0; m < 4; ++m) { const size_t off = (size_t)(row0 + ai * 128 + m * 16) * NE + col0;
#pragma unroll
                for (int bj = 0; bj < 2; ++bj)
#pragma unroll
                    for (int n = 0; n < 2; ++n) *(f32x4*)(O + off + bj * 128 + n * 16) = acc[ai][bj][m][n]; }
    }
};
struct MoeTables { LAS int* tn; LAS int* es; LAS int* us; };
struct MoeUnits { LAS int* rec; LAS int* cnt; LAS unsigned short* tok; };
template <int NPN> struct MoeOrder {
    MoeTables tb; MoeUnits mu; const char* Abase; const char* Bbase; size_t strideE, stridePN; size_t apitch;
    int chunk; int colw;
    __device__ __forceinline__ bool next(int i, pg8::Unit& u) const {
        if (i >= __builtin_amdgcn_readfirstlane(mu.cnt[0])) return false;
        const int e = __builtin_amdgcn_readfirstlane(mu.rec[4 * i]), ti = __builtin_amdgcn_readfirstlane(mu.rec[4 * i + 1]), pn = __builtin_amdgcn_readfirstlane(mu.rec[4 * i + 2]);
        const int ne = __builtin_amdgcn_readfirstlane(tb.tn[e]), e0 = __builtin_amdgcn_readfirstlane(tb.es[e]);
        u.e = e; u.ti = ti; u.aux = pn; u.ord = i; u.row0 = e0 + ti * 256; u.nrows = (ne - ti * 256) < 256 ? (ne - ti * 256) : 256; u.col0 = pn * colw;
        u.A = Abase + (size_t)u.row0 * apitch; u.B = Bbase + (size_t)e * strideE + (size_t)pn * stridePN;
        return true;
    }
    __device__ __forceinline__ unsigned arow_off(const pg8::Unit& u, int r) const { return (unsigned)(chunk * CHT + (int)mu.tok[u.ord * 256 + r]) * (unsigned)(D * 2); }
};
template <int NPN, bool GATHER> __device__ __forceinline__ void moe_units(const MoeTables& tb, const MoeUnits& mu, int G, int c, int tid, const unsigned short* list, int chunk) {
    __syncthreads();
    const int NU = tb.us[257] * NPN;
    if (tid < 24) {
        const long L = (long)tid * G + c;
        if (L < NU) {
            int wgid = (int)L; { const int q = NU / 8, r = NU % 8, xcd = wgid % 8, off = wgid / 8; wgid = (xcd < r ? xcd * (q + 1) : r * (q + 1) + (xcd - r) * q) + off; }
            const int rt = wgid / NPN, pn = wgid % NPN;
            int lo = 0, hi = 257;
            while (hi - lo > 1) { const int mid = (lo + hi) >> 1; if (tb.us[mid] <= rt) lo = mid; else hi = mid; }
            mu.rec[4 * tid] = lo; mu.rec[4 * tid + 1] = rt - tb.us[lo]; mu.rec[4 * tid + 2] = pn;
        }
    }
    const int n = c < NU ? (NU - 1 - c) / G + 1 : 0;
    if (tid == 0) mu.cnt[0] = n < 24 ? n : 24;
    __syncthreads();
    if (GATHER) {
        const int nn = n < 16 ? n : 16;
        for (int x = tid; x < nn * 256; x += NWAVES * 64) { const int ui = x >> 8, r = x & 255, e = mu.rec[4 * ui], ti = mu.rec[4 * ui + 1];
            const int nr = tb.tn[e] - ti * 256, rr = r < nr ? r : nr - 1; int tl = ti * 256 + rr;
            if (e < 256) tl = (int)list[((size_t)chunk * 256 + e) * CHT + tl];
            mu.tok[x] = (unsigned short)tl; }
        __syncthreads();
    }
}
struct EpiGLU {
    static constexpr bool PERM = true;
    bf16_t* HB;
    __device__ __forceinline__ void operator()(const f32x4 (&acc)[2][2][4][2], const pg8::Unit& u, int wr, int wc, int fr, int fq) const {
        int rt0 = wr * 64 + fr, col0 = u.col0 + wc * 32 + 8 * fq;
        asm volatile("" : "+v"(rt0), "+v"(col0));
#pragma unroll
        for (int ai = 0; ai < 2; ++ai)
#pragma unroll
            for (int m = 0; m < 4; ++m) { int rt = rt0 + ai * 128 + m * 16;
                asm volatile("" : "+v"(rt));
                float v[8];
#pragma unroll
                for (int j = 0; j < 8; ++j) { const float g = acc[ai][0][m][j >> 2][j & 3], up = acc[ai][1][m][j >> 2][j & 3];
                    v[j] = g * __builtin_amdgcn_rcpf(1.0f + __builtin_amdgcn_exp2f(-1.4426950408889634f * g)) * up; }
                u32x4 w; w.x = cvt_pk_bf16(v[0], v[1]); w.y = cvt_pk_bf16(v[2], v[3]); w.z = cvt_pk_bf16(v[4], v[5]); w.w = cvt_pk_bf16(v[6], v[7]);
                if (rt < u.nrows) *(u32x4*)(HB + (size_t)(u.row0 + rt) * EH + col0) = w; }
    }
};
struct EpiDown {
    static constexpr int PERM = 2;
    unsigned char* Y8; bf16_t* YS; const bf16_t* H1; int chunk;
    __device__ __forceinline__ void operator()(const f32x4 (&acc)[2][2][4][2], const pg8::Unit& u, int wr, int wc, int fr, int fq) const {
        int rt0 = wr * 64 + fr, col0 = u.col0 + wc * 64 + 16 * fq;
        asm volatile("" : "+v"(rt0), "+v"(col0));
        const bool shared = u.e == 256;
#pragma unroll
        for (int ai = 0; ai < 2; ++ai)
#pragma unroll
            for (int m = 0; m < 4; ++m) { int rt = rt0 + ai * 128 + m * 16;
                asm volatile("" : "+v"(rt));
                if (rt < u.nrows) {
                    float v[16];
#pragma unroll
                    for (int j = 0; j < 16; ++j) v[j] = acc[ai][j >> 3][m][(j >> 2) & 1][j & 3];
                    if (shared) { const bf16_t* hp = H1 + (size_t)(chunk * CHT + u.ti * 256 + rt) * D + col0; const u32x4 h0 = *(const u32x4*)hp, h1 = *(const u32x4*)(hp + 8);
#pragma unroll
                        for (int j = 0; j < 4; ++j) { v[2 * j] += DN_ALPHA * __builtin_bit_cast(float, h0[j] << 16); v[2 * j + 1] += DN_ALPHA * __builtin_bit_cast(float, h0[j] & 0xffff0000u);
                            v[8 + 2 * j] += DN_ALPHA * __builtin_bit_cast(float, h1[j] << 16); v[8 + 2 * j + 1] += DN_ALPHA * __builtin_bit_cast(float, h1[j] & 0xffff0000u); }
                        u32x4 w0, w1; w0.x = cvt_pk_bf16(v[0], v[1]); w0.y = cvt_pk_bf16(v[2], v[3]); w0.z = cvt_pk_bf16(v[4], v[5]); w0.w = cvt_pk_bf16(v[6], v[7]);
                        w1.x = cvt_pk_bf16(v[8], v[9]); w1.y = cvt_pk_bf16(v[10], v[11]); w1.z = cvt_pk_bf16(v[12], v[13]); w1.w = cvt_pk_bf16(v[14], v[15]);
                        bf16_t* yp = YS + (size_t)(u.ti * 256 + rt) * D + col0; *(u32x4*)yp = w0; *(u32x4*)(yp + 8) = w1;
                    } else { int w[4] = {0, 0, 0, 0};
#pragma unroll
                        for (int d = 0; d < 4; ++d) { w[d] = __builtin_amdgcn_cvt_pk_fp8_f32(v[4 * d] * 16.f, v[4 * d + 1] * 16.f, w[d], false); w[d] = __builtin_amdgcn_cvt_pk_fp8_f32(v[4 * d + 2] * 16.f, v[4 * d + 3] * 16.f, w[d], true); }
                        u32x4 ww; ww.x = (unsigned)w[0]; ww.y = (unsigned)w[1]; ww.z = (unsigned)w[2]; ww.w = (unsigned)w[3];
                        *(u32x4*)(Y8 + (size_t)(u.row0 + rt) * D + col0) = ww; } }
                asm volatile("" ::: "memory"); }
    }
};

constexpr size_t WS_W1T = 15 * MiB;
constexpr size_t WS_W2T = 16 * MiB;
constexpr size_t WS_C1 = 16 * MiB + 65536;
namespace att {
constexpr float LOG2E = 1.4426950408889634f;
constexpr float C2 = 0.125f * LOG2E;
constexpr float THR = 8.0f;
constexpr int NB = 2;
constexpr int L_KV = 0, L_IMP = 65536, L_SELM = 98304, L_UW = 99584, L_JL = 99616, L_BIAS = 99840, L_HID = 108288, L_END = 112640;
constexpr int MODE_C1 = 0, MODE_C2 = 1, MODE_SEL = 2, MODE_WIN = 3, MODE_SWA = 4;
struct Ctx {
    LAS unsigned char* lds; int tid, lane, wave;
    const bf16_t* qkv_b;
    const bf16_t* kc; const bf16_t* vc;
    int cur, g;
};
__device__ __forceinline__ float ex2(float x) { return __builtin_amdgcn_exp2f(x); }
__device__ __forceinline__ float colmax4(float x) { x = fmaxf(x, __shfl_xor(x, 16)); return fmaxf(x, __shfl_xor(x, 32)); }
__device__ __forceinline__ float col_sum4(float x) { x += __shfl_xor(x, 16); return x + __shfl_xor(x, 32); }
__device__ __forceinline__ float quad_sum(float x) {
    x += __builtin_bit_cast(float, __builtin_amdgcn_update_dpp(0u, __builtin_bit_cast(unsigned, x), 0xB1, 0xF, 0xF, true));
    x += __builtin_bit_cast(float, __builtin_amdgcn_update_dpp(0u, __builtin_bit_cast(unsigned, x), 0x4E, 0xF, 0xF, true));
    return x;
}
__device__ __forceinline__ void glds16(const void* gsrc, unsigned lds_dst) { unsigned keep;
    asm volatile("s_mov_b32 %0, m0\n\ts_mov_b32 m0, %2\n\ts_nop 0\n\tglobal_load_lds_dwordx4 %1, off\n\ts_mov_b32 m0, %0" : "=&s"(keep) : "v"(gsrc), "s"(lds_dst) : "memory"); }
template <int MODE> __device__ __forceinline__ void blk_dma(const Ctx& c, int j, int slot) {
    const int key = c.tid >> 3, chs = c.tid & 7;
    const int kch = chs ^ (key & 7), vch = chs ^ (((key >> 1) & 3) << 1);
    const unsigned dst = (unsigned)__builtin_amdgcn_readfirstlane((int)(unsigned)(uintptr_t)(c.lds + L_KV + slot * 16384 + c.wave * 1024));
    if (MODE <= MODE_C2) { const size_t o = (size_t)(64 * j + key) * 128;
        glds16(c.kc + o + kch * 8, dst);
        if (MODE == MODE_C2) glds16(c.vc + o + vch * 8, dst + 8192u);
    } else { constexpr int KC = MODE == MODE_SEL ? C_KS : (MODE == MODE_WIN ? C_KW : C_KB), VC = MODE == MODE_SEL ? C_VS : (MODE == MODE_WIN ? C_VW : C_VB);
        const bf16_t* rp = c.qkv_b + (size_t)(64 * j + key) * QP + c.g * 64;
        glds16(rp + KC + kch * 8, dst);
        glds16(rp + VC + vch * 8, dst + 8192u); }
}
struct NoDma { __device__ __forceinline__ void operator()(int) const {} };
template <int MODE, bool PRE = false, class NextDma = NoDma> __device__ __forceinline__ void branch(const Ctx& c, const bf16x8 (&Qf)[2][2], f32x4 (&O)[2][4], float (&m)[2], float (&l)[2], const float (&invl)[2], int nblk, int j0, int hh, int par = 0, NextDma nextdma = NoDma()) {
    const int lane = c.lane, q = lane >> 4, cc = lane & 15;
    const LAS unsigned char* jl = c.lds + L_JL;
    const LAS float* biasL = (const LAS float*)(c.lds + L_BIAS) + hh * 132;
    LAS float* impL = (LAS float*)(c.lds + L_IMP);
    const LAS unsigned* selm = (const LAS unsigned*)(c.lds + L_SELM);
    const float c31 = biasL[128];
    const int nstage = (nblk + NB - 1) / NB;
    if (!PRE) {
#pragma unroll
        for (int bi = 0; bi < NB; ++bi) if (bi < nblk) blk_dma<MODE>(c, (MODE == MODE_SEL) ? (int)jl[bi] : j0 + bi, par * NB + bi);
    }
    asm volatile("s_waitcnt vmcnt(0)" ::: "memory");
    __syncthreads();
    const int kaddr0 = cc * 128 + (((0 + q) ^ (lane & 7)) << 4), kaddr1 = cc * 128 + (((4 + q) ^ (lane & 7)) << 4);
    const int vsw = ((2 * q + (cc >> 3)) & 3) << 1, vkey = (4 * q + (cc >> 2)) * 128, vb = (cc & 3) >> 1, vwi = (cc & 1) * 8;
    for (int st = 0; st < nstage; ++st) {
        if (st + 1 < nstage) {
#pragma unroll
            for (int bi = 0; bi < NB; ++bi) { const int i2 = (st + 1) * NB + bi; if (i2 < nblk) blk_dma<MODE>(c, (MODE == MODE_SEL) ? (int)jl[i2] : j0 + i2, ((st + 1 + par) & 1) * NB + bi); }
        } else nextdma((st + 1 + par) & 1);
#pragma unroll
        for (int bi = 0; bi < NB; ++bi) {
            const int i = st * NB + bi;
            if (i >= nblk) break;
            const int j = (MODE == MODE_SEL) ? (int)jl[i] : j0 + i;
            const LAS unsigned char* Kb = c.lds + L_KV + (((st + par) & 1) * NB + bi) * 16384;
            const LAS unsigned char* Vb = Kb + 8192;
            const int back = c.cur - j;
            bool far;
            if (MODE <= MODE_C2) far = !(64 * (j + 1) > 4 * c.cur - 10);
            else far = back >= 3 && !(MODE == MODE_WIN && back == 8);
            bool act[2] = {true, true}, own[2] = {true, true};
            if (MODE == MODE_SEL) {
#pragma unroll
                for (int a = 0; a < 2; ++a) { const unsigned uw = selm[256 + (2 * c.wave + a) * 4 + (j >> 5)];
                    act[a] = __builtin_amdgcn_readfirstlane((uw >> (j & 31)) & 1u) != 0;
                    own[a] = (selm[(8 * c.wave + 4 * a + (cc >> 2)) * 4 + (j >> 5)] >> (j & 31)) & 1u; }
                if (!act[0] && !act[1]) continue;
            }
            bf16x8 Kf[4][2];
#pragma unroll
            for (int kt = 0; kt < 4; ++kt) { Kf[kt][0] = *(const LAS bf16x8*)(Kb + kt * 2048 + kaddr0); Kf[kt][1] = *(const LAS bf16x8*)(Kb + kt * 2048 + kaddr1); }
            f32x4 s[2][4];
#pragma unroll
            for (int a = 0; a < 2; ++a) {
                if (!act[a]) continue;
#pragma unroll
                for (int kt = 0; kt < 4; ++kt) {
                    s[a][kt] = __builtin_amdgcn_mfma_f32_16x16x32_bf16(Kf[kt][0], Qf[a][0], (f32x4){0.f, 0.f, 0.f, 0.f}, 0, 0, 0);
                    s[a][kt] = __builtin_amdgcn_mfma_f32_16x16x32_bf16(Kf[kt][1], Qf[a][1], s[a][kt], 0, 0, 0);
                }
            }
            bf16x8 Vf[4][2];
            if (MODE != MODE_C1) {
#pragma unroll
                for (int mt = 0; mt < 4; ++mt) { const int va = vkey + ((((2 * mt) ^ vsw) + vb) << 4) + vwi;
#pragma unroll
                    for (int k2 = 0; k2 < 2; ++k2) {
                        const v4i16_t lo = __builtin_amdgcn_ds_read_tr16_b64_v4i16((LAS v4i16_t*)(Vb + (2 * k2) * 2048 + va));
                        const v4i16_t hi = __builtin_amdgcn_ds_read_tr16_b64_v4i16((LAS v4i16_t*)(Vb + (2 * k2 + 1) * 2048 + va));
                        Vf[mt][k2] = (bf16x8){lo[0], lo[1], lo[2], lo[3], hi[0], hi[1], hi[2], hi[3]}; } }
            }
#pragma unroll
            for (int a = 0; a < 2; ++a) {
                if (!act[a]) continue;
                const int tl = 8 * c.wave + 4 * a + (cc >> 2);
                if (far) {
                    const float cb = own[a] ? c31 : -INFINITY;
#pragma unroll
                    for (int kt = 0; kt < 4; ++kt)
#pragma unroll
                        for (int r = 0; r < 4; ++r) s[a][kt][r] = fmaf(s[a][kt][r], C2, cb);
                } else if (MODE <= MODE_C2) {
                    const int dd0 = 64 * c.cur + tl - 1024 * j - 31;
#pragma unroll
                    for (int kt = 0; kt < 4; ++kt)
#pragma unroll
                        for (int r = 0; r < 4; ++r) { const int d = dd0 - 16 * (16 * kt + 4 * q + r);
                            s[a][kt][r] = fmaf(s[a][kt][r], C2, biasL[d < 0 ? 0 : (d > 128 ? 128 : d)]) + (d >= 0 ? 0.f : -INFINITY); }
                } else {
                    const int dd0 = 64 * back + tl;
                    const int hi_lim = (MODE == MODE_WIN) ? 512 : (MODE == MODE_SWA ? 128 : (1 << 30));
#pragma unroll
                    for (int kt = 0; kt < 4; ++kt)
#pragma unroll
                        for (int r = 0; r < 4; ++r) { const int d = dd0 - (16 * kt + 4 * q + r);
                            s[a][kt][r] = fmaf(s[a][kt][r], C2, biasL[d < 0 ? 0 : (d > 128 ? 128 : d)]) + (((unsigned)d < (unsigned)hi_lim && own[a]) ? 0.f : -INFINITY); }
                }
                if (MODE != MODE_C2) {
                    float bm = fmaxf(fmaxf(fmaxf(s[a][0][0], s[a][0][1]), fmaxf(s[a][0][2], s[a][0][3])), fmaxf(fmaxf(s[a][1][0], s[a][1][1]), fmaxf(s[a][1][2], s[a][1][3])));
                    bm = fmaxf(bm, fmaxf(fmaxf(fmaxf(s[a][2][0], s[a][2][1]), fmaxf(s[a][2][2], s[a][2][3])), fmaxf(fmaxf(s[a][3][0], s[a][3][1]), fmaxf(s[a][3][2], s[a][3][3]))));
                    if (__any(bm > m[a] + THR)) {
                        bm = colmax4(bm);
                        const float mn = fmaxf(m[a], bm);
                        const float alpha = (mn == m[a]) ? 1.0f : ex2(m[a] - mn);
                        m[a] = mn; l[a] *= alpha;
                        if (MODE != MODE_C1) {
#pragma unroll
                            for (int mt = 0; mt < 4; ++mt) O[a][mt] = O[a][mt] * alpha;
                        }
                    }
                }
                const float mu = (m[a] == -INFINITY) ? 0.f : m[a];
                float ps = 0.f;
#pragma unroll
                for (int kt = 0; kt < 4; ++kt)
#pragma unroll
                    for (int r = 0; r < 4; ++r) { float p = ex2(s[a][kt][r] - mu); if (MODE == MODE_C2) p *= invl[a]; s[a][kt][r] = p; ps += p; }
                l[a] += ps;
                if (MODE == MODE_C2) {
#pragma unroll
                    for (int kt = 0; kt < 4; ++kt) {
                        const float s4 = quad_sum((s[a][kt][0] + s[a][kt][1]) + (s[a][kt][2] + s[a][kt][3])), lastv = quad_sum(s[a][kt][3]);
                        const int jp = 16 * j + 4 * kt + q;
                        if ((cc & 3) == 0) { __hip_atomic_fetch_add(impL + tl * 128 + jp, s4, __ATOMIC_RELAXED, __HIP_MEMORY_SCOPE_WORKGROUP);
                            if (jp < 127) __hip_atomic_fetch_add(impL + tl * 128 + jp + 1, lastv, __ATOMIC_RELAXED, __HIP_MEMORY_SCOPE_WORKGROUP); }
                    }
                }
            }
            if (MODE == MODE_C1) continue;
#pragma unroll
            for (int a = 0; a < 2; ++a) {
                if (!act[a]) continue;
                bf16x8 Pf[2];
#pragma unroll
                for (int k2 = 0; k2 < 2; ++k2) { u32x4 w; w.x = cvt_pk_bf16(s[a][2 * k2][0], s[a][2 * k2][1]); w.y = cvt_pk_bf16(s[a][2 * k2][2], s[a][2 * k2][3]); w.z = cvt_pk_bf16(s[a][2 * k2 + 1][0], s[a][2 * k2 + 1][1]); w.w = cvt_pk_bf16(s[a][2 * k2 + 1][2], s[a][2 * k2 + 1][3]);
                    Pf[k2] = __builtin_bit_cast(bf16x8, w); }
#pragma unroll
                for (int mt = 0; mt < 4; ++mt)
#pragma unroll
                    for (int k2 = 0; k2 < 2; ++k2) O[a][mt] = __builtin_amdgcn_mfma_f32_16x16x32_bf16(Vf[mt][k2], Pf[k2], O[a][mt], 0, 0, 0);
            }
        }
        asm volatile("s_waitcnt vmcnt(0)" ::: "memory");
        __syncthreads();
    }
}
__device__ __forceinline__ void clearO(f32x4 (&O)[2][4], float (&m)[2], float (&l)[2], float m0) {
#pragma unroll
    for (int a = 0; a < 2; ++a) { m[a] = m0; l[a] = 0.f;
#pragma unroll
        for (int mt = 0; mt < 4; ++mt) O[a][mt] = (f32x4){0.f, 0.f, 0.f, 0.f}; }
}

__device__ __forceinline__ void store_orow(bf16_t* obase, int q, const u32x2 (&w)[4]) {
#pragma unroll
    for (int p = 0; p < 2; ++p) { u32x2 a = w[2 * p], b = w[2 * p + 1];
        const auto r0 = __builtin_amdgcn_permlane16_swap(a.x, b.x, false, false); a.x = r0[0]; b.x = r0[1];
        const auto r1 = __builtin_amdgcn_permlane16_swap(a.y, b.y, false, false); a.y = r1[0]; b.y = r1[1];
        u32x4 v; v.x = a.x; v.y = a.y; v.z = b.x; v.w = b.y;
        *(u32x4*)(obase + 16 * (2 * p + (q & 1)) + 8 * (q >> 1)) = v; }
}
__device__ __forceinline__ void unit(LAS unsigned char* lds, int tid, int lane, int wave, const bf16_t* qkvg, const bf16_t* kcmp, const bf16_t* vcmp, const float* sinks, bf16_t* oab, int b, int g, int cur) {
    Ctx c; c.lds = lds; c.tid = tid; c.lane = lane; c.wave = wave; c.qkv_b = qkvg + (size_t)b * S * QP; c.kc = kcmp + (size_t)b * 512 * 128 + g * 64; c.vc = vcmp + (size_t)b * 512 * 128 + g * 64; c.cur = cur; c.g = g;
    const int q = lane >> 4, cc = lane & 15, hr = cc & 3, hA = g * 4 + hr;
    const int t0 = 64 * cur;
    LAS unsigned* selm = (LAS unsigned*)(lds + L_SELM); LAS unsigned* uwp = (LAS unsigned*)(lds + L_UW); LAS unsigned char* jl = lds + L_JL;
    LAS float* impL = (LAS float*)(lds + L_IMP);
    bf16x8 Qf[2][2];
    f32x4 O[2][4]; float m[2], l[2], invl[2] = {1.f, 1.f};
    LAS u32x2* stash = (LAS u32x2*)(lds + L_IMP) + wave * 512 + lane;
#pragma unroll
    for (int a = 0; a < 2; ++a) { const bf16_t* qrow = c.qkv_b + (size_t)(t0 + 8 * wave + 4 * a + (cc >> 2)) * QP;
        Qf[a][0] = *(const bf16x8*)(qrow + C_QA + hA * 64 + 8 * q); Qf[a][1] = *(const bf16x8*)(qrow + C_QA + hA * 64 + 32 + 8 * q); }
    { const u32x4 z = {0u, 0u, 0u, 0u};
#pragma unroll
      for (int i = 0; i < 4; ++i) *(LAS u32x4*)(lds + L_IMP + (i * 512 + tid) * 16) = z; }
    const int nbc = (4 * cur + 3 + 63) >> 6;
    clearO(O, m, l, -INFINITY);
    const int nstc = (nbc + NB - 1) / NB;
    branch<MODE_C1>(c, Qf, O, m, l, invl, nbc, 0, hA, 0, [&](int p) {
#pragma unroll
        for (int bi = 0; bi < NB; ++bi) if (bi < nbc) blk_dma<MODE_C2>(c, bi, p * NB + bi); });
#pragma unroll
    for (int a = 0; a < 2; ++a) invl[a] = 1.0f / fmaxf(col_sum4(l[a]), 1e-30f);
    branch<MODE_C2, true>(c, Qf, O, m, l, invl, nbc, 0, hA, nstc & 1);
    {
        unsigned long long un_lo[2] = {0ull, 0ull}, un_hi[2] = {0ull, 0ull};
        for (int i = 0; i < 8; ++i) {
            const int tok = 8 * wave + i;
            unsigned long long mlo, mhi = 0ull;
            if (cur <= 7) mlo = (2ull << cur) - 1ull;
            else {
                mlo = 1ull;
                if (cur - 1 < 64) mlo |= 1ull << (cur - 1); else mhi |= 1ull << (cur - 65);
                if (cur < 64) mlo |= 1ull << cur; else mhi |= 1ull << (cur - 64);
                const bool ok0 = lane >= 1 && lane <= cur - 2, ok1 = lane + 64 <= cur - 2;
                const unsigned k0 = ok0 ? __builtin_bit_cast(unsigned, impL[tok * 128 + lane]) + 1u : 0u;
                const unsigned k1 = ok1 ? __builtin_bit_cast(unsigned, impL[tok * 128 + 64 + lane]) + 1u : 0u;
                unsigned T = 0u;
                for (int bit = 31; bit >= 16; --bit) { const unsigned cand = T | (1u << bit);
                    const int cnt = __popcll(__ballot(k0 >= cand)) + __popcll(__ballot(k1 >= cand));
                    if (cnt >= 5) T = cand; }
                unsigned long long G0 = __ballot(k0 >= T), G1 = __ballot(k1 >= T), S0 = 0ull, S1 = 0ull;
                if (__popcll(G0) + __popcll(G1) != 5) {
                    for (int bit = 15; bit >= 8; --bit) { const unsigned cand = T | (1u << bit);
                        const int cnt = __popcll(__ballot(k0 >= cand)) + __popcll(__ballot(k1 >= cand));
                        if (cnt >= 5) T = cand; }
                    G0 = __ballot(k0 >= T); G1 = __ballot(k1 >= T);
                }
                if (__popcll(G0) + __popcll(G1) != 5) {
                    for (int bit = 7; bit >= 0; --bit) { const unsigned cand = T | (1u << bit);
                        const int cnt = __popcll(__ballot(k0 >= cand)) + __popcll(__ballot(k1 >= cand));
                        if (cnt >= 5) T = cand; }
                    G0 = __ballot(k0 > T); G1 = __ballot(k1 > T);
                    unsigned long long E0 = __ballot(k0 == T), E1 = __ballot(k1 == T);
                    int need = 5 - (__popcll(G0) + __popcll(G1));
                    while (need > 0 && E0) { const unsigned long long b_ = E0 & (0ull - E0); S0 |= b_; E0 ^= b_; --need; }
                    while (need > 0 && E1) { const unsigned long long b_ = E1 & (0ull - E1); S1 |= b_; E1 ^= b_; --need; }
                }
                mlo |= G0 | S0; mhi |= G1 | S1;
            }
            if (lane == 0) { selm[tok * 4 + 0] = (unsigned)mlo; selm[tok * 4 + 1] = (unsigned)(mlo >> 32); selm[tok * 4 + 2] = (unsigned)mhi; selm[tok * 4 + 3] = (unsigned)(mhi >> 32); }
            un_lo[i >> 2] |= mlo; un_hi[i >> 2] |= mhi;
        }
        if (lane == 0) {
#pragma unroll
            for (int a = 0; a < 2; ++a) { LAS unsigned* up = selm + 256 + (2 * wave + a) * 4; up[0] = (unsigned)un_lo[a]; up[1] = (unsigned)(un_lo[a] >> 32); up[2] = (unsigned)un_hi[a]; up[3] = (unsigned)(un_hi[a] >> 32); }
        }
    }
    __syncthreads();
    if (wave == 0) {
        unsigned long long ulo = 0ull, uhi = 0ull;
#pragma unroll
        for (int k = 0; k < 16; ++k) { ulo |= (unsigned long long)selm[256 + 4 * k] | ((unsigned long long)selm[256 + 4 * k + 1] << 32); uhi |= (unsigned long long)selm[256 + 4 * k + 2] | ((unsigned long long)selm[256 + 4 * k + 3] << 32); }
        const unsigned long long below = (1ull << lane) - 1ull;
        const int nlo = __popcll(ulo);
        if ((ulo >> lane) & 1ull) jl[__popcll(ulo & below)] = (unsigned char)lane;
        if ((uhi >> lane) & 1ull) jl[nlo + __popcll(uhi & below)] = (unsigned char)(64 + lane);
        if (lane == 0) uwp[4] = (unsigned)(nlo + __popcll(uhi));
    }
    __syncthreads();
    const int nsel = __builtin_amdgcn_readfirstlane((int)uwp[4]);
#pragma unroll
    for (int a = 0; a < 2; ++a) { const float sc = 1.0f / (1.0f + ex2(-LOG2E * bf2f(c.qkv_b[(size_t)(t0 + 8 * wave + 4 * a + (cc >> 2)) * QP + C_GA + hA * 3 + 0])));
#pragma unroll
        for (int mt = 0; mt < 4; ++mt) { const f32x4 o = O[a][mt] * sc; u32x2 w; w.x = cvt_pk_bf16(o[0], o[1]); w.y = cvt_pk_bf16(o[2], o[3]); stash[(a * 4 + mt) * 64] = w; } }
    clearO(O, m, l, -INFINITY);
    const int jw0 = cur >= 8 ? cur - 8 : 0, nwin = cur - jw0 + 1, jb0 = cur >= 2 ? cur - 2 : 0, nswa = cur - jb0 + 1;
    const int pwin = ((nsel + NB - 1) / NB) & 1, pswa = (pwin + (nwin + NB - 1) / NB) & 1;
    branch<MODE_SEL>(c, Qf, O, m, l, invl, nsel, 0, hA, 0, [&](int p) {
#pragma unroll
        for (int bi = 0; bi < NB; ++bi) if (bi < nwin) blk_dma<MODE_WIN>(c, jw0 + bi, p * NB + bi); });
#pragma unroll
    for (int a = 0; a < 2; ++a) { const float sc = (1.0f / (1.0f + ex2(-LOG2E * bf2f(c.qkv_b[(size_t)(t0 + 8 * wave + 4 * a + (cc >> 2)) * QP + C_GA + hA * 3 + 1])))) / fmaxf(col_sum4(l[a]), 1e-30f);
#pragma unroll
        for (int mt = 0; mt < 4; ++mt) { const u32x2 pv = stash[(a * 4 + mt) * 64]; f32x4 o = O[a][mt] * sc;
            o[0] += __builtin_bit_cast(float, pv.x << 16); o[1] += __builtin_bit_cast(float, pv.x & 0xffff0000u); o[2] += __builtin_bit_cast(float, pv.y << 16); o[3] += __builtin_bit_cast(float, pv.y & 0xffff0000u);
            u32x2 w; w.x = cvt_pk_bf16(o[0], o[1]); w.y = cvt_pk_bf16(o[2], o[3]); stash[(a * 4 + mt) * 64] = w; } }
    clearO(O, m, l, -INFINITY);
    branch<MODE_WIN, true>(c, Qf, O, m, l, invl, nwin, jw0, hA, pwin, [&](int p) {
#pragma unroll
        for (int bi = 0; bi < NB; ++bi) if (bi < nswa) blk_dma<MODE_SWA>(c, jb0 + bi, p * NB + bi); });
#pragma unroll
    for (int a = 0; a < 2; ++a) { const float sc = (1.0f / (1.0f + ex2(-LOG2E * bf2f(c.qkv_b[(size_t)(t0 + 8 * wave + 4 * a + (cc >> 2)) * QP + C_GA + hA * 3 + 2])))) / fmaxf(col_sum4(l[a]), 1e-30f);
        bf16_t* orow = oab + (size_t)(b * S + t0 + 8 * wave + 4 * a + (cc >> 2)) * D + hA * 64;
        u32x2 w[4];
#pragma unroll
        for (int mt = 0; mt < 4; ++mt) { const u32x2 pv = stash[(a * 4 + mt) * 64]; f32x4 o = O[a][mt] * sc;
            o[0] += __builtin_bit_cast(float, pv.x << 16); o[1] += __builtin_bit_cast(float, pv.x & 0xffff0000u); o[2] += __builtin_bit_cast(float, pv.y << 16); o[3] += __builtin_bit_cast(float, pv.y & 0xffff0000u);
            w[mt].x = cvt_pk_bf16(o[0], o[1]); w[mt].y = cvt_pk_bf16(o[2], o[3]); }
        store_orow(orow, q, w); }
    const float sk2 = sinks[hA] * LOG2E;
#pragma unroll
    for (int a = 0; a < 2; ++a) { const bf16_t* qrow = c.qkv_b + (size_t)(t0 + 8 * wave + 4 * a + (cc >> 2)) * QP;
        Qf[a][0] = *(const bf16x8*)(qrow + C_QB + hA * 64 + 8 * q); Qf[a][1] = *(const bf16x8*)(qrow + C_QB + hA * 64 + 32 + 8 * q); }
    clearO(O, m, l, sk2);
    branch<MODE_SWA, true>(c, Qf, O, m, l, invl, nswa, jb0, 8 + hA, pswa);
#pragma unroll
    for (int a = 0; a < 2; ++a) { const float sc = 1.0f / (col_sum4(l[a]) + ex2(sk2 - m[a]));
        bf16_t* orow = oab + (size_t)(b * S + t0 + 8 * wave + 4 * a + (cc >> 2)) * D + 512 + hA * 64;
        u32x2 w[4];
#pragma unroll
        for (int mt = 0; mt < 4; ++mt) { const f32x4 o = O[a][mt] * sc; w[mt].x = cvt_pk_bf16(o[0], o[1]); w[mt].y = cvt_pk_bf16(o[2], o[3]); }
        store_orow(orow, q, w); }
}

constexpr int CMP_PITCH = 144, CMP_NCH = 272 * 8;
__device__ __forceinline__ void compress_load(const bf16_t* qkvg, int u, int tid, u32x4 (&r)[5]) {
    const int nt = u & 31, g = (u >> 5) & 1, b = (u >> 6) & 7, which = u >> 9;
    const bf16_t* base = qkvg + (size_t)(b * S) * QP + (which ? C_VC : C_KC) + g * 64;
#pragma unroll
    for (int i = 0; i < 5; ++i) { int c = tid + 512 * i; c = c < CMP_NCH ? c : CMP_NCH - 1; int tok = 256 * nt + (c >> 3); tok = tok < S ? tok : S - 1;
        r[i] = *(const u32x4*)(base + (size_t)tok * QP + (c & 7) * 8); }
}
__device__ __forceinline__ void compress_stage(LAS unsigned char* lds, int tid, const u32x4 (&r)[5]) {
#pragma unroll
    for (int i = 0; i < 5; ++i) { const int c = tid + 512 * i; const int tr = c >> 3;
        if (c < CMP_NCH) *(LAS u32x4*)(lds + L_KV + ((tr & 15) * 17 + (tr >> 4)) * CMP_PITCH + (c & 7) * 16) = r[i]; }
}
__device__ __forceinline__ void compress_unit(LAS unsigned char* lds, int lane, int wave, const bf16_t* W1T, const bf16_t* W2T, const float* c1, bf16_t* kcmp, bf16_t* vcmp, int u) {
    const int nt = u & 31, g = (u >> 5) & 1, b = (u >> 6) & 7, which = u >> 9, n0 = 16 * nt;
    const int mrow = lane & 15, q = lane >> 4;
    const int n = n0 + mrow, mcl = n > 510 ? mrow - 1 : mrow;
    const LAS unsigned char* arow = lds + L_KV + mcl * CMP_PITCH + 16 * q;
    const bf16_t* brow = W1T + ((size_t)which * 128 + 16 * wave + mrow) * 2048 + 8 * q;
    f32x4 acc = {0.f, 0.f, 0.f, 0.f};
#pragma unroll 16
    for (int ks = 0; ks < 64; ++ks) {
        const bf16x8 a = *(const LAS bf16x8*)(arow + (((ks >> 1) & 15) * 17 + (ks >> 5)) * CMP_PITCH + 64 * (ks & 1));
        const bf16x8 w = *(const bf16x8*)(brow + 32 * ks);
        acc = __builtin_amdgcn_mfma_f32_16x16x32_bf16(w, a, acc, 0, 0, 0);
    }
    LAS bf16_t* hid = (LAS bf16_t*)(lds + L_HID);
    { const f32x4 cb = *(const f32x4*)(c1 + which * 128 + 16 * wave + 4 * q); float hv[4];
#pragma unroll
      for (int r = 0; r < 4; ++r) { const float xx = acc[r] + cb[r]; const float y = 0.7978845608028654f * (xx + 0.044715f * xx * xx * xx);
          const float th = 1.0f - 2.0f / (1.0f + ex2(2.0f * LOG2E * y)); hv[r] = 0.5f * xx * (1.0f + th); }
      u32x2 w; w.x = cvt_pk_bf16(hv[0], hv[1]); w.y = cvt_pk_bf16(hv[2], hv[3]);
      *(LAS u32x2*)(hid + mrow * 136 + 16 * wave + 4 * q) = w; }
    __syncthreads();
    if (wave < 4) {
        f32x4 acc2 = {0.f, 0.f, 0.f, 0.f};
        const bf16_t* w2row = W2T + ((size_t)which * 64 + 16 * wave + mrow) * 128 + 8 * q;
#pragma unroll
        for (int ks = 0; ks < 4; ++ks) {
            const bf16x8 hfr = *(const LAS bf16x8*)(hid + mrow * 136 + 32 * ks + 8 * q);
            const bf16x8 w = *(const bf16x8*)(w2row + 32 * ks);
            acc2 = __builtin_amdgcn_mfma_f32_16x16x32_bf16(w, hfr, acc2, 0, 0, 0);
        }
        u32x2 w; w.x = cvt_pk_bf16(acc2[0], acc2[1]); w.y = cvt_pk_bf16(acc2[2], acc2[3]);
        if (n > 510) { w.x = 0u; w.y = 0u; }
        *(u32x2*)((which ? vcmp : kcmp) + ((size_t)(b * 512 + n) * 2 + g) * 64 + 16 * wave + 4 * q) = w;
    }
    __syncthreads();
}
constexpr int CMP_R1 = 40960, L_HID2 = L_END;
__device__ __forceinline__ void compress_stage1(LAS unsigned char* lds, int tid, const u32x4 (&r)[5]) {
#pragma unroll
    for (int i = 0; i < 5; ++i) { const int c = tid + 512 * i; const int tr = c >> 3;
        if (c < CMP_NCH) *(LAS u32x4*)(lds + L_KV + CMP_R1 + ((tr & 15) * 17 + (tr >> 4)) * CMP_PITCH + (c & 7) * 16) = r[i]; }
}
__device__ __forceinline__ void compress_unit2(LAS unsigned char* lds, int lane, int wave, const bf16_t* W1T, const bf16_t* W2T, const float* c1, bf16_t* kcmp, bf16_t* vcmp, int u) {
    const int nt = u & 31, g = (u >> 5) & 1, b = (u >> 6) & 7, which = u >> 9, n0 = 16 * nt;
    const int mrow = lane & 15, q = lane >> 4;
    const int n = n0 + mrow, mcl = n > 510 ? mrow - 1 : mrow;
    const LAS unsigned char* arow = lds + L_KV + mcl * CMP_PITCH + 16 * q;
    const bf16_t* brow = W1T + ((size_t)which * 128 + 16 * wave + mrow) * 2048 + 8 * q;
    f32x4 acc0 = {0.f, 0.f, 0.f, 0.f}, acc1 = {0.f, 0.f, 0.f, 0.f};
#pragma unroll 16
    for (int ks = 0; ks < 64; ++ks) {
        const int ao = (((ks >> 1) & 15) * 17 + (ks >> 5)) * CMP_PITCH + 64 * (ks & 1);
        const bf16x8 a0 = *(const LAS bf16x8*)(arow + ao), a1 = *(const LAS bf16x8*)(arow + CMP_R1 + ao);
        const bf16x8 w = *(const bf16x8*)(brow + 32 * ks);
        acc0 = __builtin_amdgcn_mfma_f32_16x16x32_bf16(w, a0, acc0, 0, 0, 0);
        acc1 = __builtin_amdgcn_mfma_f32_16x16x32_bf16(w, a1, acc1, 0, 0, 0);
    }
    { const f32x4 cb = *(const f32x4*)(c1 + which * 128 + 16 * wave + 4 * q);
#pragma unroll
      for (int h = 0; h < 2; ++h) { float hv[4];
#pragma unroll
          for (int r = 0; r < 4; ++r) { const float xx = (h ? acc1[r] : acc0[r]) + cb[r]; const float y = 0.7978845608028654f * (xx + 0.044715f * xx * xx * xx);
              const float th = 1.0f - 2.0f / (1.0f + ex2(2.0f * LOG2E * y)); hv[r] = 0.5f * xx * (1.0f + th); }
          u32x2 w; w.x = cvt_pk_bf16(hv[0], hv[1]); w.y = cvt_pk_bf16(hv[2], hv[3]);
          *(LAS u32x2*)((LAS bf16_t*)(lds + (h ? L_HID2 : L_HID)) + mrow * 136 + 16 * wave + 4 * q) = w; } }
    __syncthreads();
    {   const int h = wave >> 2, w4 = wave & 3;
        const LAS bf16_t* hid = (const LAS bf16_t*)(lds + (h ? L_HID2 : L_HID));
        f32x4 acc2 = {0.f, 0.f, 0.f, 0.f};
        const bf16_t* w2row = W2T + ((size_t)which * 64 + 16 * w4 + mrow) * 128 + 8 * q;
#pragma unroll
        for (int ks = 0; ks < 4; ++ks) {
            const bf16x8 hfr = *(const LAS bf16x8*)(hid + mrow * 136 + 32 * ks + 8 * q);
            const bf16x8 w = *(const bf16x8*)(w2row + 32 * ks);
            acc2 = __builtin_amdgcn_mfma_f32_16x16x32_bf16(w, hfr, acc2, 0, 0, 0);
        }
        u32x2 w; w.x = cvt_pk_bf16(acc2[0], acc2[1]); w.y = cvt_pk_bf16(acc2[2], acc2[3]);
        if (n > 510) { w.x = 0u; w.y = 0u; }
        *(u32x2*)((which ? vcmp : kcmp) + ((size_t)((b + 4 * h) * 512 + n) * 2 + g) * 64 + 16 * w4 + 4 * q) = w;
    }
    __syncthreads();
}
}

struct __attribute__((packed, aligned(4))) Rec3 { unsigned x, y, z; };
struct MoeCtx { LAS unsigned char* lds; unsigned char* ws; float* out; const float* ln2g; const float* ln2b; int G, gw, NGW, tid, lane; };
__device__ __forceinline__ MoeTables moe_tb(LAS unsigned char* lds) { MoeTables tb; tb.tn = (LAS int*)(lds + RING_BYTES + 1024); tb.es = tb.tn + 260; tb.us = tb.es + 260; return tb; }
__device__ __forceinline__ void moe_prefix(const unsigned* cnt, LAS int* tn, LAS int* es, LAS int* us, int tid) {
    __syncthreads();
    if (tid < 64) { const int lane = tid; int n[4], tt[4], sa = 0, sb = 0;
#pragma unroll
        for (int j = 0; j < 4; ++j) { n[j] = (int)cnt[4 * lane + j]; tt[j] = (n[j] + 255) >> 8; sa += n[j]; sb += tt[j]; }
        int ia = sa, ib = sb;
#pragma unroll
        for (int o = 1; o < 64; o <<= 1) { const int xa = __shfl_up(ia, o), xb = __shfl_up(ib, o); if (lane >= o) { ia += xa; ib += xb; } }
        int ea = ia - sa, eb = ib - sb;
#pragma unroll
        for (int j = 0; j < 4; ++j) { es[4 * lane + j] = ea; if (us) us[4 * lane + j] = eb; if (tn) tn[4 * lane + j] = n[j]; ea += n[j]; eb += tt[j]; }
        if (lane == 63) { es[256] = ea; es[257] = ea + CHT; if (us) { us[256] = eb; us[257] = eb + CHT / 256; } if (tn) tn[256] = CHT; } }
    __syncthreads();
}
__device__ __forceinline__ LAS int* moe_esc(LAS unsigned char* lds) { return (LAS int*)(lds + RING_BYTES + 13056); }
template <int C> __device__ __forceinline__ void moe_combine(const MoeCtx& mc) {
    LAS int* es = moe_esc(mc.lds);
    const unsigned* eidx = (const unsigned*)(mc.ws + WS_EIDX); const float* gatev = (const float*)(mc.ws + WS_GATE); const unsigned* posv = (const unsigned*)(mc.ws + WS_POS);
    const unsigned char* y8 = mc.ws + WS_Y; const bf16_t* ys = (const bf16_t*)(mc.ws + WS_YS);
    const int lane = mc.lane;
    f32x4 g2v[4], b2v[4];
#pragma unroll
    for (int j = 0; j < 4; ++j) { g2v[j] = *(const f32x4*)(mc.ln2g + 16 * lane + 4 * j); b2v[j] = *(const f32x4*)(mc.ln2b + 16 * lane + 4 * j); }
    for (int tl = mc.gw; tl < CHT; tl += 2 * mc.NGW) {
        const int tl2 = tl + mc.NGW; const bool two = tl2 < CHT;
        const int tA = C * CHT + tl, tB = C * CHT + (two ? tl2 : tl);
        u32x4 ra[10], rb[10]; float ga[8], gb[8];
        { const size_t ie = (size_t)((lane & 8) ? tB : tA) * TOPK + (lane & 7);
          const Rec3 rec = *(const Rec3*)(eidx + 3 * ie);
          const unsigned rowv = (unsigned)es[rec.x] + rec.y; const float gvv = __builtin_bit_cast(float, rec.z) * 0.0625f;
#pragma unroll
          for (int k = 0; k < 8; ++k) {
              const unsigned rowA = (unsigned)__builtin_amdgcn_readlane((int)rowv, k), rowB = (unsigned)__builtin_amdgcn_readlane((int)rowv, 8 + k);
              ga[k] = __builtin_bit_cast(float, __builtin_amdgcn_readlane(__builtin_bit_cast(int, gvv), k)); gb[k] = __builtin_bit_cast(float, __builtin_amdgcn_readlane(__builtin_bit_cast(int, gvv), 8 + k));
              ra[k] = *(const u32x4*)(y8 + (size_t)rowA * D + 16 * lane); rb[k] = *(const u32x4*)(y8 + (size_t)rowB * D + 16 * lane); } }
        { const bf16_t* pa = ys + (size_t)tl * D + 16 * lane; const bf16_t* pb = ys + (size_t)(two ? tl2 : tl) * D + 16 * lane;
          ra[8] = *(const u32x4*)pa; ra[9] = *(const u32x4*)(pa + 8); rb[8] = *(const u32x4*)pb; rb[9] = *(const u32x4*)(pb + 8); }
#pragma unroll
        for (int h = 0; h < 2; ++h) {
            if (h == 1 && !two) break;
            float v[16];
            { const u32x4 a = h ? rb[8] : ra[8], b = h ? rb[9] : ra[9];
#pragma unroll
              for (int j = 0; j < 4; ++j) { v[2 * j] = __builtin_bit_cast(float, a[j] << 16); v[2 * j + 1] = __builtin_bit_cast(float, a[j] & 0xffff0000u);
                  v[8 + 2 * j] = __builtin_bit_cast(float, b[j] << 16); v[8 + 2 * j + 1] = __builtin_bit_cast(float, b[j] & 0xffff0000u); } }
#pragma unroll
            for (int k = 0; k < 8; ++k) { const float gk = h ? gb[k] : ga[k]; const u32x4 a = h ? rb[k] : ra[k];
#pragma unroll
                for (int j = 0; j < 4; ++j) { const f32x2 lo = __builtin_amdgcn_cvt_pk_f32_fp8((int)a[j], false), hi = __builtin_amdgcn_cvt_pk_f32_fp8((int)a[j], true);
                    v[4 * j] += gk * lo.x; v[4 * j + 1] += gk * lo.y; v[4 * j + 2] += gk * hi.x; v[4 * j + 3] += gk * hi.y; } }
            float sm = 0.f;
#pragma unroll
            for (int j = 0; j < 16; ++j) sm += v[j];
            const float mean = wave_sum_x(sm) * (1.f / D); float s2 = 0.f;
#pragma unroll
            for (int j = 0; j < 16; ++j) { v[j] -= mean; s2 += v[j] * v[j]; }
            const float rstd = 1.f / sqrtf(wave_sum_x(s2) * (1.f / D) + LN_EPS);
            float* op = mc.out + (size_t)(h ? tB : tA) * D + 16 * lane;
#pragma unroll
            for (int j = 0; j < 4; ++j) { const f32x4 gg = g2v[j], bb = b2v[j];
                f32x4 o; o.x = v[4 * j] * rstd * gg.x + bb.x; o.y = v[4 * j + 1] * rstd * gg.y + bb.y; o.z = v[4 * j + 2] * rstd * gg.z + bb.z; o.w = v[4 * j + 3] * rstd * gg.w + bb.w;
                *(f32x4*)(op + 4 * j) = o; }
        }
    }
}
template <int C> __device__ __forceinline__ void moe_gu(const MoeCtx& mc) {
    const MoeTables tb = moe_tb(mc.lds);
    const unsigned* cntw = (const unsigned*)(mc.ws + WS_CTL) + CW_CNT;
    bf16_t* h1b = (bf16_t*)((unsigned char*)mc.out + DO_H1B); bf16_t* Wgu = (bf16_t*)(mc.ws + WS_WGU); bf16_t* hb = (bf16_t*)(mc.ws + WS_HB);
    const unsigned short* elist = (const unsigned short*)(mc.ws + WS_LIST);
    moe_prefix(cntw + C * 256, tb.tn, tb.es, tb.us, mc.tid);
    MoeUnits mu; mu.rec = (LAS int*)(mc.lds + RING_BYTES + 4352); mu.cnt = mu.rec + 96; mu.tok = (LAS unsigned short*)(mc.lds + RING_BYTES + 4864);
    moe_units<2, true>(tb, mu, mc.G, (int)blockIdx.x, mc.tid, elist, C);
    { MoeOrder<2> S; S.tb = tb; S.mu = mu; S.Abase = (const char*)h1b; S.apitch = 0; S.Bbase = (const char*)Wgu; S.strideE = (size_t)512 * D * 2; S.stridePN = (size_t)256 * D * 2;
      S.chunk = C; S.colw = 128;
      EpiGLU E{hb};
      pg8::gemm_phase<EpiGLU, MoeOrder<2>, true, true, false, 8>(mc.lds, D, S, E); }
}
template <int C> __device__ __forceinline__ void moe_d(const MoeCtx& mc) {
    const MoeTables tb = moe_tb(mc.lds);
    bf16_t* h1b = (bf16_t*)((unsigned char*)mc.out + DO_H1B); bf16_t* Wd = (bf16_t*)(mc.ws + WS_WD); bf16_t* hb = (bf16_t*)(mc.ws + WS_HB);
    const unsigned short* elist = (const unsigned short*)(mc.ws + WS_LIST);
    MoeUnits mu; mu.rec = (LAS int*)(mc.lds + RING_BYTES + 4352); mu.cnt = mu.rec + 96; mu.tok = (LAS unsigned short*)(mc.lds + RING_BYTES + 4864);
    moe_units<4, false>(tb, mu, mc.G, (int)blockIdx.x, mc.tid, elist, C);
    { MoeOrder<4> S; S.tb = tb; S.mu = mu; S.Abase = (const char*)hb; S.apitch = (size_t)EH * 2; S.Bbase = (const char*)Wd; S.strideE = (size_t)D * EH * 2; S.stridePN = (size_t)256 * EH * 2;
      S.chunk = C; S.colw = 256;
      EpiDown E{mc.ws + WS_Y, (bf16_t*)(mc.ws + WS_YS), h1b, C};
      int kk = EH; asm volatile("" : "+s"(kk));
      pg8::gemm_phase<EpiDown, MoeOrder<4>, true, false, false, 8>(mc.lds, kk, S, E); }
}
template <int C> __device__ __forceinline__ void moe_cgu(const MoeCtx& mc) {
    const unsigned* cntw = (const unsigned*)(mc.ws + WS_CTL) + CW_CNT;
    moe_prefix(cntw + C * 256, nullptr, moe_esc(mc.lds), nullptr, mc.tid);
    const bool first = (((int)blockIdx.x >> 3) & 1) == 0;
    if (first) moe_combine<C>(mc);
    moe_gu<C + 1>(mc);
    if (!first) moe_combine<C>(mc);
}

struct MegaArgs { const float* in[23]; float* out; unsigned char* ws; unsigned phases; unsigned li; };

__device__ __forceinline__ int colmap_win(int c) {
    if (c < 1280) return c;
    if (c < 1792) return O_QB + (c - 1280);
    if (c < 2048) return O_KB + (c - 1792);
    if (c < 2072) return O_GA + (c - 2048);
    if (c < 2304) return -1;
    if (c < 3328) return O_GATEA + (c - 2304);
    return O_GATEB + (c - 3328);
}
template <class CMap> __device__ __forceinline__ void transpose_item(const float* W, int K, int Nsrc, bf16_t* WT, int nblk, LAS unsigned char* scr, int item, int lane, CMap cmap, int ldo = 0, int koff = 0) {
    if (ldo == 0) ldo = K;
    const int kb = item / nblk, nb = item % nblk, k0 = 64 * kb, n0 = 64 * nb;
    const int sc = cmap(n0 + 4 * (lane & 15));
    const float* src = W + (size_t)(k0 + (lane >> 4)) * Nsrc + (sc >= 0 ? sc : 0);
#pragma unroll 8
    for (int i = 0; i < 16; ++i) { f32x4 v = {0.f, 0.f, 0.f, 0.f}; if (sc >= 0) v = __builtin_nontemporal_load((const f32x4*)(src + (size_t)(4 * i) * Nsrc));
        u32x2 w; w.x = pk2(v.x, v.y); w.y = pk2(v.z, v.w);
        *(LAS u32x2*)(scr + (4 * i + (lane >> 4)) * 144 + (lane & 15) * 8) = w; }
    asm volatile("s_waitcnt lgkmcnt(0)" ::: "memory");
    const int q = lane >> 4, cc = lane & 15;
#pragma unroll
    for (int it = 0; it < 8; ++it) { const int ng = it >> 1, kc = 4 * (it & 1) + q;
        const LAS unsigned char* p = scr + (8 * kc + (cc >> 2)) * 144 + (16 * ng + 4 * (cc & 3)) * 2;
        const v4i16_t lo = __builtin_amdgcn_ds_read_tr16_b64_v4i16((LAS v4i16_t*)p);
        const v4i16_t hi = __builtin_amdgcn_ds_read_tr16_b64_v4i16((LAS v4i16_t*)(p + 4 * 144));
        const bf16x8 o = {lo[0], lo[1], lo[2], lo[3], hi[0], hi[1], hi[2], hi[3]};
        *(bf16x8*)(WT + (size_t)(n0 + 16 * ng + cc) * ldo + koff + k0 + 8 * kc) = o; }
    asm volatile("s_waitcnt lgkmcnt(0)" ::: "memory");
}

__device__ __forceinline__ void route_select(const float (&lg)[4], const float (&rb)[4], int lane, unsigned long long (&Sm)[4], float (&sc)[4], float& gsum) {
            float ch[4];
#pragma unroll
            for (int i = 0; i < 4; ++i) { sc[i] = 1.0f / (1.0f + expf(-lg[i])); ch[i] = sc[i] + rb[i]; }
            float gs[8];
#pragma unroll
            for (int i = 0; i < 4; ++i) {
                float m1 = ch[i]; int a1 = lane;
#pragma unroll
                for (int o = 16; o > 0; o >>= 1) { const float om = __shfl_xor(m1, o); const int oa_ = __shfl_xor(a1, o); if (om > m1 || (om == m1 && oa_ < a1)) { m1 = om; a1 = oa_; } }
                float m2 = (lane == a1) ? -INFINITY : ch[i];
#pragma unroll
                for (int o = 16; o > 0; o >>= 1) m2 = fmaxf(m2, __shfl_xor(m2, o));
                const float s2 = m1 + m2;
                gs[2 * i] = __shfl(s2, 0); gs[2 * i + 1] = __shfl(s2, 32);
            }
            float cm[4];
#pragma unroll
            for (int i = 0; i < 4; ++i) { int r0 = 0, r1 = 0;
#pragma unroll
                for (int b = 0; b < 8; ++b) { r0 += (gs[b] > gs[2 * i] || (gs[b] == gs[2 * i] && b < 2 * i)) ? 1 : 0; r1 += (gs[b] > gs[2 * i + 1] || (gs[b] == gs[2 * i + 1] && b < 2 * i + 1)) ? 1 : 0; }
                const bool k = (lane < 32) ? (r0 < 4) : (r1 < 4); cm[i] = k ? ch[i] : -INFINITY; }
            unsigned key[4];
#pragma unroll
            for (int i = 0; i < 4; ++i) { const unsigned b_ = __builtin_bit_cast(unsigned, cm[i]); key[i] = (cm[i] == -INFINITY) ? 0u : (b_ ^ ((b_ >> 31) ? 0xFFFFFFFFu : 0x80000000u)); }
            unsigned Tk = 0u;
            for (int bit = 31; bit >= 16; --bit) { const unsigned cand = Tk | (1u << bit);
                const int cnt = __popcll(__ballot(key[0] >= cand)) + __popcll(__ballot(key[1] >= cand)) + __popcll(__ballot(key[2] >= cand)) + __popcll(__ballot(key[3] >= cand));
                if (cnt >= TOPK) Tk = cand; }
            int cge = 0;
#pragma unroll
            for (int i = 0; i < 4; ++i) { Sm[i] = __ballot(key[i] >= Tk); cge += __popcll(Sm[i]); }
            if (cge != TOPK) {
                for (int bit = 15; bit >= 8; --bit) { const unsigned cand = Tk | (1u << bit);
                    const int cnt = __popcll(__ballot(key[0] >= cand)) + __popcll(__ballot(key[1] >= cand)) + __popcll(__ballot(key[2] >= cand)) + __popcll(__ballot(key[3] >= cand));
                    if (cnt >= TOPK) Tk = cand; }
                cge = 0;
#pragma unroll
                for (int i = 0; i < 4; ++i) { Sm[i] = __ballot(key[i] >= Tk); cge += __popcll(Sm[i]); }
            }
            if (cge != TOPK) {
                for (int bit = 7; bit >= 0; --bit) { const unsigned cand = Tk | (1u << bit);
                    const int cnt = __popcll(__ballot(key[0] >= cand)) + __popcll(__ballot(key[1] >= cand)) + __popcll(__ballot(key[2] >= cand)) + __popcll(__ballot(key[3] >= cand));
                    if (cnt >= TOPK) Tk = cand; }
                int need = TOPK;
#pragma unroll
                for (int i = 0; i < 4; ++i) { Sm[i] = __ballot(key[i] > Tk); need -= __popcll(Sm[i]); }
#pragma unroll
                for (int i = 0; i < 4; ++i) { unsigned long long E_ = __ballot(key[i] == Tk);
                    while (need > 0 && E_) { const unsigned long long b_ = E_ & (0ull - E_); Sm[i] |= b_; E_ ^= b_; --need; } }
            }
            float gpart = 0.f;
#pragma unroll
            for (int i = 0; i < 4; ++i) gpart += ((Sm[i] >> lane) & 1ull) ? sc[i] : 0.f;
            gsum = wave_sum_x(gpart);
}
__device__ __forceinline__ void route_commit(int t, int lane, const unsigned long long (&Sm)[4], const float (&gv)[4], const unsigned (&p)[4], unsigned* eidx, float* gatev, unsigned* posv, unsigned short* elist) {
            const unsigned long long below = (1ull << lane) - 1ull;
            const int c = t / CHT;
            int base_ = 0;
#pragma unroll
            for (int i = 0; i < 4; ++i) {
                if ((Sm[i] >> lane) & 1ull) {
                    const int slot = base_ + __popcll(Sm[i] & below), e = lane + 64 * i;
                    { Rec3 rec; rec.x = (unsigned)e; rec.y = p[i]; rec.z = __builtin_bit_cast(unsigned, gv[i]);
                      *(Rec3*)(eidx + 3 * ((size_t)t * TOPK + slot)) = rec; }
                    elist[((size_t)c * 256 + e) * CHT + p[i]] = (unsigned short)(t - c * CHT);
                }
                base_ += __popcll(Sm[i]);
            }
}
struct PanelOrder { const char* A; const char* Bt; int K, row0;
    __device__ __forceinline__ bool next(int i, pg8::Unit& u) const { if (i >= 4) return false;
        u.A = A + (size_t)row0 * K * 2; u.B = Bt + (size_t)i * pg8::BM * K * 2; u.row0 = row0; u.col0 = i * pg8::BM; u.nrows = pg8::BM; u.aux = i; u.e = 0; u.ti = 0; u.ord = 0; return true; }
    __device__ __forceinline__ unsigned arow_off(const pg8::Unit&, int) const { return 0u; } };
constexpr int I_GU = (D / 64) * (512 / 64), I_D = (EH / 64) * (D / 64), I_E = I_GU + I_D, I_EXP = 257 * I_E;
__device__ __forceinline__ void expert_load(const float* const* in, int it, int lane, f32x4 (&v)[16]) {
    it = it < I_EXP ? it : I_EXP - 1;
    const int e = it / I_E; int r = it % I_E;
    const float* src; int Nsrc, kb, sc;
    if (r < I_GU) { const int nb = r % 8, bj = (nb >> 1) & 1, pnn = nb >> 2; kb = r / 8;
        src = (e < 256) ? ((bj ? in[16] : in[15]) + (size_t)e * D * EH) : (bj ? in[19] : in[18]); Nsrc = EH; sc = pnn * 128 + 64 * (nb & 1);
    } else { r -= I_GU; src = (e < 256) ? (in[17] + (size_t)e * EH * D) : in[20]; Nsrc = D; kb = r / (D / 64); sc = 64 * (r % (D / 64)); }
    const char* base = (const char*)(src + (size_t)(64 * kb) * Nsrc + sc);
    const unsigned loff = (unsigned)((lane >> 4) * Nsrc + 4 * (lane & 15)) * 4u;
#pragma unroll
    for (int i = 0; i < 16; ++i) v[i] = __builtin_nontemporal_load((const f32x4*)(base + (size_t)(4 * i) * Nsrc * 4 + loff));
}
__device__ __forceinline__ void expert_finish(bf16_t* Wgu, bf16_t* Wd, LAS unsigned char* scr, int it, int lane, const f32x4 (&v)[16]) {
    if (it >= I_EXP) return;
    const int e = it / I_E; int r = it % I_E;
    bf16_t* WT; int ldo, kb, nb;
    if (r < I_GU) { WT = Wgu + (size_t)e * 512 * D; ldo = D; kb = r / 8; nb = r % 8; }
    else { r -= I_GU; WT = Wd + (size_t)e * D * EH; ldo = EH; kb = r / (D / 64); nb = r % (D / 64); }
#pragma unroll
    for (int i = 0; i < 16; ++i) { u32x2 w; w.x = pk2(v[i].x, v[i].y); w.y = pk2(v[i].z, v[i].w);
        *(LAS u32x2*)(scr + (4 * i + (lane >> 4)) * 144 + (lane & 15) * 8) = w; }
    asm volatile("s_waitcnt lgkmcnt(0)" ::: "memory");
    const int q = lane >> 4, cc = lane & 15;
    char* obase = (char*)(WT + (size_t)(64 * nb) * ldo + 64 * kb);
    const unsigned ooff = (unsigned)(cc * ldo + 8 * q) * 2u;
    const LAS unsigned char* p0 = scr + (8 * q + (cc >> 2)) * 144 + (4 * (cc & 3)) * 2;
#pragma unroll
    for (int x = 0; x < 8; ++x) { const int ng = x >> 1, kh = x & 1;
        const LAS unsigned char* p = p0 + (32 * kh) * 144 + (16 * ng) * 2;
        const v4i16_t lo = __builtin_amdgcn_ds_read_tr16_b64_v4i16((LAS v4i16_t*)p);
        const v4i16_t hi = __builtin_amdgcn_ds_read_tr16_b64_v4i16((LAS v4i16_t*)(p + 4 * 144));
        const bf16x8 o = {lo[0], lo[1], lo[2], lo[3], hi[0], hi[1], hi[2], hi[3]};
        *(bf16x8*)(obase + ((size_t)(16 * ng) * ldo + 32 * kh) * 2 + ooff) = o; }
    asm volatile("s_waitcnt lgkmcnt(0)" ::: "memory");
}
struct OneUnit { pg8::Unit u; __device__ __forceinline__ bool next(int i, pg8::Unit& o) const { if (i) return false; o = u; return true; } __device__ __forceinline__ unsigned arow_off(const pg8::Unit&, int) const { return 0u; } };

__global__ void __launch_bounds__(NWAVES * 64, 2) mega(MegaArgs args) {
    extern __shared__ __attribute__((aligned(16))) unsigned char lds_raw[];
    LAS unsigned char* lds = (LAS unsigned char*)lds_raw;
    volatile LAS unsigned* MISC = (volatile LAS unsigned*)(lds + MISC_OFF);
    const int tid = threadIdx.x, lane = tid & 63, wave = __builtin_amdgcn_readfirstlane(tid >> 6);
    const int G = gridDim.x;
    const int vcu = (G % 8 == 0) ? ((int)blockIdx.x % 8) * (G / 8) + (int)blockIdx.x / 8 : (int)blockIdx.x;
    unsigned char* ws = args.ws;
    gu32* ctl = (gu32*)(ws + WS_CTL);
    for (int u = tid; u < (LDS_BYTES - RING_BYTES) / 4; u += NWAVES * 64) ((LAS unsigned*)(lds + RING_BYTES))[u] = 0u;
    __syncthreads();
    XcdBarrier bar = xcd_barrier_post((unsigned*)(ctl + CW_BAR) + (args.li & 255u) * XCD_BAR_WORDS, MISC + 8);
    const unsigned ph = args.phases;
    const float* x = args.in[0]; const float* w_in = args.in[1];
    bf16_t* xb = (bf16_t*)(ws + WS_XB);
    bf16_t* merged = (bf16_t*)((unsigned char*)args.out + DO_MERGED);
    bf16_t* oab = (bf16_t*)((unsigned char*)args.out + DO_OAB);
    bf16_t* WinT = (bf16_t*)(ws + WS_WINT); bf16_t* projT = (bf16_t*)(ws + WS_PROJT); bf16_t* woutT = (bf16_t*)(ws + WS_WOUTT); bf16_t* WrT = (bf16_t*)(ws + WS_WRT);
    bf16_t* qkvg = (bf16_t*)(ws + WS_QKV); bf16_t* gates = (bf16_t*)(ws + WS_GATES);
    bf16_t* pre = (bf16_t*)(ws + WS_PRE);
    bf16_t* h1b = (bf16_t*)((unsigned char*)args.out + DO_H1B);
    bf16_t* Wgu = (bf16_t*)(ws + WS_WGU); bf16_t* Wd = (bf16_t*)(ws + WS_WD);
    bf16_t* hb = (bf16_t*)(ws + WS_HB); bf16_t* ybuf = (bf16_t*)(ws + WS_Y);
    float* logits = (float*)(ws + WS_LOGITS);
    unsigned* eidx = (unsigned*)(ws + WS_EIDX); float* gatev = (float*)(ws + WS_GATE); unsigned* posv = (unsigned*)(ws + WS_POS);
    unsigned short* elist = (unsigned short*)(ws + WS_LIST);
    unsigned* cntw = (unsigned*)(ctl + CW_CNT);
    const int gw = vcu * NWAVES + wave, NGW = G * NWAVES;

    if (ph & 1u) {
        LAS unsigned char* scr = lds + wave * 16384;
        constexpr int NBLK = QW / 64, I_WIN = (D / 64) * NBLK, I_PA = (512 / 64) * (D / 64), I_WO = (D / 64) * (D / 64), I_WR = (D / 64) * (NE / 64);
        constexpr int NITEMS = I_WIN + 2 * I_PA + I_WO + I_WR;
        auto ident = [](int c) { return c; };
        for (int it = gw; it < NITEMS; it += NGW) {
            int r = it;
            if (r < I_WIN) { transpose_item(w_in, D, INW, WinT, NBLK, scr, r, lane, [](int c) { return colmap_win(c); }); continue; } r -= I_WIN;
            if (r < I_PA) { transpose_item(args.in[8], 512, D, projT, D / 64, scr, r, lane, ident, D, 0); continue; } r -= I_PA;
            if (r < I_PA) { transpose_item(args.in[9], 512, D, projT, D / 64, scr, r, lane, ident, D, 512); continue; } r -= I_PA;
            if (r < I_WO) { transpose_item(args.in[10], D, D, woutT, D / 64, scr, r, lane, ident); continue; } r -= I_WO;
            transpose_item(args.in[13], D, NE, WrT, NE / 64, scr, r, lane, ident);
        }
        { bf16_t* W1T = (bf16_t*)(ws + WS_W1T); bf16_t* W2T = (bf16_t*)(ws + WS_W2T); float* c1 = (float*)(ws + WS_C1);
          constexpr int I_1 = (2048 / 64) * (128 / 64), I_2 = (128 / 64) * (64 / 64);
          for (int it = gw; it < 2 * (I_1 + I_2); it += NGW) { const int which = it / (I_1 + I_2); int r = it % (I_1 + I_2);
              if (r < I_1) transpose_item(args.in[3] + (size_t)which * 2048 * 128, 2048, 128, W1T + (size_t)which * 128 * 2048, 2, scr, r, lane, ident);
              else transpose_item(args.in[5] + (size_t)which * 128 * 64, 128, 64, W2T + (size_t)which * 64 * 128, 1, scr, r - I_1, lane, ident); }
          for (int o = gw; o < 256; o += NGW) { const int which = o >> 7, nn = o & 127; const float* pe = args.in[2] + which * 2048; const float* w1 = args.in[3] + (size_t)which * 2048 * 128 + nn;
              float a = 0.f; for (int k = lane; k < 2048; k += 64) a = fmaf(pe[k], w1[(size_t)k * 128], a);
              a = wave_sum_x(a); if (lane == 0) c1[o] = a + args.in[4][o]; } }
        const size_t nchunk = (size_t)T * D / 8, gstep = (size_t)G * NWAVES * 64;
        for (size_t i = (size_t)blockIdx.x * (NWAVES * 64) + tid; i < nchunk; i += 4 * gstep) {
            f32x4 a[4], b[4];
#pragma unroll
            for (int j = 0; j < 4; ++j) { const size_t ii = (i + j * gstep < nchunk) ? i + j * gstep : i; a[j] = __builtin_nontemporal_load((const f32x4*)(x + ii * 8)); b[j] = __builtin_nontemporal_load((const f32x4*)(x + ii * 8 + 4)); }
#pragma unroll
            for (int j = 0; j < 4; ++j) { const size_t ii = (i + j * gstep < nchunk) ? i + j * gstep : i;
                u32x4 o; o.x = pk2(a[j][0], a[j][1]); o.y = pk2(a[j][2], a[j][3]); o.z = pk2(b[j][0], b[j][1]); o.w = pk2(b[j][2], b[j][3]);
                *(u32x4*)(xb + ii * 8) = o; }
        }
        xcd_barrier(bar);
    }
    if (ph & 2u) {
        pg8::DenseOrder S; S.init(xb, WinT, T, QW, D, G, (int)blockIdx.x);
        EpiQKV E{qkvg, gates};
        pg8::gemm_phase<EpiQKV, pg8::DenseOrder, true, false, false, 16>(lds, D, S, E);
        xcd_barrier(bar);
    }
    if (ph & 4u) {
        const bf16_t* W1T = (const bf16_t*)(ws + WS_W1T); const bf16_t* W2T = (const bf16_t*)(ws + WS_W2T); const float* c1 = (const float*)(ws + WS_C1);
        if (G == 256) {
            u32x4 cr0[5], cr1[5]; att::compress_load(qkvg, (int)blockIdx.x, tid, cr0); att::compress_load(qkvg, (int)blockIdx.x + 256, tid, cr1);
            for (int u = (int)blockIdx.x; u < 1024; u += 512) {
                att::compress_stage(lds, tid, cr0); att::compress_stage1(lds, tid, cr1);
                __syncthreads();
                { const int un = u + 512 < 1024 ? u + 512 : u; att::compress_load(qkvg, un, tid, cr0); att::compress_load(qkvg, un + 256, tid, cr1); }
                att::compress_unit2(lds, lane, wave, W1T, W2T, c1, (bf16_t*)(ws + WS_KCMP), (bf16_t*)(ws + WS_VCMP), u);
            }
        } else {
            u32x4 cr[5]; att::compress_load(qkvg, (int)blockIdx.x < 1024 ? (int)blockIdx.x : 0, tid, cr);
            for (int u = (int)blockIdx.x; u < 1024; u += G) {
                att::compress_stage(lds, tid, cr);
                __syncthreads();
                att::compress_load(qkvg, u + G < 1024 ? u + G : u, tid, cr);
                att::compress_unit(lds, lane, wave, W1T, W2T, c1, (bf16_t*)(ws + WS_KCMP), (bf16_t*)(ws + WS_VCMP), u);
            }
        }
        xcd_barrier(bar);
    }
    if (ph & 8u) {
        { LAS float* biasL = (LAS float*)(lds + att::L_BIAS); const float* tab = args.in[7];
          for (int i = tid; i < 16 * 132; i += NWAVES * 64) { const int hh = i / 132, d = i % 132; biasL[i] = tab[(d >= 128 ? 31 : (int)BUCKET[d]) * 16 + hh] * att::LOG2E; } }
        __syncthreads();
        const int nstat = (2048 - 256 - (int)blockIdx.x + G - 1) / G, cgrp = ((int)blockIdx.x >> 3) & 7, cslot = nstat <= 0 ? 0 : (cgrp < nstat ? cgrp : nstat - 1);
        int u = 256 + (int)blockIdx.x;
        for (int itn = 0;; ++itn) {
            int tile = -1, bg = 0;
            if (u < 2048) { const int w = u & 255, k = u >> 8, sub = w >> 4; bg = w & 15; tile = 16 * k + ((k & 1) ? 15 - sub : sub); u += G; }
            else {
                __syncthreads();
                if (tid == 0) *(volatile LAS unsigned*)(lds + att::L_END) = __hip_atomic_fetch_add((unsigned*)(ctl + CW_ATTQ), 1u, __ATOMIC_RELAXED, __HIP_MEMORY_SCOPE_AGENT);
                __syncthreads();
                const int qd = __builtin_amdgcn_readfirstlane((int)*(volatile LAS unsigned*)(lds + att::L_END));
                if (qd < 256) { bg = qd & 15; tile = 15 - (qd >> 4); }
            }
            if (itn == cslot) {
                static_assert(2047 + 23 * 2048 < I_EXP && I_EXP <= 25 * 2048, "conversion share");
                for (int r = 0; r < 8; ++r) {
                    int lane2 = tid; asm volatile("" : "+v"(lane2)); lane2 &= 63;
                    LAS unsigned char* scr = lds + wave * 9216;
                    const int i0 = __builtin_amdgcn_readfirstlane(gw + 3 * r * NGW), i1 = i0 + NGW, i2 = i1 + NGW;
                    f32x4 va[16], vb[16];
                    expert_load(args.in, i0, lane2, va); expert_load(args.in, i1, lane2, vb);
                    expert_finish(Wgu, Wd, scr, i0, lane2, va); expert_load(args.in, i2, lane2, va);
                    expert_finish(Wgu, Wd, scr, i1, lane2, vb);
                    expert_finish(Wgu, Wd, scr, i2, lane2, va);
                }
            }
            if (tile < 0) break;
            __syncthreads();
            { int tidu = tid; asm volatile("" : "+v"(tidu));
              att::unit(lds, tidu, tidu & 63, wave, qkvg, (const bf16_t*)(ws + WS_KCMP), (const bf16_t*)(ws + WS_VCMP), args.in[6], oab, bg >> 1, bg & 1, tile); }
            __syncthreads();
        }
        {
            const int it = gw + 24 * NGW;
            if (it < I_EXP) { int lane2 = tid; asm volatile("" : "+v"(lane2)); lane2 &= 63; f32x4 vc[16]; expert_load(args.in, it, lane2, vc); expert_finish(Wgu, Wd, lds + wave * 9216, it, lane2, vc); }
        }
        xcd_barrier(bar);
    }
    if (ph & 64u) {
        pg8::DenseOrder S; S.init(h1b, WrT, T, NE, D, G, (int)blockIdx.x);
        {
            OneUnit S1; if (!S.next(0, S1.u)) S1.u = pg8::Unit{(const char*)h1b, (const char*)WrT, 0, 0, 256, 0, 0, 0, 0};
            { PanelOrder SP{(const char*)oab, (const char*)projT, D, S1.u.row0}; EpiMerge E{gates, merged}; pg8::gemm_phase<EpiMerge, PanelOrder, true, false, true>(lds, D, SP, E); }
            xcd_barrier(bar);
            { PanelOrder SP{(const char*)merged, (const char*)woutT, D, S1.u.row0}; EpiWout E{xb, pre}; pg8::gemm_phase<EpiWout, PanelOrder, true, false, false>(lds, D, SP, E); }
            asm volatile("s_waitcnt vmcnt(0)" ::: "memory");
            __syncthreads();
            __builtin_amdgcn_fence(__ATOMIC_ACQUIRE, "agent");
            const int r0 = S1.u.row0 + wave * 32;
            f32x4 g1v[4], b1v[4];
#pragma unroll
            for (int j = 0; j < 4; ++j) { g1v[j] = *(const f32x4*)(args.in[11] + 16 * lane + 4 * j); b1v[j] = *(const f32x4*)(args.in[12] + 16 * lane + 4 * j); }
            for (int m = 0; m < 32; m += 4) {
                u32x4 ra[4], rc[4];
#pragma unroll
                for (int j = 0; j < 4; ++j) { const bf16_t* xr = pre + (size_t)(r0 + m + j) * D + 16 * lane; ra[j] = *(const u32x4*)xr; rc[j] = *(const u32x4*)(xr + 8); }
#pragma unroll
                for (int j = 0; j < 4; ++j) ln_regs_to_bf16(ra[j], rc[j], h1b + (size_t)(r0 + m + j) * D, g1v, b1v, lane);
            }
            asm volatile("s_waitcnt vmcnt(0)" ::: "memory");
            __syncthreads();
            { EpiLogits E{logits}; pg8::gemm_phase<EpiLogits, OneUnit, false, false, false>(lds, D, S1, E); }
            asm volatile("s_waitcnt vmcnt(0)" ::: "memory");
            __syncthreads();
            {
                LAS float* lgs = (LAS float*)(lds + wave * 8192);
                float rb[4];
#pragma unroll
                for (int i = 0; i < 4; ++i) rb[i] = args.in[14][lane + 64 * i];
                f32x4 rr[8];
#pragma unroll
                for (int k = 0; k < 8; ++k) rr[k] = *(const f32x4*)(logits + (size_t)(r0 + k) * NE + 4 * lane);
                unsigned long long pSm[4] = {0ull, 0ull, 0ull, 0ull}; float pg[4] = {0.f, 0.f, 0.f, 0.f}; unsigned pp[4] = {0u, 0u, 0u, 0u};
                for (int mb = 0; mb < 32; mb += 8) {
#pragma unroll
                    for (int k = 0; k < 8; ++k) *(LAS f32x4*)(lgs + k * 256 + 4 * lane) = rr[k];
                    { const int nb_ = mb + 8 < 32 ? mb + 8 : mb;
#pragma unroll
                      for (int k = 0; k < 8; ++k) rr[k] = *(const f32x4*)(logits + (size_t)(r0 + nb_ + k) * NE + 4 * lane); }
                    for (int m = mb; m < mb + 8; ++m) {
                        const int t = r0 + m;
                        float lg[4];
#pragma unroll
                        for (int i = 0; i < 4; ++i) lg[i] = lgs[(m - mb) * 256 + lane + 64 * i];
                        unsigned long long Sm[4]; float sc[4], gsum;
                        route_select(lg, rb, lane, Sm, sc, gsum);
                        unsigned p[4];
#pragma unroll
                        for (int i = 0; i < 4; ++i) { p[i] = 0u; if ((Sm[i] >> lane) & 1ull) p[i] = atomicAdd(&cntw[(t / CHT) * 256 + lane + 64 * i], 1u); }
                        if (m > 0) route_commit(t - 1, lane, pSm, pg, pp, eidx, gatev, posv, elist);
#pragma unroll
                        for (int i = 0; i < 4; ++i) { pSm[i] = Sm[i]; pg[i] = sc[i] / gsum * 2.5f; pp[i] = p[i]; }
                    }
                }
                route_commit(r0 + 31, lane, pSm, pg, pp, eidx, gatev, posv, elist);
            }
        }
        xcd_barrier(bar);
    }
    if (ph & 512u) {
        MoeCtx mc; mc.lds = lds; mc.ws = ws; mc.out = args.out; mc.ln2g = args.in[21]; mc.ln2b = args.in[22]; mc.G = G; mc.gw = gw; mc.NGW = NGW; mc.tid = tid; mc.lane = lane;
        static_assert(NCH == 2, "MoE chunk program");
        moe_gu<0>(mc); xcd_barrier(bar); moe_d<0>(mc); xcd_barrier(bar);
        moe_cgu<0>(mc); xcd_barrier(bar); moe_d<1>(mc); xcd_barrier(bar);
        moe_prefix((const unsigned*)(ws + WS_CTL) + CW_CNT + 1 * 256, nullptr, moe_esc(lds), nullptr, tid);
        moe_combine<1>(mc);
    }
}

extern "C" void kernel_launch(void* const* d_in, const int* in_sizes, int n_in, void* d_out, int out_size, void* d_ws, size_t ws_size, hipStream_t stream) {
    static int grid = 0;
    if (grid == 0) {
        if (n_in != 23 || in_sizes[0] != T * D || out_size != T * D || ws_size < WS_NEED) { fprintf(stderr, "kernel_launch: unexpected inputs / workspace (%d inputs, %zu bytes)\n", n_in, ws_size); grid = -1; return; }
        int dev = 0, cus = 0;
        if (hipGetDevice(&dev) != hipSuccess || hipDeviceGetAttribute(&cus, hipDeviceAttributeMultiprocessorCount, dev) != hipSuccess) { grid = -1; return; }
        if (hipFuncSetAttribute((const void*)mega, hipFuncAttributeMaxDynamicSharedMemorySize, LDS_BYTES) != hipSuccess) { fprintf(stderr, "kernel_launch: hipFuncSetAttribute failed\n"); grid = -1; return; }
        int per_cu = 0;
        if (hipOccupancyMaxActiveBlocksPerMultiprocessor(&per_cu, (const void*)mega, NWAVES * 64, LDS_BYTES) != hipSuccess || per_cu < 1) fprintf(stderr, "kernel_launch: occupancy query says %d\n", per_cu);
        (void)hipGetLastError();
        if (cus != 256) fprintf(stderr, "kernel_launch: built for the 256 CUs of MI355X (one row panel per workgroup), found %d\n", cus);
        grid = cus;
    }
    if (grid < 0) return;
    (void)hipMemsetAsync((char*)d_ws + WS_CTL, 0, CTL_ZERO_BYTES, stream);
    MegaArgs a{};
    for (int i = 0; i < 23; ++i) a.in[i] = (const float*)d_in[i];
    a.out = (float*)d_out; a.ws = (unsigned char*)d_ws; a.phases = 0x3ffu; a.li = 0u;
    hipLaunchKernelGGL(mega, dim3(grid), dim3(NWAVES * 64), LDS_BYTES, stream, a);
}
```
